# Optimizing an MI355X kernel written in HIP

```python
import jax, jax.numpy as jnp
from jax import lax
import numpy as np

D_MODEL = 1024
BATCH = 8
SEQ = 8192
DEPTH = 2
DEC_BATCH = 32
DEC_SEQ = 64
PAST_LEN = 4096

CHUNK = 64
MLP_CHUNK = 128
HEAD_DIM = 64
D_A = 512
N_HEADS_A = D_A // HEAD_DIM
D_B = 256
POOL_WINDOWS = (2, 4, 8, 16)
N_POOL_GROUPS = len(POOL_WINDOWS)
POOL_GROUP_DIM = D_B // N_POOL_GROUPS
POOL_STATE = max(POOL_WINDOWS) - 1
D_C = 256
N_HEADS_C = D_C // HEAD_DIM
CONV_W = 3
D_MIX = D_A + D_B + D_C
D_IN = 2 * D_A + D_B + 3 * D_C
D_FF = -(-8 * D_MODEL // (3 * 256)) * 256
ALPHA = (2 * DEPTH) ** 0.25
BETA = (8 * DEPTH) ** -0.25
LN_EPS = 1e-5

kernel_name = 'hybrid_stream_gmlp_pool_shortconv_step'


def layer_norm(x, g, b):
    xf = x.astype(jnp.float32)
    mu = jnp.mean(xf, axis=-1, keepdims=True)
    var = jnp.mean(jnp.square(xf - mu), axis=-1, keepdims=True)
    return ((xf - mu) * lax.rsqrt(var + LN_EPS) * g.astype(jnp.float32) + b.astype(jnp.float32)).astype(x.dtype)


def chunk_mlp(u, v, w_spatial, b_spatial):
    bsz, s, _ = v.shape
    pad = (-s) % MLP_CHUNK
    vp = jnp.pad(v, ((0, 0), (0, pad), (0, 0)))
    n = (s + pad) // MLP_CHUNK
    vb = vp.reshape(bsz, n, MLP_CHUNK, N_HEADS_A, HEAD_DIM)
    blk = jnp.arange(MLP_CHUNK) // CHUNK
    mask = blk[None, :] <= blk[:, None]
    ws = jnp.where(mask[None], w_spatial, jnp.zeros((), w_spatial.dtype))
    z = jnp.einsum('hij,bnjhd->bnihd', ws, vb) + b_spatial.T[None, None, :, :, None]
    z = z.reshape(bsz, n * MLP_CHUNK, D_A)[:, :s]
    return u * z


def pool_mixer(xb, pool_prefix, pos0, w_pool, pool_scale):
    bsz, s, _ = xb.shape
    padded = jnp.concatenate([pool_prefix.astype(xb.dtype), xb], axis=1)
    cs = jnp.cumsum(padded.astype(jnp.float32), axis=1)
    cs = jnp.pad(cs, ((0, 0), (1, 0), (0, 0)))
    pos = pos0 + jnp.arange(s)
    end = POOL_STATE + 1
    groups = []
    for g, w in enumerate(POOL_WINDOWS):
        c0 = g * POOL_GROUP_DIM
        c1 = c0 + POOL_GROUP_DIM
        win = cs[:, end:end + s, c0:c1] - cs[:, end - w:end - w + s, c0:c1]
        cnt = jnp.minimum(pos + 1, w).astype(jnp.float32)[None, :, None]
        groups.append(win / cnt)
    pooled = jnp.stack(groups, axis=2)
    xg = xb.reshape(bsz, s, N_POOL_GROUPS, POOL_GROUP_DIM).astype(jnp.float32)
    diff = (pooled - xg).astype(xb.dtype)
    out = jnp.einsum('bsgc,gce->bsge', diff, w_pool).reshape(bsz, s, D_B) * pool_scale
    return out, padded[:, -POOL_STATE:]


def short_conv(gb, gc, h, conv_prefix, conv_w):
    s = h.shape[1]
    z = gc * h
    padded = jnp.concatenate([conv_prefix.astype(z.dtype), z], axis=1)
    y = conv_w[0] * padded[:, 0:s]
    for k in range(1, CONV_W):
        y = y + conv_w[k] * padded[:, k:k + s]
    return gb * y, padded[:, -(CONV_W - 1):]


def trunk_layer(x, pool_prefix, conv_prefix, pos0, ln_mix_g, ln_mix_b, w_in, v_norm_g, v_norm_b,
                w_spatial, b_spatial, w_pool, pool_scale, conv_w, w_out,
                ln_ffn_g, ln_ffn_b, w_gate, w_up, w_down):
    proj = jnp.einsum('bsd,de->bse', x, w_in)
    cuts = [D_A, 2 * D_A, 2 * D_A + D_B, 2 * D_A + D_B + D_C, 2 * D_A + D_B + 2 * D_C]
    u, v, xb, gb, gc, h = jnp.split(proj, cuts, axis=-1)
    v = layer_norm(v, v_norm_g, v_norm_b)
    out_a = chunk_mlp(u, v, w_spatial, b_spatial)
    out_b, pool_state = pool_mixer(xb, pool_prefix, pos0, w_pool, pool_scale)
    out_c, conv_state = short_conv(gb, gc, h, conv_prefix, conv_w)
    mix = jnp.einsum('bse,ed->bsd', jnp.concatenate([out_a, out_b, out_c], axis=-1), w_out)
    x = layer_norm(ALPHA * x + mix, ln_mix_g, ln_mix_b)
    hid = jax.nn.silu(jnp.einsum('bsd,df->bsf', x, w_gate)) * jnp.einsum('bsd,df->bsf', x, w_up)
    ffn = jnp.einsum('bsf,fd->bsd', hid, w_down)
    x = layer_norm(ALPHA * x + ffn, ln_ffn_g, ln_ffn_b)
    return x, pool_state, conv_state, v


def setup_inputs(seed: int = 0) -> dict:
    key = jax.random.key(seed)
    ks = jax.random.split(key, 24)
    f32 = jnp.float32
    nrm = lambda k, shp, sc: jax.random.normal(k, shp, f32) * sc
    return {
        'x_prompt': nrm(ks[0], (BATCH, SEQ, D_MODEL), 1.0),
        'x_sample': nrm(ks[1], (DEC_BATCH, DEC_SEQ, D_MODEL), 1.0),
        'state_pool': nrm(ks[2], (DEPTH, DEC_BATCH, POOL_STATE, D_B), 1.0),
        'state_conv': nrm(ks[3], (DEPTH, DEC_BATCH, CONV_W - 1, D_C), 1.0),
        'ln_mix_g': 1.0 + nrm(ks[4], (DEPTH, D_MODEL), 0.02),
        'ln_mix_b': nrm(ks[5], (DEPTH, D_MODEL), 0.02),
        'w_in': nrm(ks[6], (DEPTH, D_MODEL, D_IN), D_MODEL ** -0.5),
        'v_norm_g': 1.0 + nrm(ks[7], (DEPTH, D_A), 0.02),
        'v_norm_b': nrm(ks[8], (DEPTH, D_A), 0.02),
        'w_spatial': nrm(ks[9], (DEPTH, N_HEADS_A, MLP_CHUNK, MLP_CHUNK), MLP_CHUNK ** -0.5),
        'b_spatial': 1.0 + nrm(ks[10], (DEPTH, N_HEADS_A, MLP_CHUNK), 0.02),
        'w_pool': nrm(ks[11], (DEPTH, N_POOL_GROUPS, POOL_GROUP_DIM, POOL_GROUP_DIM), POOL_GROUP_DIM ** -0.5),
        'pool_scale': 1.0 + nrm(ks[12], (DEPTH, D_B), 0.1),
        'conv_w': nrm(ks[13], (DEPTH, CONV_W, D_C), CONV_W ** -0.5),
        'w_out': nrm(ks[14], (DEPTH, D_MIX, D_MODEL), BETA * D_MIX ** -0.5),
        'ln_ffn_g': 1.0 + nrm(ks[15], (DEPTH, D_MODEL), 0.02),
        'ln_ffn_b': nrm(ks[16], (DEPTH, D_MODEL), 0.02),
        'w_gate': nrm(ks[17], (DEPTH, D_MODEL, D_FF), D_MODEL ** -0.5),
        'w_up': nrm(ks[18], (DEPTH, D_MODEL, D_FF), D_MODEL ** -0.5),
        'w_down': nrm(ks[19], (DEPTH, D_FF, D_MODEL), BETA * D_FF ** -0.5),
    }


def reference(x_prompt, x_sample, state_pool, state_conv, ln_mix_g, ln_mix_b, w_in, v_norm_g, v_norm_b,
              w_spatial, b_spatial, w_pool, pool_scale, conv_w, w_out,
              ln_ffn_g, ln_ffn_b, w_gate, w_up, w_down):
    bp = x_prompt.shape[0]
    zero_pool = jnp.zeros((bp, POOL_STATE, D_B), x_prompt.dtype)
    zero_conv = jnp.zeros((bp, CONV_W - 1, D_C), x_prompt.dtype)
    yp, ys = x_prompt, x_sample
    pool_p, pool_s, conv_p, conv_s, v_s = [], [], [], [], []
    for l in range(DEPTH):
        params = (ln_mix_g[l], ln_mix_b[l], w_in[l], v_norm_g[l], v_norm_b[l],
                  w_spatial[l], b_spatial[l], w_pool[l], pool_scale[l], conv_w[l], w_out[l],
                  ln_ffn_g[l], ln_ffn_b[l], w_gate[l], w_up[l], w_down[l])
        yp, sp_pool, sp_conv, _ = trunk_layer(yp, zero_pool, zero_conv, 0, *params)
        ys, ss_pool, ss_conv, ss_v = trunk_layer(ys, state_pool[l], state_conv[l], PAST_LEN, *params)
        pool_p.append(sp_pool)
        conv_p.append(sp_conv)
        pool_s.append(ss_pool)
        conv_s.append(ss_conv)
        v_s.append(ss_v)
    new_pool_prompt = jnp.stack(pool_p, axis=0)
    new_pool_sample = jnp.stack(pool_s, axis=0)
    new_conv_prompt = jnp.stack(conv_p, axis=0)
    new_conv_sample = jnp.stack(conv_s, axis=0)
    new_chunk_v_sample = jnp.stack(v_s, axis=0)
    return (yp, ys, new_pool_prompt, new_pool_sample, new_conv_prompt, new_conv_sample, new_chunk_v_sample)
```

```cpp
#include <hip/hip_runtime.h>
#include <hip/hip_cooperative_groups.h>
#include <cstdio>
#include <cstdint>
namespace cg = cooperative_groups;
#define WGM_G2 8
#define WGM_G4 8
namespace pg8 {
#define PG8_LAS __attribute__((address_space(3)))
typedef unsigned short bf16_t;
typedef short bf16x8 __attribute__((ext_vector_type(8)));
typedef float f32x4 __attribute__((ext_vector_type(4)));
typedef unsigned u32x4 __attribute__((ext_vector_type(4)));
constexpr int BM = 256, BK = 64, HALF = 128, HTB = HALF * BK * 2  , STAGE_BYTES = 8 * HTB, NXCD = 8, WGM = 6;

__host__ __device__ __forceinline__ int lds_byte(int r, int c) { const int st = (r >> 4) * 2 + (c >> 5), rr = r & 15, cc = c & 31, ob = rr * 64 + cc * 2; return st * 1024 + (ob ^ (((ob >> 9) & 1) << 5)); }
__host__ __device__ __forceinline__ void stage_rc(int b, int& R, int& C) { const int st = b / 1024, sb = b % 1024, swz = sb ^ (((sb >> 9) & 1) << 5); R = (st >> 1) * 16 + swz / 64; C = (st & 1) * 32 + (swz % 64) / 2; }
__host__ __device__ __forceinline__ int perm32(int rho) { const int n = rho >> 4, i = rho & 15; return 8 * (i >> 2) + 4 * n + (i & 3); }

struct Unit { int pm, pn, k0, nt, split; };
struct Gemm { const bf16_t* A; const bf16_t* Bt; int M, N, K; };

struct StaticOrder {
    int nM, nN, nwg, G, c, ntf, wgm;
    __host__ __device__ void init(int M, int N, int K, int G_, int c_, int wgm_ = WGM) { nM = M / BM; nN = N / BM; nwg = nM * nN; G = G_; c = c_; ntf = K / BK; wgm = wgm_; }
    __host__ __device__ bool next(int i, Unit& u) const {
        const long L = (long)i * G + c; if (L >= nwg) return false;
        int wgid = (int)L; { const int q = nwg / NXCD, r = nwg % NXCD, xcd = wgid % NXCD, off = wgid / NXCD; wgid = (xcd < r ? xcd * (q + 1) : r * (q + 1) + (xcd - r) * q) + off; }
        const int nig = wgm * nN, gid = wgid / nig, fm = gid * wgm, gsz = (nM - fm) < wgm ? (nM - fm) : wgm;
        u.pm = fm + ((wgid % nig) % gsz); u.pn = (wgid % nig) / gsz; u.k0 = 0; u.nt = ntf; u.split = -1; return true;
    }
    __device__ __forceinline__ void a_ready(const Unit&) const {}
    __device__ __forceinline__ void done(const Unit&) const {}
};
constexpr int NSPLIT = 4;
__host__ __device__ __forceinline__ bool split_ok(int Mfull, int Mprompt, int N, int G) { const int nN = N / BM; return (G >= 8 * nN * NSPLIT) && ((Mprompt / BM * nN) % G == 0) && ((Mfull - Mprompt) / BM == 8); }
struct TailSplitOrder {
    int pm0, nN, c, q, rem;
    __host__ __device__ void init(int Mprompt, int N, int K, int c_) { nN = N / BM; pm0 = Mprompt / BM; c = c_; const int ntf = K / BK; q = (ntf / NSPLIT) & ~1; rem = ntf - q * NSPLIT; }
    __host__ __device__ bool next(int i, Unit& u) const {
        if (i > 0 || c >= 8 * nN * NSPLIT) return false;
        const int tu = c % (8 * nN), s = c / (8 * nN), first_big = NSPLIT - rem / 2;
        u.pm = pm0 + tu / nN; u.pn = tu % nN; u.k0 = s * q + (s > first_big ? 2 * (s - first_big) : 0); u.nt = q + (s >= first_big ? 2 : 0); u.split = s; return true;
    }
    __device__ __forceinline__ void a_ready(const Unit&) const {}
    __device__ __forceinline__ void done(const Unit&) const {}
};
__device__ __forceinline__ unsigned cvt_pk_bf16(float lo, float hi) { unsigned r; asm volatile("v_cvt_pk_bf16_f32 %0, %1, %2" : "=v"(r) : "v"(lo), "v"(hi)); return r; }
constexpr float LN_EPS = 1e-5f;
constexpr float ALPHA = 1.41421356237309515f;
typedef unsigned u32x2 __attribute__((ext_vector_type(2)));
__device__ __forceinline__ void unpack8(const u32x4 w, float (&f)[8]) {
    f[0] = __uint_as_float(w.x << 16); f[1] = __uint_as_float(w.x & 0xffff0000u); f[2] = __uint_as_float(w.y << 16); f[3] = __uint_as_float(w.y & 0xffff0000u);
    f[4] = __uint_as_float(w.z << 16); f[5] = __uint_as_float(w.z & 0xffff0000u); f[6] = __uint_as_float(w.w << 16); f[7] = __uint_as_float(w.w & 0xffff0000u);
}
__device__ __forceinline__ void unpack4(const u32x2 w, float (&f)[4]) {
    f[0] = __uint_as_float(w.x << 16); f[1] = __uint_as_float(w.x & 0xffff0000u); f[2] = __uint_as_float(w.y << 16); f[3] = __uint_as_float(w.y & 0xffff0000u);
}
__device__ __forceinline__ u32x4 pack8(const float (&f)[8]) { u32x4 w; w.x = cvt_pk_bf16(f[0], f[1]); w.y = cvt_pk_bf16(f[2], f[3]); w.z = cvt_pk_bf16(f[4], f[5]); w.w = cvt_pk_bf16(f[6], f[7]); return w; }
__device__ __forceinline__ void row_stats(const float* st, int row, float& mu, float& rstd) {
    typedef float f32x2v __attribute__((ext_vector_type(2)));
    const f32x2v a = *(const f32x2v*)(st + (size_t)row * 2); mu = a[0]; rstd = a[1];
}
__device__ __forceinline__ void load8f(const float* p, float (&f)[8]) { const f32x4 a = *(const f32x4*)p, b = *(const f32x4*)(p + 4); f[0] = a[0]; f[1] = a[1]; f[2] = a[2]; f[3] = a[3]; f[4] = b[0]; f[5] = b[1]; f[6] = b[2]; f[7] = b[3]; }

struct EpiProj {
    static constexpr bool PERM = true, AFTER_DRAIN = false;
    bf16_t* O; int ldo; const float* stats; const float* c1; const float* c2;
    __device__ __forceinline__ void operator()(f32x4 (&acc)[2][2][4][2], const Unit& u, int wr, int wc, int fr, int fq) const {
        const int row0 = u.pm * BM + wr * 64 + fr, col0 = u.pn * BM + wc * 32 + 8 * fq;
        const bool ln = stats != nullptr;
        float rs8[8], nm8[8];
#pragma unroll
        for (int i = 0; i < 8; ++i) { float mu = 0.f; rs8[i] = 1.f; if (ln) row_stats(stats, row0 + (i >> 2) * HALF + (i & 3) * 16, mu, rs8[i]); nm8[i] = -rs8[i] * mu; }
#pragma unroll
        for (int bj = 0; bj < 2; ++bj) {
            float k1[8], k2[8];
            if (ln) { load8f(c1 + col0 + bj * HALF, k1); load8f(c2 + col0 + bj * HALF, k2); }
            else {
#pragma unroll
                for (int q = 0; q < 8; ++q) { k1[q] = 0.f; k2[q] = 0.f; } }
#pragma unroll
            for (int ai = 0; ai < 2; ++ai)
#pragma unroll
                for (int m = 0; m < 4; ++m) {
                    const float rs = rs8[ai * 4 + m], nm = nm8[ai * 4 + m];
#pragma unroll
                    for (int q = 0; q < 4; ++q) { acc[ai][bj][m][0][q] = rs * acc[ai][bj][m][0][q] + (nm * k1[q] + k2[q]); acc[ai][bj][m][1][q] = rs * acc[ai][bj][m][1][q] + (nm * k1[4 + q] + k2[4 + q]); }
                }
        }
        asm volatile("" ::: "memory");
#pragma unroll
        for (int ai = 0; ai < 2; ++ai)
#pragma unroll
            for (int m = 0; m < 4; ++m) {
                const int row = row0 + ai * HALF + m * 16;
#pragma unroll
                for (int bj = 0; bj < 2; ++bj) { u32x4 w; w.x = cvt_pk_bf16(acc[ai][bj][m][0][0], acc[ai][bj][m][0][1]); w.y = cvt_pk_bf16(acc[ai][bj][m][0][2], acc[ai][bj][m][0][3]);
                    w.z = cvt_pk_bf16(acc[ai][bj][m][1][0], acc[ai][bj][m][1][1]); w.w = cvt_pk_bf16(acc[ai][bj][m][1][2], acc[ai][bj][m][1][3]);
                    *(u32x4*)(O + (size_t)row * ldo + col0 + bj * HALF) = w; }
            }
    }
};
struct EpiSwiGLU {
    static constexpr bool PERM = true, AFTER_DRAIN = false;
    bf16_t* O; int ldo; const float* stats; const float* c1; const float* c2;
    __device__ __forceinline__ void operator()(f32x4 (&acc)[2][2][4][2], const Unit& u, int wr, int wc, int fr, int fq) const {
        const int row0 = u.pm * BM + wr * 64 + fr, cidx = u.pn * BM + wc * 32 + 8 * fq, ocol = u.pn * HALF + wc * 32 + 8 * fq;
        float rs8[8], nm8[8];
#pragma unroll
        for (int i = 0; i < 8; ++i) { float mu; row_stats(stats, row0 + (i >> 2) * HALF + (i & 3) * 16, mu, rs8[i]); nm8[i] = -rs8[i] * mu; }
        float k1g[8], k2g[8], k1u[8], k2u[8];
        load8f(c1 + cidx, k1g); load8f(c2 + cidx, k2g); load8f(c1 + cidx + HALF, k1u); load8f(c2 + cidx + HALF, k2u);
#pragma unroll
        for (int ai = 0; ai < 2; ++ai)
#pragma unroll
            for (int m = 0; m < 4; ++m) {
                const int row = row0 + ai * HALF + m * 16;
                const float rs = rs8[ai * 4 + m], nm = nm8[ai * 4 + m];
                float o[8];
#pragma unroll
                for (int q = 0; q < 8; ++q) {
                    const float ga = (q < 4) ? acc[ai][0][m][0][q & 3] : acc[ai][0][m][1][q & 3], ua = (q < 4) ? acc[ai][1][m][0][q & 3] : acc[ai][1][m][1][q & 3];
                    const float g = rs * ga + (nm * k1g[q] + k2g[q]), up = rs * ua + (nm * k1u[q] + k2u[q]);
                    o[q] = g * __builtin_amdgcn_rcpf(1.f + __expf(-g)) * up;
                }
                *(u32x4*)(O + (size_t)row * ldo + ocol) = pack8(o);
            }
    }
};
struct EpiRes {
    static constexpr bool PERM = true, AFTER_DRAIN = false;
    bf16_t* O; const bf16_t* R; const float* stats_in; const float* g; const float* b; float* stats_out; PG8_LAS float* pst;
    __device__ __forceinline__ void operator()(f32x4 (&acc)[2][2][4][2], const Unit& u, int wr, int wc, int fr, int fq) const {
        const int row0 = u.pm * BM + wr * 64 + fr, col0 = u.pn * BM + wc * 32 + 8 * fq;
        const bool ln = stats_in != nullptr;
#pragma unroll
        for (int bj = 0; bj < 2; ++bj) {
            float gg[8], bb[8];
            if (ln) { load8f(g + col0 + bj * HALF, gg); load8f(b + col0 + bj * HALF, bb); }
            else {
#pragma unroll
                for (int q = 0; q < 8; ++q) { gg[q] = 1.f; bb[q] = 0.f; } }
#pragma unroll
            for (int ai = 0; ai < 2; ++ai) {
                u32x4 rw[4];
                asm volatile("" ::: "memory");
#pragma unroll
                for (int m = 0; m < 4; ++m) rw[m] = *(const u32x4*)((const char*)R + (size_t)(((unsigned)(row0 + ai * HALF + m * 16) * 1024u + (unsigned)(col0 + bj * HALF)) * 2u));
                float mu4[4], rs4[4];
#pragma unroll
                for (int m = 0; m < 4; ++m) { mu4[m] = 0.f; rs4[m] = 1.f; if (ln) row_stats(stats_in, row0 + ai * HALF + m * 16, mu4[m], rs4[m]); }
#pragma unroll
                for (int m = 0; m < 4; ++m) {
                    const float mu = mu4[m], rs = rs4[m];
                    float r[8]; unpack8(rw[m], r);
#pragma unroll
                    for (int n = 0; n < 2; ++n)
#pragma unroll
                        for (int q4 = 0; q4 < 4; ++q4) { const int q = n * 4 + q4;
                            const float xr = (r[q] - mu) * rs * gg[q] + bb[q];
                            const float a = ALPHA * xr + acc[ai][bj][m][n][q4];
                            acc[ai][bj][m][n][q4] = a; }
                }
                asm volatile("" : "+v"(acc[ai][bj][0][0]), "+v"(acc[ai][bj][0][1]), "+v"(acc[ai][bj][1][0]), "+v"(acc[ai][bj][1][1]), "+v"(acc[ai][bj][2][0]), "+v"(acc[ai][bj][2][1]), "+v"(acc[ai][bj][3][0]), "+v"(acc[ai][bj][3][1]) :: "memory");
            }
        }
        asm volatile("" ::: "memory");
#pragma unroll
        for (int ai = 0; ai < 2; ++ai)
#pragma unroll
            for (int m = 0; m < 4; ++m) {
                const int row = row0 + ai * HALF + m * 16;
                float s = 0.f, q2 = 0.f;
#pragma unroll
                for (int bj = 0; bj < 2; ++bj) {
#pragma unroll
                    for (int n = 0; n < 2; ++n)
#pragma unroll
                        for (int q4 = 0; q4 < 4; ++q4) { const float a = acc[ai][bj][m][n][q4]; s += a; q2 += a * a; }
                    u32x4 w; w.x = cvt_pk_bf16(acc[ai][bj][m][0][0], acc[ai][bj][m][0][1]); w.y = cvt_pk_bf16(acc[ai][bj][m][0][2], acc[ai][bj][m][0][3]);
                    w.z = cvt_pk_bf16(acc[ai][bj][m][1][0], acc[ai][bj][m][1][1]); w.w = cvt_pk_bf16(acc[ai][bj][m][1][2], acc[ai][bj][m][1][3]);
                    *(u32x4*)((char*)O + (size_t)(((unsigned)row * 1024u + (unsigned)(col0 + bj * HALF)) * 2u)) = w; }
                s += __shfl_xor(s, 16); s += __shfl_xor(s, 32); q2 += __shfl_xor(q2, 16); q2 += __shfl_xor(q2, 32);
                if (fq == 0) { PG8_LAS float* p = pst + ((ai * HALF + wr * 64 + m * 16 + fr) * 4 + wc) * 2; p[0] = s; p[1] = q2; }
            }
        asm volatile("s_waitcnt lgkmcnt(0)" ::: "memory"); __builtin_amdgcn_s_barrier(); asm volatile("" ::: "memory");
        if (threadIdx.x < 256) {
            const int row = threadIdx.x; const PG8_LAS f32x4* p = (const PG8_LAS f32x4*)(pst + row * 8);
            const f32x4 a = p[0], c = p[1];
            typedef float f32x2v __attribute__((ext_vector_type(2)));
            *(f32x2v*)(stats_out + ((size_t)(u.pm * BM + row) * 4 + u.pn) * 2) = (f32x2v){(a[0] + a[2]) + (c[0] + c[2]), (a[1] + a[3]) + (c[1] + c[3])};
        }
    }
};

struct EpiPart {
    static constexpr bool PERM = true, AFTER_DRAIN = false;
    float* part; int part_row0, part_rows;
    __device__ __forceinline__ void operator()(f32x4 (&acc)[2][2][4][2], const Unit& u, int wr, int wc, int fr, int fq) const {
        const int row0 = u.pm * BM + wr * 64 + fr, col0 = u.pn * BM + wc * 32 + 8 * fq;
        const unsigned pb = (((unsigned)u.split * (unsigned)part_rows + (unsigned)(row0 - part_row0)) * 1024u + (unsigned)col0) * 4u;
#pragma unroll
        for (int ai = 0; ai < 2; ++ai)
#pragma unroll
            for (int m = 0; m < 4; ++m)
#pragma unroll
                for (int bj = 0; bj < 2; ++bj) { float* p = (float*)((char*)part + (size_t)(pb + (unsigned)((ai * HALF + m * 16) * 1024 + bj * HALF) * 4u)); *(f32x4*)p = acc[ai][bj][m][0]; *(f32x4*)(p + 4) = acc[ai][bj][m][1]; }
    }
};
template <class Epi, class Sched, bool ALIGN_EPI = false, bool SP2 = false>
__device__ __forceinline__ void gemm_phase(PG8_LAS unsigned char* lds, const Gemm g, const Sched& S, const Epi& E) {
    int tid_ = threadIdx.x; asm volatile("" : "+v"(tid_));
    const int tid = tid_, wid = __builtin_amdgcn_readfirstlane(tid >> 6), lane = tid & 63, wr = wid >> 2, wc = wid & 3, fr = lane & 15, fq = lane >> 4;
    const int K = g.K;
    unsigned voffA[2], voffB[2];
#pragma unroll
    for (int i = 0; i < 2; ++i) { int R, C; stage_rc(tid * 16 + i * 8192, R, C); const int Rb = Epi::PERM ? ((R & ~31) + perm32(R & 31)) : R;
        voffA[i] = (unsigned)(R * K + C) * 2u; voffB[i] = (unsigned)(Rb * K + C) * 2u; }
    const size_t kstep = (size_t)(BK * 2);
    const size_t hstep = (size_t)HALF * K * 2;
    const size_t tstep = 2 * hstep;
    const unsigned ldsw = (unsigned)wid * 1024u;
    const int aoff = lds_byte(wr * 64 + fr, fq * 8), boff = lds_byte(wc * 32 + fr, fq * 8);
#define PG8_SA(b, h) (((b) * 2 + (h)) * HTB)
#define PG8_SB(b, h) ((4 + (b) * 2 + (h)) * HTB)
#define PG8_STAGE(bufoff, gbase, voff) do { _Pragma("unroll") for (int _i = 0; _i < 2; ++_i) \
        __builtin_amdgcn_global_load_lds((const unsigned*)((const char*)(gbase) + (voff)[_i]), (PG8_LAS unsigned*)(lds + (bufoff) + ldsw + _i * 8192), 16, 0, 0); } while (0)
#define PG8_LDA(dst, b, h) do { _Pragma("unroll") for (int m = 0; m < 4; ++m) _Pragma("unroll") for (int k = 0; k < 2; ++k) dst[m][k] = *(const PG8_LAS bf16x8*)(lds + PG8_SA(b, h) + aoff + m * 2048 + k * 1024); } while (0)
#define PG8_LDB(dst, b, h) do { _Pragma("unroll") for (int n = 0; n < 2; ++n) _Pragma("unroll") for (int k = 0; k < 2; ++k) dst[n][k] = *(const PG8_LAS bf16x8*)(lds + PG8_SB(b, h) + boff + n * 2048 + k * 1024); } while (0)
#define PG8_MMA(ai, bj, At, Bt) do { __builtin_amdgcn_s_setprio(1); _Pragma("unroll") for (int m = 0; m < 4; ++m) _Pragma("unroll") for (int n = 0; n < 2; ++n) _Pragma("unroll") for (int k = 0; k < 2; ++k) \
        acc[ai][bj][m][n] = __builtin_amdgcn_mfma_f32_16x16x32_bf16(Bt[n][k], At[m][k], acc[ai][bj][m][n], 0, 0, 0); __builtin_amdgcn_s_setprio(0); } while (0)
#define PG8_WAIT_V(n) asm volatile("s_waitcnt vmcnt(" #n ")" ::: "memory")
#define PG8_WAIT_L(n) asm volatile("s_waitcnt lgkmcnt(" #n ")" ::: "memory")
#define PG8_BAR __builtin_amdgcn_s_barrier()
#define PG8_SCHED __builtin_amdgcn_sched_barrier(0)
    Unit cur, nxt; int ui = 0;
    if (!S.next(0, cur)) return;
    f32x4 acc[2][2][4][2];
#pragma unroll
    for (int a = 0; a < 2; ++a)
#pragma unroll
        for (int b = 0; b < 2; ++b)
#pragma unroll
            for (int m = 0; m < 4; ++m)
#pragma unroll
                for (int n = 0; n < 2; ++n) acc[a][b][m][n] = (f32x4){0.f, 0.f, 0.f, 0.f};
    bf16x8 At[4][2], B0[2][2], B1[2][2];
    const char* cA = (const char*)g.A + (size_t)cur.pm * tstep + (size_t)cur.k0 * kstep; const char* cB = (const char*)g.Bt + (size_t)cur.pn * tstep + (size_t)cur.k0 * kstep;
    S.a_ready(cur);
    if constexpr (SP2) {
        PG8_STAGE(PG8_SB(0, 0), cB, voffB); PG8_STAGE(PG8_SB(0, 1), cB + hstep, voffB); PG8_STAGE(PG8_SA(0, 0), cA, voffA); PG8_STAGE(PG8_SA(0, 1), cA + hstep, voffA);
        if (wr == 1) PG8_BAR;
        PG8_WAIT_V(2); PG8_BAR;
        PG8_STAGE(PG8_SB(1, 0), cB + kstep, voffB); PG8_STAGE(PG8_SA(1, 0), cA + kstep, voffA); PG8_STAGE(PG8_SB(1, 1), cB + hstep + kstep, voffB);
        PG8_WAIT_V(6); PG8_BAR;
    } else {
        PG8_STAGE(PG8_SB(0, 0), cB, voffB); PG8_STAGE(PG8_SA(0, 0), cA, voffA); PG8_STAGE(PG8_SB(0, 1), cB + hstep, voffB); PG8_STAGE(PG8_SA(0, 1), cA + hstep, voffA);
        if (wr == 1) PG8_BAR;
        PG8_WAIT_V(4); PG8_BAR;
        PG8_STAGE(PG8_SB(1, 0), cB + kstep, voffB); PG8_STAGE(PG8_SA(1, 0), cA + kstep, voffA); PG8_STAGE(PG8_SB(1, 1), cB + hstep + kstep, voffB);
        PG8_WAIT_V(6); PG8_BAR;
    }
    for (;;) {
        const bool has_next = S.next(ui + 1, nxt);
        const char* nA = has_next ? (const char*)g.A + (size_t)nxt.pm * tstep + (size_t)nxt.k0 * kstep : cA; const char* nB = has_next ? (const char*)g.Bt + (size_t)nxt.pn * tstep + (size_t)nxt.k0 * kstep : cB;
        const int nt = cur.nt;
#ifndef KREP
#define KREP 1
#endif
        for (int tt_ = 0; tt_ < nt * KREP; tt_ += 2) {
            const int t = (KREP > 1 && tt_ >= nt) ? tt_ - nt : tt_;
            if (KREP > 1 && tt_ == nt) {
#pragma unroll
                for (int a = 0; a < 2; ++a)
#pragma unroll
                    for (int b2_ = 0; b2_ < 2; ++b2_)
#pragma unroll
                        for (int m = 0; m < 4; ++m)
#pragma unroll
                            for (int n = 0; n < 2; ++n) acc[a][b2_][m][n] = (f32x4){0.f, 0.f, 0.f, 0.f}; }
            const bool last = (tt_ == nt * KREP - 2);
            const char* a1 = cA + (size_t)(t + 1) * kstep;
            const int t2 = (KREP > 1 && t + 2 >= nt) ? t + 2 - nt : t + 2;
            const char* a2 = last ? nA : cA + (size_t)t2 * kstep; const char* b2 = last ? nB : cB + (size_t)t2 * kstep;
            const char* a3 = a2 + kstep; const char* b3 = b2 + kstep;
            if (last && has_next) S.a_ready(nxt);
            if constexpr (SP2) {
            PG8_LDB(B0, 0, 0); PG8_LDB(B1, 0, 1); PG8_SCHED; PG8_LDA(At, 0, 0); PG8_STAGE(PG8_SA(1, 1), a1 + hstep, voffA);
            PG8_WAIT_V(8); PG8_WAIT_L(0); PG8_BAR; PG8_MMA(0, 0, At, B0); PG8_MMA(0, 1, At, B1); PG8_BAR; PG8_SCHED;
            PG8_LDA(At, 0, 1); PG8_STAGE(PG8_SB(0, 0), b2, voffB); PG8_STAGE(PG8_SB(0, 1), b2 + hstep, voffB); PG8_STAGE(PG8_SA(0, 0), a2, voffA);
            PG8_WAIT_V(8); PG8_WAIT_L(0); PG8_BAR; PG8_MMA(1, 0, At, B0); PG8_MMA(1, 1, At, B1); PG8_BAR; PG8_SCHED;
            PG8_LDB(B0, 1, 0); PG8_LDB(B1, 1, 1); PG8_SCHED; PG8_LDA(At, 1, 0); PG8_STAGE(PG8_SA(0, 1), a2 + hstep, voffA);
            PG8_WAIT_V(8); PG8_WAIT_L(0); PG8_BAR; PG8_MMA(0, 0, At, B0); PG8_MMA(0, 1, At, B1); PG8_BAR; PG8_SCHED;
            PG8_LDA(At, 1, 1); PG8_STAGE(PG8_SB(1, 0), b3, voffB); PG8_STAGE(PG8_SB(1, 1), b3 + hstep, voffB); PG8_STAGE(PG8_SA(1, 0), a3, voffA);
            PG8_WAIT_V(8); PG8_WAIT_L(0); PG8_BAR; PG8_MMA(1, 0, At, B0); PG8_MMA(1, 1, At, B1); PG8_BAR; PG8_SCHED;
            } else {
            PG8_LDB(B0, 0, 0); PG8_SCHED; PG8_LDA(At, 0, 0); PG8_STAGE(PG8_SA(1, 1), a1 + hstep, voffA);
            PG8_WAIT_L(8); PG8_BAR; PG8_WAIT_L(0); PG8_MMA(0, 0, At, B0); PG8_BAR; PG8_SCHED;
            PG8_LDB(B1, 0, 1); PG8_STAGE(PG8_SB(0, 0), b2, voffB);
            PG8_BAR; PG8_WAIT_L(0); PG8_MMA(0, 1, At, B1); PG8_BAR;
            PG8_LDA(At, 0, 1); PG8_STAGE(PG8_SA(0, 0), a2, voffA);
            PG8_BAR; PG8_WAIT_L(0); PG8_MMA(1, 0, At, B0); PG8_BAR; PG8_SCHED;
            PG8_STAGE(PG8_SB(0, 1), b2 + hstep, voffB);
            PG8_WAIT_V(6); PG8_BAR; PG8_MMA(1, 1, At, B1); PG8_BAR;
            PG8_LDB(B0, 1, 0); PG8_SCHED; PG8_LDA(At, 1, 0); PG8_STAGE(PG8_SA(0, 1), a2 + hstep, voffA);
            PG8_WAIT_L(8); PG8_BAR; PG8_WAIT_L(0); PG8_MMA(0, 0, At, B0); PG8_BAR; PG8_SCHED;
            PG8_LDB(B1, 1, 1); PG8_STAGE(PG8_SB(1, 0), b3, voffB);
            PG8_BAR; PG8_WAIT_L(0); PG8_MMA(0, 1, At, B1); PG8_BAR;
            PG8_LDA(At, 1, 1); PG8_STAGE(PG8_SA(1, 0), a3, voffA);
            PG8_BAR; PG8_WAIT_L(0); PG8_MMA(1, 0, At, B0); PG8_BAR; PG8_SCHED;
            PG8_STAGE(PG8_SB(1, 1), b3 + hstep, voffB);
            PG8_WAIT_V(6); PG8_BAR; PG8_MMA(1, 1, At, B1); PG8_BAR;
            }
        }
        if constexpr (ALIGN_EPI) { if (wr == 0) PG8_BAR; }
        if constexpr (!Epi::AFTER_DRAIN) { E(acc, cur, wr, wc, fr, fq); S.done(cur); }
        if (!has_next) break;
#pragma unroll
        for (int a = 0; a < 2; ++a)
#pragma unroll
            for (int b = 0; b < 2; ++b)
#pragma unroll
                for (int m = 0; m < 4; ++m)
#pragma unroll
                    for (int n = 0; n < 2; ++n) acc[a][b][m][n] = (f32x4){0.f, 0.f, 0.f, 0.f};
        cur = nxt; cA = nA; cB = nB; ++ui;
        if constexpr (ALIGN_EPI) { if (wr == 1) PG8_BAR; }
    }
    PG8_WAIT_V(0);
    if constexpr (!ALIGN_EPI) { if (wr == 0) PG8_BAR; }
    PG8_BAR;
    if constexpr (Epi::AFTER_DRAIN) { E.fused(acc, cur, wr, wc, fr, fq, lds, wid, lane); S.done(cur); }
#undef PG8_SA
#undef PG8_SB
#undef PG8_STAGE
#undef PG8_LDA
#undef PG8_LDB
#undef PG8_MMA
#undef PG8_WAIT_V
#undef PG8_WAIT_L
#undef PG8_BAR
#undef PG8_SCHED
}
}
#ifndef WGM_G2
#define WGM_G2 6
#endif
#ifndef WGM_G4
#define WGM_G4 6
#endif
#ifndef REP_P0
#define REP_P0 1
#endif
#ifndef REP_G1
#define REP_G1 1
#endif
#ifndef REP_MIX
#define REP_MIX 1
#endif
#ifndef REP_G2
#define REP_G2 1
#endif
#ifndef REP_G3
#define REP_G3 1
#endif
#ifndef REP_G4
#define REP_G4 1
#endif
#ifndef REP_FIN
#define REP_FIN 1
#endif
#ifndef REP_SYNC
#define REP_SYNC 1
#endif
using pg8::bf16_t; using pg8::bf16x8; using pg8::f32x4; using pg8::u32x4; using pg8::u32x2; using pg8::unpack8; using pg8::unpack4; using pg8::pack8; using pg8::cvt_pk_bf16; using pg8::load8f;
#define LAS __attribute__((address_space(3)))
constexpr int NWAVES = 8, NTHR = 512;
constexpr int D = 1024, DIN = 2048, DFF = 2816, NGU = 2 * DFF, DEPTH = 2;
constexpr int TP = 8 * 8192, TS = 32 * 64, T = TP + TS;
constexpr int LDS_BYTES = 155648, PST_OFF = 131072, MISC_OFF = LDS_BYTES - 64;
constexpr size_t al256(size_t x) { return (x + 255) & ~(size_t)255; }
constexpr size_t SZ_WIN = (size_t)DIN * D * 2, SZ_WOUT = (size_t)D * D * 2, SZ_WGU = (size_t)NGU * D * 2, SZ_WD = (size_t)D * DFF * 2, SZ_WSB = 8 * 128 * 128 * 2, SZ_WPT = 4 * 64 * 64 * 2;
constexpr size_t WS_WIN = 0, WS_WOUT = WS_WIN + DEPTH * SZ_WIN, WS_WGU = WS_WOUT + DEPTH * SZ_WOUT, WS_WD = WS_WGU + DEPTH * SZ_WGU, WS_WSB = WS_WD + DEPTH * SZ_WD, WS_WPT = WS_WSB + DEPTH * SZ_WSB;
constexpr size_t WS_C1IN = WS_WPT + DEPTH * SZ_WPT, WS_C2IN = WS_C1IN + DEPTH * DIN * 4, WS_C1GU = WS_C2IN + DEPTH * DIN * 4, WS_C2GU = WS_C1GU + DEPTH * NGU * 4;
constexpr size_t WS_BAR = al256(WS_C2GU + DEPTH * NGU * 4), BAR_BYTES = 16384;
constexpr size_t WS_ST1P = WS_BAR + BAR_BYTES, WS_ST2P = WS_ST1P + (size_t)T * 32, WS_ST1 = WS_ST2P + (size_t)T * 32, WS_ST2 = WS_ST1 + (size_t)T * 8;
constexpr size_t SZ_ACT = (size_t)T * D * 2;
constexpr size_t WS_XB = al256(WS_ST2 + (size_t)T * 8), WS_P1 = WS_XB + SZ_ACT, WS_P2 = WS_P1 + SZ_ACT, WS_PROJ = WS_P2 + SZ_ACT, WS_CAT = WS_PROJ + 2 * SZ_ACT, WS_HID = WS_PROJ, WS_PART = WS_CAT + SZ_ACT, WS_END = WS_PART + (size_t)pg8::NSPLIT * TS * D * 4;
static_assert((size_t)T * DFF * 2 <= 3 * SZ_ACT, "hid overlays proj|cat");
constexpr size_t O_YP = 0, O_YS = (size_t)TP * D, O_POOLP = (size_t)T * D, O_POOLS = O_POOLP + (size_t)DEPTH * 8 * 15 * 256, O_CONVP = O_POOLS + (size_t)DEPTH * 32 * 15 * 256,
                 O_CONVS = O_CONVP + (size_t)DEPTH * 8 * 2 * 256, O_V = O_CONVS + (size_t)DEPTH * 32 * 2 * 256, O_END = O_V + (size_t)DEPTH * 32 * 64 * 512;

struct Params { const float* in[20]; float* out; unsigned char* ws; };

__device__ __forceinline__ float wave_sum(float v) {
#pragma unroll
    for (int o = 1; o < 64; o <<= 1) v += __shfl_xor(v, o);
    return v;
}
__device__ __forceinline__ float bf2f(bf16_t h) { return __uint_as_float(((unsigned)h) << 16); }
#define LDS_WAIT() asm volatile("s_waitcnt lgkmcnt(0)" ::: "memory")

#define XB_TMO      128
#define XB_XCNT(j)  (256  + 64 * (j))
#define XB_XSUB(j)  (1280 + 64 * (j))
#define XB_XGEN(j)  (2304 + 64 * (j))
#define XB_TOP      3328
#define XB_TOPGEN   3392
#define XCD_BAR_WORDS 3456
#define XB_SPIN_CAP (1u << 18)

__device__ __forceinline__ unsigned xb_ld(unsigned* p)              { return __hip_atomic_load(p, __ATOMIC_RELAXED, __HIP_MEMORY_SCOPE_AGENT); }
__device__ __forceinline__ unsigned xb_add(unsigned* p, unsigned v) { return __hip_atomic_fetch_add(p, v, __ATOMIC_RELAXED, __HIP_MEMORY_SCOPE_AGENT); }
__device__ __forceinline__ unsigned xb_xcc_id() { return (unsigned)__builtin_amdgcn_s_getreg((3 << 11) | 20) & 0xFu; }
#define XB_SPIN(cond, bar) do { unsigned _sp = 0; while (cond) { __builtin_amdgcn_s_sleep(1); \
    if ((++_sp & 255u) == 0u) { if (xb_ld(&(bar)[XB_TMO])) break; if (_sp > XB_SPIN_CAP) { atomicAdd(&(bar)[XB_TMO], 1u); break; } } } } while (0)

struct XcdBarrier {
    unsigned* bar; unsigned x;
    volatile LAS unsigned* st;
};

__device__ __forceinline__ XcdBarrier xcd_barrier_post(unsigned* bar, volatile LAS unsigned* st) {
    XcdBarrier b; b.bar = bar; b.x = xb_xcc_id(); b.st = st;
    if (threadIdx.x == 0) (void)xb_add(&bar[XB_XCNT(b.x)], 1u);
    return b;
}
__device__ __forceinline__ void xcd_barrier_complete(unsigned* bar, unsigned x, unsigned& nloc, unsigned& nx) {
    const unsigned G = gridDim.x * gridDim.y * gridDim.z;
    unsigned sum, cnt, mine, sp = 0u;
    for (;;) {
        sum = 0u; cnt = 0u; mine = 0u;
#pragma unroll
        for (unsigned j = 0; j < 16; ++j) { const unsigned c = xb_ld(&bar[XB_XCNT(j)]); sum += c; cnt += (c > 0u) ? 1u : 0u; mine = (j == x) ? c : mine; }
        if (sum == G) break;
        __builtin_amdgcn_s_sleep(1);
        if ((++sp & 255u) == 0u) { if (xb_ld(&bar[XB_TMO])) break; if (sp > XB_SPIN_CAP) { atomicAdd(&bar[XB_TMO], 1u); break; } }
    }
    nloc = mine > 0u ? mine : 1u; nx = cnt > 0u ? cnt : 1u;
}

__device__ __forceinline__ void xcd_barrier(const XcdBarrier& b) {
    asm volatile("s_waitcnt vmcnt(0)" ::: "memory");
    __syncthreads();
    if (threadIdx.x == 0) {
        unsigned* bar = b.bar;
        __builtin_amdgcn_s_waitcnt(0);
        unsigned nloc = b.st[0], nx = b.st[1];
        if (nloc == 0u) { xcd_barrier_complete(bar, b.x, nloc, nx); b.st[0] = nloc; b.st[1] = nx; }
        const unsigned old = xb_add(&bar[XB_XSUB(b.x)], 1u);
        const unsigned gen = old / nloc;
        if (old + 1u == (gen + 1u) * nloc) {
            __builtin_amdgcn_fence(__ATOMIC_RELEASE, "agent");
            asm volatile("s_waitcnt vmcnt(0)" ::: "memory");
            const unsigned og = xb_add(&bar[XB_TOP], 1u);
            const unsigned tg = og / nx;
            if (og + 1u == (tg + 1u) * nx) xb_add(&bar[XB_TOPGEN], 1u);
            else XB_SPIN(xb_ld(&bar[XB_TOPGEN]) == tg, bar);
            __builtin_amdgcn_fence(__ATOMIC_ACQUIRE, "agent");
            xb_add(&bar[XB_XGEN(b.x)], 1u);
            asm volatile("s_waitcnt vmcnt(0)" ::: "memory");
        } else {
            XB_SPIN(xb_ld(&bar[XB_XGEN(b.x)]) == gen, bar);
            __builtin_amdgcn_fence(__ATOMIC_ACQUIRE, "agent");
            asm volatile("s_waitcnt vmcnt(0)" ::: "memory");
        }
    }
    __syncthreads();
}

__device__ __forceinline__ void p0_tile(const float* W, int srcN, int K, int k0, int n0, bf16_t* WT, int dstrow0, const float* g, const float* bvec, LAS float* scr, int lane, float (&s1)[4], float (&s2)[4]) {
    { f32x4 t[8];
#pragma unroll
      for (int i = 0; i < 8; ++i) t[i] = *(const f32x4*)(W + (size_t)(k0 + 8 * i + (lane >> 3)) * srcN + n0 + (lane & 7) * 4);
#pragma unroll
      for (int i = 0; i < 8; ++i) { LAS float* d = scr + (8 * i + (lane >> 3)) * 33 + (lane & 7) * 4; d[0] = t[i][0]; d[1] = t[i][1]; d[2] = t[i][2]; d[3] = t[i][3]; } }
    LDS_WAIT(); asm volatile("" ::: "memory");
    const int c = lane & 7;
    float gv[8], bv[8];
    if (g) { load8f(g + k0 + 8 * c, gv); load8f(bvec + k0 + 8 * c, bv); }
    else {
#pragma unroll
        for (int q = 0; q < 8; ++q) { gv[q] = 1.f; bv[q] = 0.f; } }
#pragma unroll
    for (int j = 0; j < 4; ++j) { const int n = (lane >> 3) + 8 * j; const LAS float* s = scr + (8 * c) * 33 + n;
        float v[8]; float t2 = 0.f;
#pragma unroll
        for (int q = 0; q < 8; ++q) { const float w = s[q * 33]; v[q] = w * gv[q]; t2 += w * bv[q]; }
        const u32x4 o = pack8(v);
        float r[8]; unpack8(o, r);
        s1[j] += ((r[0] + r[1]) + (r[2] + r[3])) + ((r[4] + r[5]) + (r[6] + r[7])); s2[j] += t2;
        *(u32x4*)(WT + (size_t)(dstrow0 + n) * K + k0 + 8 * c) = o; }
    LDS_WAIT(); asm volatile("" ::: "memory");
}
__device__ __forceinline__ void p0_phase(const Params& p, LAS unsigned char* lds, int wave, int lane) {
    LAS float* scr = (LAS float*)(lds + wave * 16384);
    const int gw = blockIdx.x * NWAVES + wave, NGW = gridDim.x * NWAVES;
    unsigned char* ws = p.ws;
    constexpr int IA_IN = DIN / 32, IA_GU = NGU / 32, IA_L = IA_IN + IA_GU, IA = DEPTH * IA_L;
    LAS float* red = (LAS float*)(lds + PST_OFF);
    for (int it = blockIdx.x; it < IA; it += gridDim.x) {
        const int l = it / IA_L; int r = it % IA_L;
        const float* W; int srcN, n0, dstrow0; bf16_t* WT; const float* g; const float* bv; float* c1; float* c2;
        if (r < IA_IN) { W = p.in[6] + (size_t)l * D * DIN; srcN = DIN; n0 = 32 * r; dstrow0 = 32 * r; WT = (bf16_t*)(ws + WS_WIN + l * SZ_WIN);
            g = l ? p.in[15] : nullptr; bv = l ? p.in[16] : nullptr;
            c1 = (float*)(ws + WS_C1IN) + l * DIN; c2 = (float*)(ws + WS_C2IN) + l * DIN; }
        else { r -= IA_IN; dstrow0 = 32 * r; const int pn = dstrow0 >> 8, jj = dstrow0 & 255; W = (jj < 128 ? p.in[17] : p.in[18]) + (size_t)l * D * DFF; srcN = DFF; n0 = pn * 128 + (jj & 127);
            WT = (bf16_t*)(ws + WS_WGU + l * SZ_WGU); g = p.in[4] + l * D; bv = p.in[5] + l * D; c1 = (float*)(ws + WS_C1GU) + l * NGU; c2 = (float*)(ws + WS_C2GU) + l * NGU; }
        float s1[4] = {0.f, 0.f, 0.f, 0.f}, s2[4] = {0.f, 0.f, 0.f, 0.f};
        for (int kb = 2 * wave; kb < 2 * wave + 2; ++kb) p0_tile(W, srcN, D, 64 * kb, n0, WT, dstrow0, g, bv, scr, lane, s1, s2);
#pragma unroll
        for (int j = 0; j < 4; ++j) { float a = s1[j], b = s2[j]; a += __shfl_xor(a, 1); a += __shfl_xor(a, 2); a += __shfl_xor(a, 4); b += __shfl_xor(b, 1); b += __shfl_xor(b, 2); b += __shfl_xor(b, 4);
            if ((lane & 7) == 0) { const int n = (lane >> 3) + 8 * j; red[(wave * 32 + n) * 2] = a; red[(wave * 32 + n) * 2 + 1] = b; } }
        __syncthreads();
        if (wave == 0 && lane < 32) { float a = 0.f, b = 0.f;
#pragma unroll
            for (int w8 = 0; w8 < 8; ++w8) { a += red[(w8 * 32 + lane) * 2]; b += red[(w8 * 32 + lane) * 2 + 1]; }
            c1[dstrow0 + lane] = a; c2[dstrow0 + lane] = b; }
        __syncthreads();
    }
    constexpr int IB_O = (D / 64) * (D / 32), IB_D = (DFF / 64) * (D / 32), IB_L = IB_O + IB_D, IB = DEPTH * IB_L;
    for (int it = gw; it < IB; it += NGW) {
        const int l = it / IB_L; int r = it % IB_L; float d1[4] = {0.f, 0.f, 0.f, 0.f}, d2[4] = {0.f, 0.f, 0.f, 0.f};
        if (r < IB_O) { const int kb = r / (D / 32), nb = r % (D / 32); p0_tile(p.in[14] + (size_t)l * D * D, D, D, 64 * kb, 32 * nb, (bf16_t*)(ws + WS_WOUT + l * SZ_WOUT), 32 * nb, nullptr, nullptr, scr, lane, d1, d2); }
        else { r -= IB_O; const int kb = r / (D / 32), nb = r % (D / 32); p0_tile(p.in[19] + (size_t)l * DFF * D, D, DFF, 64 * kb, 32 * nb, (bf16_t*)(ws + WS_WD + l * SZ_WD), 32 * nb, nullptr, nullptr, scr, lane, d1, d2); }
    }
    const int gt = blockIdx.x * NTHR + wave * 64 + lane, GT = gridDim.x * NTHR;
    { bf16_t* wsb = (bf16_t*)(ws + WS_WSB); const float* src = p.in[9];
      for (int i = gt; i < DEPTH * 8 * 128 * 128 / 2; i += GT) { const int e = 2 * i, jj = e & 127, ii = (e >> 7) & 127; const bool keep = (jj >> 6) <= (ii >> 6);
          const float a = keep ? src[e] : 0.f, b = keep ? src[e + 1] : 0.f; ((unsigned*)wsb)[i] = cvt_pk_bf16(a, b); }
      bf16_t* wpt = (bf16_t*)(ws + WS_WPT); const float* wp = p.in[11];
      for (int i = gt; i < DEPTH * 4 * 64 * 64; i += GT) { const int c = i & 63, e = (i >> 6) & 63, lg = i >> 12; wpt[i] = (bf16_t)(cvt_pk_bf16(wp[((size_t)lg * 64 + c) * 64 + e], 0.f) & 0xffffu); } }
    { bf16_t* xb = (bf16_t*)(ws + WS_XB); constexpr int NCH = T * D / 8, PCH = TP * D / 8;
#pragma unroll 4
      for (int i = gt; i < NCH; i += GT) { const float* s = (i < PCH) ? p.in[0] + (size_t)i * 8 : p.in[1] + (size_t)(i - PCH) * 8; float f[8]; load8f(s, f); *(u32x4*)(xb + (size_t)i * 8) = pack8(f); } }
}

struct MixArgs {
    const bf16_t* proj; bf16_t* cat; const float* vg; const float* vb; const bf16_t* wsb; const float* bsp; const bf16_t* wpt; const float* pscale; const float* convw;
    const float* st_pool; const float* st_conv; float* o_pool_p; float* o_pool_s; float* o_conv_p; float* o_conv_s; float* o_v;
};
constexpr int VT_S = 136, XS = 264, VSTAT_OFF = 8 * 64 * VT_S * 2;
static_assert(VSTAT_OFF + 8192 <= MISC_OFF && 79 * XS * 2 <= MISC_OFF, "MIX LDS map");
__device__ __forceinline__ void mix_chunk_unit(LAS unsigned char* lds, const MixArgs& A, int u, int tid_in, int wid_in, int lane_in) {
    int tid = tid_in; asm volatile("" : "+v"(tid)); const int lane = tid & 63, wid = __builtin_amdgcn_readfirstlane(tid >> 6); (void)wid_in; (void)lane_in;
    const int fr = lane & 15, fq = lane >> 4;
    const int r0 = u * 128; const bool prompt = u < 512;
    const bf16_t* proj = A.proj;
    typedef float f32x2v __attribute__((ext_vector_type(2)));
    LAS f32x2v* part = (LAS f32x2v*)(lds + VSTAT_OFF);
    const int h = wid; LAS bf16_t* vt = (LAS bf16_t*)lds + h * 64 * VT_S;
    const int j0 = 2 * lane;
    u32x4 ra[8], rb[8];
    {
      LAS unsigned char* stg = (LAS unsigned char*)vt;
      u32x4 t[16];
      const unsigned goff = ((unsigned)(r0 + (lane >> 3)) * DIN + 512u + (unsigned)(h * 64 + (lane & 7) * 8)) * 2u;
#pragma unroll
      for (int k = 0; k < 16; ++k) t[k] = *(const u32x4*)((const char*)proj + (size_t)(goff + (unsigned)(8 * k * DIN) * 2u));
#pragma unroll
      for (int k = 0; k < 16; ++k) { const int r = (lane >> 3) + 8 * k; *(LAS u32x4*)(stg + r * 128 + (((lane & 7) ^ ((r >> 1) & 7)) * 16)) = t[k]; }
      LDS_WAIT(); asm volatile("" ::: "memory");
#pragma unroll
      for (int dc = 0; dc < 8; ++dc) { ra[dc] = *(const LAS u32x4*)(stg + (2 * lane) * 128 + ((dc ^ (lane & 7)) * 16)); rb[dc] = *(const LAS u32x4*)(stg + (2 * lane + 1) * 128 + ((dc ^ (lane & 7)) * 16)); }
      LDS_WAIT(); asm volatile("" ::: "memory");
    }
    { float s0 = 0.f, q0 = 0.f, s1 = 0.f, q1 = 0.f;
#pragma unroll
      for (int dc = 0; dc < 8; ++dc) { float a[8], b[8]; unpack8(ra[dc], a); unpack8(rb[dc], b);
#pragma unroll
          for (int q = 0; q < 8; ++q) { s0 += a[q]; q0 += a[q] * a[q]; s1 += b[q]; q1 += b[q] * b[q]; } }
      part[h * 128 + j0] = (f32x2v){s0, q0}; part[h * 128 + j0 + 1] = (f32x2v){s1, q1}; }
    __syncthreads();
    float mu0, rs0, mu1, rs1;
    { float s0 = 0.f, q0 = 0.f, s1 = 0.f, q1 = 0.f;
#pragma unroll
      for (int hh = 0; hh < 8; ++hh) { const f32x2v a = part[hh * 128 + j0], b = part[hh * 128 + j0 + 1]; s0 += a[0]; q0 += a[1]; s1 += b[0]; q1 += b[1]; }
      mu0 = s0 * (1.f / 512.f); rs0 = rsqrtf(fmaxf(q0 * (1.f / 512.f) - mu0 * mu0, 0.f) + pg8::LN_EPS);
      mu1 = s1 * (1.f / 512.f); rs1 = rsqrtf(fmaxf(q1 * (1.f / 512.f) - mu1 * mu1, 0.f) + pg8::LN_EPS); }
#pragma unroll
    for (int dc = 0; dc < 8; ++dc) { float a[8], b[8], gv[8], bv[8]; unpack8(ra[dc], a); unpack8(rb[dc], b);
        load8f(A.vg + h * 64 + dc * 8, gv); load8f(A.vb + h * 64 + dc * 8, bv);
#pragma unroll
        for (int q = 0; q < 8; ++q) { a[q] = (a[q] - mu0) * rs0 * gv[q] + bv[q]; b[q] = (b[q] - mu1) * rs1 * gv[q] + bv[q]; }
        if (!prompt) { float* o = A.o_v + (size_t)(r0 - TP + j0) * 512 + h * 64 + dc * 8;
            *(f32x4*)o = (f32x4){a[0], a[1], a[2], a[3]}; *(f32x4*)(o + 4) = (f32x4){a[4], a[5], a[6], a[7]}; *(f32x4*)(o + 512) = (f32x4){b[0], b[1], b[2], b[3]}; *(f32x4*)(o + 516) = (f32x4){b[4], b[5], b[6], b[7]}; }
#pragma unroll
        for (int q = 0; q < 8; ++q) *(LAS unsigned*)(vt + (dc * 8 + q) * VT_S + j0) = cvt_pk_bf16(a[q], b[q]); }
    LDS_WAIT(); asm volatile("" ::: "memory");
#pragma unroll 1
    for (int ob = 0; ob < 2; ++ob) {
        const int wsr0 = prompt ? ob * 64 : 0, vr0 = prompt ? 0 : ob * 64, nk = (prompt && ob) ? 4 : 2;
        u32x2 uw[4][4];
#pragma unroll
        for (int it = 0; it < 4; ++it)
#pragma unroll
            for (int dt = 0; dt < 4; ++dt) uw[it][dt] = *(const u32x2*)(proj + ((size_t)r0 + ob * 64 + it * 16 + fr) * DIN + h * 64 + dt * 16 + fq * 4);
#pragma unroll
        for (int it = 0; it < 4; ++it) {
            const int wrow = wsr0 + it * 16 + fr; const size_t row = (size_t)r0 + ob * 64 + it * 16 + fr;
            const float bs = A.bsp[h * 128 + wrow];
            bf16x8 wf[4];
#pragma unroll
            for (int ks = 0; ks < 4; ++ks) if (ks < nk) wf[ks] = *(const bf16x8*)(A.wsb + ((size_t)h * 128 + wrow) * 128 + ks * 32 + fq * 8);
            f32x4 acc[4];
#pragma unroll
            for (int b = 0; b < 4; ++b) acc[b] = (f32x4){0.f, 0.f, 0.f, 0.f};
#pragma unroll
            for (int ks = 0; ks < 4; ++ks) if (ks < nk) { bf16x8 vf[4];
#pragma unroll
                for (int dt = 0; dt < 4; ++dt) vf[dt] = *(const LAS bf16x8*)(vt + (dt * 16 + fr) * VT_S + vr0 + ks * 32 + fq * 8);
#pragma unroll
                for (int dt = 0; dt < 4; ++dt) acc[dt] = __builtin_amdgcn_mfma_f32_16x16x32_bf16(vf[dt], wf[ks], acc[dt], 0, 0, 0); }
#pragma unroll
            for (int dt = 0; dt < 4; ++dt) { const int d = h * 64 + dt * 16 + fq * 4; float uu[4]; unpack4(uw[it][dt], uu);
                u32x2 o; o.x = cvt_pk_bf16(uu[0] * (acc[dt][0] + bs), uu[1] * (acc[dt][1] + bs)); o.y = cvt_pk_bf16(uu[2] * (acc[dt][2] + bs), uu[3] * (acc[dt][3] + bs));
                *(u32x2*)(A.cat + row * D + d) = o; }
        }
    }
    __syncthreads();
}
__device__ __forceinline__ void mix_pool_conv_block(LAS unsigned char* lds, const MixArgs& A, int blk, int tid_in, int wid_in, int lane_in) {
    int tid = tid_in; asm volatile("" : "+v"(tid)); const int lane = tid & 63, wid = __builtin_amdgcn_readfirstlane(tid >> 6); (void)wid_in; (void)lane_in;
    const int fr = lane & 15, fq = lane >> 4;
    const int r0 = blk * 64; const bool prompt = blk < 1024; const int bi = blk & 127, sb = blk - 1024;
    const int t0 = prompt ? bi * 64 : 0;
    const bf16_t* proj = A.proj;
    LAS bf16_t* xt = (LAS bf16_t*)lds;
    const int g = wid >> 1, half = wid & 1, w = 2 << g;
    bf16x8 wf[2][4];
#pragma unroll
    for (int ks = 0; ks < 2; ++ks)
#pragma unroll
        for (int et = 0; et < 4; ++et) wf[ks][et] = *(const bf16x8*)(A.wpt + ((size_t)g * 64 + et * 16 + fr) * 64 + ks * 32 + fq * 8);
    u32x4 tw[5];
#pragma unroll
    for (int i = 0; i < 5; ++i) { const int idx = tid + i * NTHR, tr = idx >> 5, cc = idx & 31; u32x4 wv = (u32x4){0u, 0u, 0u, 0u};
        if (idx < 79 * 32) {
            if (tr >= 15 || (prompt && bi != 0)) wv = *(const u32x4*)(proj + (size_t)(r0 - 15 + tr) * DIN + 1024 + cc * 8);
            else if (!prompt) { float f[8]; load8f(A.st_pool + ((size_t)sb * 15 + tr) * 256 + cc * 8, f); wv = pack8(f); } }
        tw[i] = wv; }
    const int cj = tid >> 5, cc8 = (tid & 31) * 8;
#pragma unroll 1
    for (int hb = 0; hb < 2; ++hb) {
        u32x4 cgb[2], cgc[2][3], chh[2][3];
#pragma unroll
        for (int i2 = 0; i2 < 2; ++i2) { const int j = cj + 16 * (2 * hb + i2), t = t0 + j; const bf16_t* pr = proj + ((size_t)r0 + j) * DIN;
            cgb[i2] = *(const u32x4*)(pr + 1280 + cc8);
#pragma unroll
            for (int k = 0; k < 3; ++k) { const bool ok = t >= k; const bf16_t* q = pr - (ok ? k : 0) * DIN;
                cgc[i2][k] = *(const u32x4*)(q + 1536 + cc8); chh[i2][k] = *(const u32x4*)(q + 1792 + cc8); } }
        float w0[8], w1[8], w2[8]; load8f(A.convw + cc8, w0); load8f(A.convw + 256 + cc8, w1); load8f(A.convw + 512 + cc8, w2);
#pragma unroll
        for (int i2 = 0; i2 < 2; ++i2) { const int j = cj + 16 * (2 * hb + i2), t = t0 + j; const size_t row = (size_t)r0 + j;
            float gb[8], gc[8], hh[8], z0[8], z1[8], z2[8];
            unpack8(cgb[i2], gb); unpack8(cgc[i2][0], gc); unpack8(chh[i2][0], hh);
#pragma unroll
            for (int q = 0; q < 8; ++q) z0[q] = gc[q] * hh[q];
            unpack8(cgc[i2][1], gc); unpack8(chh[i2][1], hh);
#pragma unroll
            for (int q = 0; q < 8; ++q) z1[q] = gc[q] * hh[q];
            unpack8(cgc[i2][2], gc); unpack8(chh[i2][2], hh);
#pragma unroll
            for (int q = 0; q < 8; ++q) z2[q] = gc[q] * hh[q];
            if (t < 2) {
                if (t < 1) { if (!prompt) load8f(A.st_conv + ((size_t)sb * 2 + 1) * 256 + cc8, z1); else {
#pragma unroll
                        for (int q = 0; q < 8; ++q) z1[q] = 0.f; } }
                if (!prompt) load8f(A.st_conv + ((size_t)sb * 2 + t) * 256 + cc8, z2); else {
#pragma unroll
                    for (int q = 0; q < 8; ++q) z2[q] = 0.f; } }
            float o[8];
#pragma unroll
            for (int q = 0; q < 8; ++q) o[q] = gb[q] * (w0[q] * z2[q] + w1[q] * z1[q] + w2[q] * z0[q]);
            *(u32x4*)(A.cat + row * D + 768 + cc8) = pack8(o);
            const int tl = prompt ? 8190 : 62;
            if (t >= tl) { float* o2 = (prompt ? A.o_conv_p + ((size_t)(blk >> 7) * 2 + (t - tl)) * 256 : A.o_conv_s + ((size_t)sb * 2 + (t - tl)) * 256) + cc8;
                *(f32x4*)o2 = (f32x4){z0[0], z0[1], z0[2], z0[3]}; *(f32x4*)(o2 + 4) = (f32x4){z0[4], z0[5], z0[6], z0[7]}; } }
    }
#pragma unroll
    for (int i = 0; i < 5; ++i) { const int idx = tid + i * NTHR, tr = idx >> 5, cc = idx & 31; if (idx < 79 * 32) *(LAS u32x4*)(xt + tr * XS + cc * 8) = tw[i]; }
    __syncthreads();
#pragma unroll 1
    for (int tt = 0; tt < 2; ++tt) {
        f32x4 acc[4];
#pragma unroll
        for (int b = 0; b < 4; ++b) acc[b] = (f32x4){0.f, 0.f, 0.f, 0.f};
        const int j = half * 32 + tt * 16 + fr, ti = 15 + j;
        const int pos = t0 + j; const float cnt = prompt ? (float)min(pos + 1, w) : (float)w; const float inv = 1.f / cnt;
#pragma unroll
        for (int ks = 0; ks < 2; ++ks) { const int c = g * 64 + ks * 32 + fq * 8;
            float sum[8] = {0.f, 0.f, 0.f, 0.f, 0.f, 0.f, 0.f, 0.f}, x0[8];
#pragma unroll 2
            for (int k = 0; k < w; ++k) { float x[8]; unpack8(*(const LAS u32x4*)(xt + (ti - k) * XS + c), x);
#pragma unroll
                for (int q = 0; q < 8; ++q) sum[q] += x[q]; }
            unpack8(*(const LAS u32x4*)(xt + ti * XS + c), x0);
            float df[8];
#pragma unroll
            for (int q = 0; q < 8; ++q) df[q] = sum[q] * inv - x0[q];
            const u32x4 dw = pack8(df); bf16x8 dfr; __builtin_memcpy(&dfr, &dw, 16);
#pragma unroll
            for (int et = 0; et < 4; ++et) acc[et] = __builtin_amdgcn_mfma_f32_16x16x32_bf16(wf[ks][et], dfr, acc[et], 0, 0, 0); }
        const size_t row = (size_t)r0 + j;
#pragma unroll
        for (int et = 0; et < 4; ++et) { const int e = g * 64 + et * 16 + fq * 4; const f32x4 sc = *(const f32x4*)(A.pscale + e);
            u32x2 o; o.x = cvt_pk_bf16(acc[et][0] * sc[0], acc[et][1] * sc[1]); o.y = cvt_pk_bf16(acc[et][2] * sc[2], acc[et][3] * sc[3]);
            *(u32x2*)(A.cat + row * D + 512 + e) = o; } }
    if (!prompt || bi == 127) { float* dst = prompt ? A.o_pool_p + (size_t)(blk >> 7) * 15 * 256 : A.o_pool_s + (size_t)sb * 15 * 256;
        for (int idx = tid; idx < 15 * 256; idx += NTHR) { const int i = idx >> 8, c = idx & 255; dst[i * 256 + c] = bf2f(xt[(15 + 49 + i) * XS + c]); } }
    __syncthreads();
}
__device__ __forceinline__ void mix_phase(LAS unsigned char* lds, const MixArgs& A, int tid, int wid, int lane) {
    const int c = blockIdx.x, G = gridDim.x;
    constexpr int NA = T / 128, NB = T / 64;
    const int nA = (NA + G - 1) / G, nB = (NB + G - 1) / G;
#pragma unroll 1
    for (int i = 0; i < nA + nB; ++i) {
        int type = -1, idx = 0;
        if (G == 256) {
            if (i < 2) { type = 0; idx = c + 256 * i; }
            else if (c < 16) { if (i == 2) { type = 0; idx = 512 + c; } else if (i < 5) { type = 1; idx = 2 * c + (i - 3); } }
            else { const int j = c - 16; if (i < 6) { type = 1; idx = 32 + j + 240 * (i - 2); } else if (i == 6 && j < 64) { type = 1; idx = 992 + j; } }
        } else {
            if (i < nA) { idx = c + G * i; type = idx < NA ? 0 : -1; } else { idx = c + G * (i - nA); type = idx < NB ? 1 : -1; }
        }
        type = __builtin_amdgcn_readfirstlane(type); idx = __builtin_amdgcn_readfirstlane(idx);
#ifndef REP_MIXA
#define REP_MIXA 1
#endif
#ifndef REP_MIXB
#define REP_MIXB 1
#endif
        if (type == 0) { for (int r = 0; r < REP_MIXA; ++r) mix_chunk_unit(lds, A, idx, tid, wid, lane); }
        else if (type == 1) { for (int r = 0; r < REP_MIXB; ++r) mix_pool_conv_block(lds, A, idx, tid, wid, lane); }
    }
}

__device__ __forceinline__ void finalize_stats(const float* part, float* fin, int nrows) {
    typedef float f32x2v __attribute__((ext_vector_type(2)));
    for (int row = blockIdx.x * NTHR + threadIdx.x; row < nrows; row += gridDim.x * NTHR) {
        const f32x4 a = *(const f32x4*)(part + (size_t)row * 8), b = *(const f32x4*)(part + (size_t)row * 8 + 4);
        const float S = (a[0] + a[2]) + (b[0] + b[2]), Q = (a[1] + a[3]) + (b[1] + b[3]);
        const float mu = S * (1.f / 1024.f), var = fmaxf(Q * (1.f / 1024.f) - mu * mu, 0.f);
        *(f32x2v*)(fin + (size_t)row * 2) = (f32x2v){mu, rsqrtf(var + pg8::LN_EPS)};
    }
}
__device__ __forceinline__ bool split_on(int G) { return pg8::split_ok(T, TP, D, G); }
__device__ __forceinline__ void finalize_sample(const float* part, const bf16_t* R, const float* stats_in, const float* g, const float* b, bf16_t* O, float* fin) {
    typedef float f32x2v __attribute__((ext_vector_type(2)));
    int tid_ = threadIdx.x; asm volatile("" : "+v"(tid_)); const int lane = tid_ & 63, wave = __builtin_amdgcn_readfirstlane(tid_ >> 6);
    for (int lr = blockIdx.x * NWAVES + wave; lr < TS; lr += gridDim.x * NWAVES) {
        const size_t row = (size_t)TP + lr; float mu = 0.f, rs = 1.f; if (stats_in) pg8::row_stats(stats_in, (int)row, mu, rs);
        float v[2][8], s = 0.f, q = 0.f;
#pragma unroll
        for (int hh = 0; hh < 2; ++hh) { const int c = hh * 512 + lane * 8; float r[8], gg[8], bb[8]; unpack8(*(const u32x4*)(R + row * D + c), r);
            if (stats_in) { load8f(g + c, gg); load8f(b + c, bb); }
#pragma unroll
            for (int k = 0; k < 8; ++k) v[hh][k] = pg8::ALPHA * (stats_in ? (r[k] - mu) * rs * gg[k] + bb[k] : r[k]);
#pragma unroll
            for (int sp = 0; sp < pg8::NSPLIT; ++sp) { float p8[8]; load8f(part + ((size_t)sp * TS + lr) * D + c, p8);
#pragma unroll
                for (int k = 0; k < 8; ++k) v[hh][k] += p8[k]; }
#pragma unroll
            for (int k = 0; k < 8; ++k) { s += v[hh][k]; q += v[hh][k] * v[hh][k]; }
            *(u32x4*)(O + row * D + c) = pack8(v[hh]); }
        s = wave_sum(s); q = wave_sum(q);
        const float m2 = s * (1.f / 1024.f), var = fmaxf(q * (1.f / 1024.f) - m2 * m2, 0.f);
        if (lane == 0) *(f32x2v*)(fin + row * 2) = (f32x2v){m2, rsqrtf(var + pg8::LN_EPS)};
    }
}
typedef const __attribute__((address_space(4))) Params* ParamsPtr;
#define GETP() ParamsPtr pp; { auto kp_ = __builtin_amdgcn_kernarg_segment_ptr(); asm volatile("" : "+s"(kp_)); pp = (ParamsPtr)kp_; } unsigned char* ws = pp->ws; int l = lc; asm volatile("" : "+s"(l));
__global__ void __launch_bounds__(NTHR, 2) fwd_megakernel(Params p_unused) {
    extern __shared__ __attribute__((aligned(16))) unsigned char lds_raw[];
    LAS unsigned char* lds = (LAS unsigned char*)lds_raw;
    cg::grid_group grid = cg::this_grid();
    const int tid = threadIdx.x;
    if (gridDim.x == 0x7fffffffu) grid.sync();
    volatile LAS unsigned* MISC = (volatile LAS unsigned*)(lds + MISC_OFF);
    if (tid < 16) MISC[tid] = 0u;
    __syncthreads();
    { auto kp0 = __builtin_amdgcn_kernarg_segment_ptr(); (void)xcd_barrier_post((unsigned*)(((ParamsPtr)kp0)->ws + WS_BAR), MISC); }
#define GRIDBAR() do { auto kpb_ = __builtin_amdgcn_kernarg_segment_ptr(); asm volatile("" : "+s"(kpb_)); XcdBarrier xb_; xb_.bar = (unsigned*)(((ParamsPtr)kpb_)->ws + WS_BAR); xb_.x = xb_xcc_id(); \
        xb_.st = (volatile LAS unsigned*)((LAS unsigned char*)lds_raw + MISC_OFF); xcd_barrier(xb_); } while (0)
#ifndef NO_P0
    for (int rep = 0; rep < REP_P0; ++rep) { const int lc = 0; GETP(); (void)l; (void)ws; Params p; for (int i = 0; i < 20; ++i) p.in[i] = pp->in[i]; p.out = pp->out; p.ws = pp->ws;
      int tid0 = threadIdx.x; asm volatile("" : "+v"(tid0)); p0_phase(p, lds, __builtin_amdgcn_readfirstlane(tid0 >> 6), tid0 & 63); }
#endif
    GRIDBAR();

    for (int lc = 0; lc < DEPTH; ++lc) {
#ifndef NO_G1
        for (int rep = 0; rep < REP_G1; ++rep) { GETP(); const int G = gridDim.x;
          pg8::Gemm g{(const bf16_t*)(ws + (l ? WS_P2 : WS_XB)), (const bf16_t*)(ws + WS_WIN + l * SZ_WIN), T, DIN, D}; pg8::StaticOrder S; S.init(T, DIN, D, G, (int)blockIdx.x);
          pg8::EpiProj E{(bf16_t*)(ws + WS_PROJ), DIN, l ? (const float*)(ws + WS_ST2) : nullptr, (const float*)(ws + WS_C1IN) + l * DIN, (const float*)(ws + WS_C2IN) + l * DIN};
          pg8::gemm_phase<pg8::EpiProj, pg8::StaticOrder, true, true>(lds, g, S, E); }
#endif
        GRIDBAR();
#ifndef NO_MIX
        for (int rep = 0; rep < REP_MIX; ++rep) { GETP(); const int G = gridDim.x; float* out = pp->out;
          MixArgs A; A.proj = (const bf16_t*)(ws + WS_PROJ); A.cat = (bf16_t*)(ws + WS_CAT); A.vg = pp->in[7] + l * 512; A.vb = pp->in[8] + l * 512; A.wsb = (const bf16_t*)(ws + WS_WSB + l * SZ_WSB); A.bsp = pp->in[10] + l * 8 * 128;
          A.wpt = (const bf16_t*)(ws + WS_WPT + l * SZ_WPT); A.pscale = pp->in[12] + l * 256; A.convw = pp->in[13] + l * 3 * 256; A.st_pool = pp->in[2] + (size_t)l * 32 * 15 * 256; A.st_conv = pp->in[3] + (size_t)l * 32 * 2 * 256;
          A.o_pool_p = out + O_POOLP + (size_t)l * 8 * 15 * 256; A.o_pool_s = out + O_POOLS + (size_t)l * 32 * 15 * 256; A.o_conv_p = out + O_CONVP + (size_t)l * 8 * 2 * 256; A.o_conv_s = out + O_CONVS + (size_t)l * 32 * 2 * 256;
          A.o_v = out + O_V + (size_t)l * 32 * 64 * 512;
          int tid2 = threadIdx.x; asm volatile("" : "+v"(tid2)); const int lane2 = tid2 & 63, wid2 = __builtin_amdgcn_readfirstlane(tid2 >> 6);
          (void)G; mix_phase(lds, A, tid2, wid2, lane2); }
#endif
        GRIDBAR();
#ifndef NO_G2
        for (int rep = 0; rep < REP_G2; ++rep) { GETP(); const int G = gridDim.x;
          pg8::Gemm g{(const bf16_t*)(ws + WS_CAT), (const bf16_t*)(ws + WS_WOUT + l * SZ_WOUT), T, D, D}; const bool sp = split_on(G); pg8::StaticOrder S; S.init(sp ? TP : T, D, D, G, (int)blockIdx.x, WGM_G2);
          pg8::EpiRes E{(bf16_t*)(ws + WS_P1), (const bf16_t*)(ws + (l ? WS_P2 : WS_XB)), l ? (const float*)(ws + WS_ST2) : nullptr, pp->in[15] + (l - 1) * D, pp->in[16] + (l - 1) * D, (float*)(ws + WS_ST1P), (LAS float*)(lds + PST_OFF)};
          pg8::gemm_phase<pg8::EpiRes, pg8::StaticOrder, true, true>(lds, g, S, E);
          if (sp) { pg8::TailSplitOrder S2; S2.init(TP, D, D, (int)blockIdx.x); pg8::EpiPart E2{(float*)(ws + WS_PART), TP, TS}; pg8::gemm_phase<pg8::EpiPart, pg8::TailSplitOrder, true, true>(lds, g, S2, E2); } }
#endif
        GRIDBAR();
        { GETP(); const bool sp = split_on((int)gridDim.x); finalize_stats((const float*)(ws + WS_ST1P), (float*)(ws + WS_ST1), sp ? TP : T);
          if (sp) finalize_sample((const float*)(ws + WS_PART), (const bf16_t*)(ws + (l ? WS_P2 : WS_XB)), l ? (const float*)(ws + WS_ST2) : nullptr, pp->in[15] + (l - 1) * D, pp->in[16] + (l - 1) * D, (bf16_t*)(ws + WS_P1), (float*)(ws + WS_ST1)); }
        GRIDBAR();
#ifndef NO_G3
        for (int rep = 0; rep < REP_G3; ++rep) { GETP(); const int G = gridDim.x;
          pg8::Gemm g{(const bf16_t*)(ws + WS_P1), (const bf16_t*)(ws + WS_WGU + l * SZ_WGU), T, NGU, D}; pg8::StaticOrder S; S.init(T, NGU, D, G, (int)blockIdx.x);
          pg8::EpiSwiGLU E{(bf16_t*)(ws + WS_HID), DFF, (const float*)(ws + WS_ST1), (const float*)(ws + WS_C1GU) + l * NGU, (const float*)(ws + WS_C2GU) + l * NGU};
          pg8::gemm_phase<pg8::EpiSwiGLU, pg8::StaticOrder, true, true>(lds, g, S, E); }
#endif
        GRIDBAR();
#ifndef NO_G4
        for (int rep = 0; rep < REP_G4; ++rep) { GETP(); const int G = gridDim.x;
          pg8::Gemm g{(const bf16_t*)(ws + WS_HID), (const bf16_t*)(ws + WS_WD + l * SZ_WD), T, D, DFF}; const bool sp = split_on(G); pg8::StaticOrder S; S.init(sp ? TP : T, D, DFF, G, (int)blockIdx.x, WGM_G4);
          pg8::EpiRes E{(bf16_t*)(ws + WS_P2), (const bf16_t*)(ws + WS_P1), (const float*)(ws + WS_ST1), pp->in[4] + l * D, pp->in[5] + l * D, (float*)(ws + WS_ST2P), (LAS float*)(lds + PST_OFF)};
          pg8::gemm_phase<pg8::EpiRes, pg8::StaticOrder, true, true>(lds, g, S, E);
          if (sp) { pg8::TailSplitOrder S2; S2.init(TP, D, DFF, (int)blockIdx.x); pg8::EpiPart E2{(float*)(ws + WS_PART), TP, TS}; pg8::gemm_phase<pg8::EpiPart, pg8::TailSplitOrder, true, true>(lds, g, S2, E2); } }
#endif
        GRIDBAR();
        { GETP(); const bool sp = split_on((int)gridDim.x); finalize_stats((const float*)(ws + WS_ST2P), (float*)(ws + WS_ST2), sp ? TP : T);
          if (sp) finalize_sample((const float*)(ws + WS_PART), (const bf16_t*)(ws + WS_P1), (const float*)(ws + WS_ST1), pp->in[4] + l * D, pp->in[5] + l * D, (bf16_t*)(ws + WS_P2), (float*)(ws + WS_ST2)); }
        GRIDBAR();
        for (int rep = 1; rep < REP_SYNC; ++rep) GRIDBAR();
    }
    for (int rep = 0; rep < REP_FIN; ++rep) { const int lc = DEPTH - 1; GETP(); const int G = gridDim.x; float* out = pp->out;
      const float* gF = pp->in[15] + l * D; const float* bF = pp->in[16] + l * D; const bf16_t* P2 = (const bf16_t*)(ws + WS_P2); const float* ST2 = (const float*)(ws + WS_ST2);
      int tidf = threadIdx.x; asm volatile("" : "+v"(tidf)); const int lane = tidf & 63, wid = __builtin_amdgcn_readfirstlane(tidf >> 6);
      const int gw = blockIdx.x * NWAVES + wid, NGW = G * NWAVES;
      float gv[2][8], bv[2][8]; load8f(gF + lane * 8, gv[0]); load8f(gF + 512 + lane * 8, gv[1]); load8f(bF + lane * 8, bv[0]); load8f(bF + 512 + lane * 8, bv[1]);
#pragma unroll 2
      for (int row = gw; row < T; row += NGW) { float mu, rs; pg8::row_stats(ST2, row, mu, rs);
#pragma unroll
          for (int hh = 0; hh < 2; ++hh) { float f[8]; unpack8(*(const u32x4*)(P2 + (size_t)row * D + hh * 512 + lane * 8), f); float* o = out + (size_t)row * D + hh * 512 + lane * 8;
#pragma unroll
              for (int q = 0; q < 8; ++q) f[q] = (f[q] - mu) * rs * gv[hh][q] + bv[hh][q];
              *(f32x4*)o = (f32x4){f[0], f[1], f[2], f[3]}; *(f32x4*)(o + 4) = (f32x4){f[4], f[5], f[6], f[7]}; } } }
}

extern "C" void kernel_launch(void* const* d_in, const int* in_sizes, int n_in, void* d_out, int out_size, void* d_ws, size_t ws_size, hipStream_t stream) {
    static int grid = 0;
    if (grid == 0) {
        if (n_in != 20 || (size_t)out_size != O_END || ws_size < WS_END) { fprintf(stderr, "kernel_launch: unexpected sizes n_in %d out %d (want %zu) ws %zu (want %zu)\n", n_in, out_size, (size_t)O_END, ws_size, (size_t)WS_END); grid = -1; return; }
        int dev = 0, cus = 0, per_cu = 0;
        if (hipGetDevice(&dev) != hipSuccess || hipDeviceGetAttribute(&cus, hipDeviceAttributeMultiprocessorCount, dev) != hipSuccess) { grid = -1; return; }
        if (hipFuncSetAttribute((const void*)fwd_megakernel, hipFuncAttributeMaxDynamicSharedMemorySize, LDS_BYTES) != hipSuccess) { fprintf(stderr, "kernel_launch: hipFuncSetAttribute failed\n"); grid = -1; return; }
        if (hipOccupancyMaxActiveBlocksPerMultiprocessor(&per_cu, (const void*)fwd_megakernel, NTHR, LDS_BYTES) != hipSuccess || per_cu < 1) { fprintf(stderr, "kernel_launch: occupancy query reports %d\n", per_cu); (void)hipGetLastError(); per_cu = 1; }
        grid = cus;
    }
    if (grid < 0) return;
    if (hipMemsetAsync((char*)d_ws + WS_BAR, 0, BAR_BYTES, stream) != hipSuccess) { fprintf(stderr, "kernel_launch: memset of the barrier words failed\n"); return; }
    Params p{};
    for (int i = 0; i < 20; ++i) p.in[i] = (const float*)d_in[i];
    p.out = (float*)d_out; p.ws = (unsigned char*)d_ws;
    void* args[] = {&p};
    const hipError_t e = hipLaunchCooperativeKernel((const void*)fwd_megakernel, dim3(grid), dim3(NTHR), args, LDS_BYTES, stream);
    if (e != hipSuccess) fprintf(stderr, "kernel_launch: cooperative launch failed: %s (grid %d)\n", hipGetErrorString(e), grid);
}
```

```cpp
#include <hip/hip_runtime.h>
#include <hip/hip_cooperative_groups.h>
#include <cstdio>
#include <cstdint>
namespace cg = cooperative_groups;
#define WGM_G2 8
#define WGM_G4 8
namespace pg8 {
#define PG8_LAS __attribute__((address_space(3)))
typedef unsigned short bf16_t;
typedef short bf16x8 __attribute__((ext_vector_type(8)));
typedef float f32x4 __attribute__((ext_vector_type(4)));
typedef unsigned u32x4 __attribute__((ext_vector_type(4)));
typedef int i32x4 __attribute__((ext_vector_type(4)));
typedef int i32x8 __attribute__((ext_vector_type(8)));
constexpr int BM = 256, BK = 64, HALF = 128, HTB = HALF * BK * 2  , STAGE_BYTES = 8 * HTB, NXCD = 8, WGM = 6;

__host__ __device__ __forceinline__ int lds_byte(int r, int c) { const int st = (r >> 4) * 2 + (c >> 5), rr = r & 15, cc = c & 31, ob = rr * 64 + cc * 2; return st * 1024 + (ob ^ (((ob >> 9) & 1) << 5)); }
__host__ __device__ __forceinline__ void stage_rc(int b, int& R, int& C) { const int st = b / 1024, sb = b % 1024, swz = sb ^ (((sb >> 9) & 1) << 5); R = (st >> 1) * 16 + swz / 64; C = (st & 1) * 32 + (swz % 64) / 2; }
__host__ __device__ __forceinline__ int perm32(int rho) { const int n = rho >> 4, i = rho & 15; return 8 * (i >> 2) + 4 * n + (i & 3); }

struct Unit { int pm, pn, k0, nt, split; };
struct Gemm { const bf16_t* A; const bf16_t* Bt; int M, N, K; };

struct StaticOrder {
    int nM, nN, nwg, G, c, ntf, wgm;
    __host__ __device__ void init(int M, int N, int K, int G_, int c_, int wgm_ = WGM) { nM = M / BM; nN = N / BM; nwg = nM * nN; G = G_; c = c_; ntf = K / BK; wgm = wgm_; }
    __host__ __device__ bool next(int i, Unit& u) const {
        const long L = (long)i * G + c; if (L >= nwg) return false;
        int wgid = (int)L; { const int q = nwg / NXCD, r = nwg % NXCD, xcd = wgid % NXCD, off = wgid / NXCD; wgid = (xcd < r ? xcd * (q + 1) : r * (q + 1) + (xcd - r) * q) + off; }
        const int nig = wgm * nN, gid = wgid / nig, fm = gid * wgm, gsz = (nM - fm) < wgm ? (nM - fm) : wgm;
        u.pm = fm + ((wgid % nig) % gsz); u.pn = (wgid % nig) / gsz; u.k0 = 0; u.nt = ntf; u.split = -1; return true;
    }
    __device__ __forceinline__ void a_ready(const Unit&) const {}
    __device__ __forceinline__ void done(const Unit&) const {}
};
constexpr int NSPLIT = 4;
__host__ __device__ __forceinline__ bool split_ok(int Mfull, int Mprompt, int N, int G) { const int nN = N / BM; return (G >= 8 * nN * NSPLIT) && ((Mprompt / BM * nN) % G == 0) && ((Mfull - Mprompt) / BM == 8); }
struct TailSplitOrder {
    int pm0, nN, c, q, rem;
    __host__ __device__ void init(int Mprompt, int N, int K, int c_) { nN = N / BM; pm0 = Mprompt / BM; c = c_; const int ntf = K / BK; q = (ntf / NSPLIT) & ~1; rem = ntf - q * NSPLIT; }
    __host__ __device__ bool next(int i, Unit& u) const {
        if (i > 0 || c >= 8 * nN * NSPLIT) return false;
        const int tu = c % (8 * nN), s = c / (8 * nN), first_big = NSPLIT - rem / 2;
        u.pm = pm0 + tu / nN; u.pn = tu % nN; u.k0 = s * q + (s > first_big ? 2 * (s - first_big) : 0); u.nt = q + (s >= first_big ? 2 : 0); u.split = s; return true;
    }
    __device__ __forceinline__ void a_ready(const Unit&) const {}
    __device__ __forceinline__ void done(const Unit&) const {}
};
__device__ __forceinline__ unsigned cvt_pk_bf16(float lo, float hi) { unsigned r; asm volatile("v_cvt_pk_bf16_f32 %0, %1, %2" : "=v"(r) : "v"(lo), "v"(hi)); return r; }
constexpr float LN_EPS = 1e-5f;
constexpr float ALPHA = 1.41421356237309515f;
typedef unsigned u32x2 __attribute__((ext_vector_type(2)));
__device__ __forceinline__ void unpack8(const u32x4 w, float (&f)[8]) {
    f[0] = __uint_as_float(w.x << 16); f[1] = __uint_as_float(w.x & 0xffff0000u); f[2] = __uint_as_float(w.y << 16); f[3] = __uint_as_float(w.y & 0xffff0000u);
    f[4] = __uint_as_float(w.z << 16); f[5] = __uint_as_float(w.z & 0xffff0000u); f[6] = __uint_as_float(w.w << 16); f[7] = __uint_as_float(w.w & 0xffff0000u);
}
__device__ __forceinline__ void unpack4(const u32x2 w, float (&f)[4]) {
    f[0] = __uint_as_float(w.x << 16); f[1] = __uint_as_float(w.x & 0xffff0000u); f[2] = __uint_as_float(w.y << 16); f[3] = __uint_as_float(w.y & 0xffff0000u);
}
__device__ __forceinline__ u32x4 pack8(const float (&f)[8]) { u32x4 w; w.x = cvt_pk_bf16(f[0], f[1]); w.y = cvt_pk_bf16(f[2], f[3]); w.z = cvt_pk_bf16(f[4], f[5]); w.w = cvt_pk_bf16(f[6], f[7]); return w; }
__device__ __forceinline__ void row_stats(const float* st, int row, float& mu, float& rstd) {
    typedef float f32x2v __attribute__((ext_vector_type(2)));
    const f32x2v a = *(const f32x2v*)(st + (size_t)row * 2); mu = a[0]; rstd = a[1];
}
__device__ __forceinline__ void load8f(const float* p, float (&f)[8]) { const f32x4 a = *(const f32x4*)p, b = *(const f32x4*)(p + 4); f[0] = a[0]; f[1] = a[1]; f[2] = a[2]; f[3] = a[3]; f[4] = b[0]; f[5] = b[1]; f[6] = b[2]; f[7] = b[3]; }

struct EpiProj {
    static constexpr bool PERM = true, AFTER_DRAIN = false;
    bf16_t* O; int ldo; const float* stats; const float* c1; const float* c2;
    __device__ __forceinline__ void operator()(f32x4 (&acc)[2][2][4][2], const Unit& u, int wr, int wc, int fr, int fq) const {
        const int row0 = u.pm * BM + wr * 64 + fr, col0 = u.pn * BM + wc * 32 + 8 * fq;
        const bool ln = stats != nullptr;
        float rs8[8], nm8[8];
#pragma unroll
        for (int i = 0; i < 8; ++i) { float mu = 0.f; rs8[i] = 1.f; if (ln) row_stats(stats, row0 + (i >> 2) * HALF + (i & 3) * 16, mu, rs8[i]); nm8[i] = -rs8[i] * mu; }
#pragma unroll
        for (int bj = 0; bj < 2; ++bj) {
            float k1[8], k2[8];
            if (ln) { load8f(c1 + col0 + bj * HALF, k1); load8f(c2 + col0 + bj * HALF, k2); }
            else {
#pragma unroll
                for (int q = 0; q < 8; ++q) { k1[q] = 0.f; k2[q] = 0.f; } }
#pragma unroll
            for (int ai = 0; ai < 2; ++ai)
#pragma unroll
                for (int m = 0; m < 4; ++m) {
                    const float rs = rs8[ai * 4 + m], nm = nm8[ai * 4 + m];
#pragma unroll
                    for (int q = 0; q < 4; ++q) { acc[ai][bj][m][0][q] = rs * acc[ai][bj][m][0][q] + (nm * k1[q] + k2[q]); acc[ai][bj][m][1][q] = rs * acc[ai][bj][m][1][q] + (nm * k1[4 + q] + k2[4 + q]); }
                }
        }
        asm volatile("" ::: "memory");
#pragma unroll
        for (int ai = 0; ai < 2; ++ai)
#pragma unroll
            for (int m = 0; m < 4; ++m) {
                const int row = row0 + ai * HALF + m * 16;
#pragma unroll
                for (int bj = 0; bj < 2; ++bj) { u32x4 w; w.x = cvt_pk_bf16(acc[ai][bj][m][0][0], acc[ai][bj][m][0][1]); w.y = cvt_pk_bf16(acc[ai][bj][m][0][2], acc[ai][bj][m][0][3]);
                    w.z = cvt_pk_bf16(acc[ai][bj][m][1][0], acc[ai][bj][m][1][1]); w.w = cvt_pk_bf16(acc[ai][bj][m][1][2], acc[ai][bj][m][1][3]);
                    *(u32x4*)(O + (size_t)row * ldo + col0 + bj * HALF) = w; }
            }
    }
};
template <bool F8OUT> struct EpiSwiGLU {
    static constexpr bool PERM = true, AFTER_DRAIN = false;
    bf16_t* O; int ldo; const float* stats; const float* c1; const float* c2;
    __device__ __forceinline__ void operator()(f32x4 (&acc)[2][2][4][2], const Unit& u, int wr, int wc, int fr, int fq) const {
        const int row0 = u.pm * BM + wr * 64 + fr, cidx = u.pn * BM + wc * 32 + 8 * fq, ocol = u.pn * HALF + wc * 32 + 8 * fq;
        float rs8[8], nm8[8];
#pragma unroll
        for (int i = 0; i < 8; ++i) { float mu; row_stats(stats, row0 + (i >> 2) * HALF + (i & 3) * 16, mu, rs8[i]); nm8[i] = -rs8[i] * mu; }
        float k1g[8], k2g[8], k1u[8], k2u[8];
        load8f(c1 + cidx, k1g); load8f(c2 + cidx, k2g); load8f(c1 + cidx + HALF, k1u); load8f(c2 + cidx + HALF, k2u);
#pragma unroll
        for (int ai = 0; ai < 2; ++ai)
#pragma unroll
            for (int m = 0; m < 4; ++m) {
                const int row = row0 + ai * HALF + m * 16;
                const float rs = rs8[ai * 4 + m], nm = nm8[ai * 4 + m];
                float o[8];
#pragma unroll
                for (int q = 0; q < 8; ++q) {
                    const float ga = (q < 4) ? acc[ai][0][m][0][q & 3] : acc[ai][0][m][1][q & 3], ua = (q < 4) ? acc[ai][1][m][0][q & 3] : acc[ai][1][m][1][q & 3];
                    const float g = rs * ga + (nm * k1g[q] + k2g[q]), up = rs * ua + (nm * k1u[q] + k2u[q]);
                    o[q] = g * __builtin_amdgcn_rcpf(1.f + __expf(-g)) * up;
                }
                if constexpr (F8OUT) { int w0 = 0, w1 = 0; w0 = __builtin_amdgcn_cvt_pk_fp8_f32(o[0], o[1], w0, false); w0 = __builtin_amdgcn_cvt_pk_fp8_f32(o[2], o[3], w0, true);
                    w1 = __builtin_amdgcn_cvt_pk_fp8_f32(o[4], o[5], w1, false); w1 = __builtin_amdgcn_cvt_pk_fp8_f32(o[6], o[7], w1, true);
                    u32x2 w; w.x = (unsigned)w0; w.y = (unsigned)w1; *(u32x2*)((unsigned char*)O + (size_t)row * ldo + ocol) = w; }
                else *(u32x4*)(O + (size_t)row * ldo + ocol) = pack8(o);
            }
    }
};
template <int RB> struct EpiRes {
    static constexpr bool PERM = true, AFTER_DRAIN = false;
    bf16_t* O; const bf16_t* R; const float* stats_in; const float* g; const float* b; float* stats_out; PG8_LAS float* pst; float accscale;
    __device__ __forceinline__ void operator()(f32x4 (&acc)[2][2][4][2], const Unit& u, int wr, int wc, int fr, int fq) const {
        const int row0 = u.pm * BM + wr * 64 + fr, col0 = u.pn * BM + wc * 32 + 8 * fq;
        const bool ln = stats_in != nullptr;
#pragma unroll
        for (int bj = 0; bj < 2; ++bj) {
            float gg[8], bb[8];
            if (ln) { load8f(g + col0 + bj * HALF, gg); load8f(b + col0 + bj * HALF, bb); }
            else {
#pragma unroll
                for (int q = 0; q < 8; ++q) { gg[q] = 1.f; bb[q] = 0.f; } }
#pragma unroll
            for (int ai = 0; ai < 2; ++ai)
#pragma unroll
            for (int mh = 0; mh < 4; mh += RB) {
                u32x4 rw[RB];
                asm volatile("" ::: "memory");
#pragma unroll
                for (int mm = 0; mm < RB; ++mm) rw[mm] = *(const u32x4*)((const char*)R + (size_t)(((unsigned)(row0 + ai * HALF + (mh + mm) * 16) * 1024u + (unsigned)(col0 + bj * HALF)) * 2u));
                float mu4[RB], rs4[RB];
#pragma unroll
                for (int mm = 0; mm < RB; ++mm) { mu4[mm] = 0.f; rs4[mm] = 1.f; if (ln) row_stats(stats_in, row0 + ai * HALF + (mh + mm) * 16, mu4[mm], rs4[mm]); }
#pragma unroll
                for (int mm = 0; mm < RB; ++mm) { const int m = mh + mm;
                    const float mu = mu4[mm], rs = rs4[mm];
                    float r[8]; unpack8(rw[mm], r);
#pragma unroll
                    for (int n = 0; n < 2; ++n)
#pragma unroll
                        for (int q4 = 0; q4 < 4; ++q4) { const int q = n * 4 + q4;
                            const float xr = (r[q] - mu) * rs * gg[q] + bb[q];
                            const float a = ALPHA * xr + accscale * acc[ai][bj][m][n][q4];
                            acc[ai][bj][m][n][q4] = a; }
                }
                if constexpr (RB == 4) asm volatile("" : "+v"(acc[ai][bj][0][0]), "+v"(acc[ai][bj][0][1]), "+v"(acc[ai][bj][1][0]), "+v"(acc[ai][bj][1][1]), "+v"(acc[ai][bj][2][0]), "+v"(acc[ai][bj][2][1]), "+v"(acc[ai][bj][3][0]), "+v"(acc[ai][bj][3][1]) :: "memory");
                else asm volatile("" : "+v"(acc[ai][bj][mh][0]), "+v"(acc[ai][bj][mh][1]), "+v"(acc[ai][bj][mh + 1][0]), "+v"(acc[ai][bj][mh + 1][1]) :: "memory");
            }
        }
        asm volatile("" ::: "memory");
#pragma unroll
        for (int ai = 0; ai < 2; ++ai)
#pragma unroll
            for (int m = 0; m < 4; ++m) {
                const int row = row0 + ai * HALF + m * 16;
                float s = 0.f, q2 = 0.f;
#pragma unroll
                for (int bj = 0; bj < 2; ++bj) {
#pragma unroll
                    for (int n = 0; n < 2; ++n)
#pragma unroll
                        for (int q4 = 0; q4 < 4; ++q4) { const float a = acc[ai][bj][m][n][q4]; s += a; q2 += a * a; }
                    u32x4 w; w.x = cvt_pk_bf16(acc[ai][bj][m][0][0], acc[ai][bj][m][0][1]); w.y = cvt_pk_bf16(acc[ai][bj][m][0][2], acc[ai][bj][m][0][3]);
                    w.z = cvt_pk_bf16(acc[ai][bj][m][1][0], acc[ai][bj][m][1][1]); w.w = cvt_pk_bf16(acc[ai][bj][m][1][2], acc[ai][bj][m][1][3]);
                    *(u32x4*)((char*)O + (size_t)(((unsigned)row * 1024u + (unsigned)(col0 + bj * HALF)) * 2u)) = w; }
                s += __shfl_xor(s, 16); s += __shfl_xor(s, 32); q2 += __shfl_xor(q2, 16); q2 += __shfl_xor(q2, 32);
                if (fq == 0) { PG8_LAS float* p = pst + ((ai * HALF + wr * 64 + m * 16 + fr) * 4 + wc) * 2; p[0] = s; p[1] = q2; }
            }
        asm volatile("s_waitcnt lgkmcnt(0)" ::: "memory"); __builtin_amdgcn_s_barrier(); asm volatile("" ::: "memory");
        if (threadIdx.x < 256) {
            const int row = threadIdx.x; const PG8_LAS f32x4* p = (const PG8_LAS f32x4*)(pst + row * 8);
            const f32x4 a = p[0], c = p[1];
            typedef float f32x2v __attribute__((ext_vector_type(2)));
            *(f32x2v*)(stats_out + ((size_t)(u.pm * BM + row) * 4 + u.pn) * 2) = (f32x2v){(a[0] + a[2]) + (c[0] + c[2]), (a[1] + a[3]) + (c[1] + c[3])};
        }
    }
};

struct EpiPart {
    static constexpr bool PERM = true, AFTER_DRAIN = false;
    float* part; int part_row0, part_rows; float accscale;
    __device__ __forceinline__ void operator()(f32x4 (&acc)[2][2][4][2], const Unit& u, int wr, int wc, int fr, int fq) const {
        const int row0 = u.pm * BM + wr * 64 + fr, col0 = u.pn * BM + wc * 32 + 8 * fq;
        const unsigned pb = (((unsigned)u.split * (unsigned)part_rows + (unsigned)(row0 - part_row0)) * 1024u + (unsigned)col0) * 4u;
#pragma unroll
        for (int ai = 0; ai < 2; ++ai)
#pragma unroll
            for (int m = 0; m < 4; ++m)
#pragma unroll
                for (int bj = 0; bj < 2; ++bj) { float* p = (float*)((char*)part + (size_t)(pb + (unsigned)((ai * HALF + m * 16) * 1024 + bj * HALF) * 4u)); *(f32x4*)p = acc[ai][bj][m][0] * accscale; *(f32x4*)(p + 4) = acc[ai][bj][m][1] * accscale; }
    }
};

struct EpiRaw {
    static constexpr bool PERM = true, AFTER_DRAIN = false;
    __device__ __forceinline__ void prefetch(const Unit&, PG8_LAS unsigned char*, int) const {}
    bf16_t* O; int ldo; float scale;
    __device__ __forceinline__ void operator()(f32x4 (&acc)[2][2][4][2], const Unit& u, int wr, int wc, int fr, int fq) const {
        const int row0 = u.pm * BM + wr * 64 + fr, col0 = u.pn * BM + wc * 32 + 8 * fq;
#pragma unroll
        for (int ai = 0; ai < 2; ++ai)
#pragma unroll
            for (int m = 0; m < 4; ++m)
#pragma unroll
                for (int bj = 0; bj < 2; ++bj) { u32x4 w; const f32x4 a = acc[ai][bj][m][0] * scale, b = acc[ai][bj][m][1] * scale;
                    w.x = cvt_pk_bf16(a[0], a[1]); w.y = cvt_pk_bf16(a[2], a[3]); w.z = cvt_pk_bf16(b[0], b[1]); w.w = cvt_pk_bf16(b[2], b[3]);
                    *(u32x4*)((char*)O + (size_t)(((unsigned)(row0 + ai * HALF + m * 16) * (unsigned)ldo + (unsigned)(col0 + bj * HALF)) * 2u)) = w; }
    }
};
template <class Epi, class Sched, bool ALIGN_EPI = false, bool SP2 = false, bool FP8 = false>
__device__ __forceinline__ void gemm_phase(PG8_LAS unsigned char* lds, const Gemm g, const Sched& S, const Epi& E) {
    int tid_ = threadIdx.x; asm volatile("" : "+v"(tid_));
    const int tid = tid_, wid = __builtin_amdgcn_readfirstlane(tid >> 6), lane = tid & 63, wr = wid >> 2, wc = wid & 3, fr = lane & 15, fq = lane >> 4;
    const int K = g.K;
    unsigned voffA[2], voffB[2];
#pragma unroll
    for (int i = 0; i < 2; ++i) { int R, C; stage_rc(tid * 16 + i * 8192, R, C); const int Rb = Epi::PERM ? ((R & ~31) + perm32(R & 31)) : R;
        voffA[i] = (unsigned)(R * K + C) * 2u; voffB[i] = (unsigned)(Rb * K + C) * 2u; }
    const size_t kstep = (size_t)(BK * 2);
    const size_t hstep = (size_t)HALF * K * 2;
    const size_t tstep = 2 * hstep;
    const unsigned ldsw = (unsigned)wid * 1024u;
    const int aoff = lds_byte(wr * 64 + fr, fq * 8), boff = lds_byte(wc * 32 + fr, fq * 8);
#define PG8_SA(b, h) (((b) * 2 + (h)) * HTB)
#define PG8_SB(b, h) ((4 + (b) * 2 + (h)) * HTB)
#define PG8_STAGE(bufoff, gbase, voff) do { _Pragma("unroll") for (int _i = 0; _i < 2; ++_i) \
        __builtin_amdgcn_global_load_lds((const unsigned*)((const char*)(gbase) + (voff)[_i]), (PG8_LAS unsigned*)(lds + (bufoff) + ldsw + _i * 8192), 16, 0, 0); } while (0)
#define PG8_LDA(dst, b, h) do { if constexpr (FP8) { _Pragma("unroll") for (int m = 0; m < 4; ++m) { const i32x4 lo_ = *(const PG8_LAS i32x4*)(lds + PG8_SA(b, h) + aoff + m * 2048), hi_ = *(const PG8_LAS i32x4*)(lds + PG8_SA(b, h) + aoff + m * 2048 + 1024); \
            dst##8[m] = __builtin_shufflevector(lo_, hi_, 0, 1, 2, 3, 4, 5, 6, 7); } } \
        else { _Pragma("unroll") for (int m = 0; m < 4; ++m) _Pragma("unroll") for (int k = 0; k < 2; ++k) dst[m][k] = *(const PG8_LAS bf16x8*)(lds + PG8_SA(b, h) + aoff + m * 2048 + k * 1024); } } while (0)
#define PG8_LDB(dst, b, h) do { if constexpr (FP8) { _Pragma("unroll") for (int n = 0; n < 2; ++n) { const i32x4 lo_ = *(const PG8_LAS i32x4*)(lds + PG8_SB(b, h) + boff + n * 2048), hi_ = *(const PG8_LAS i32x4*)(lds + PG8_SB(b, h) + boff + n * 2048 + 1024); \
            dst##8[n] = __builtin_shufflevector(lo_, hi_, 0, 1, 2, 3, 4, 5, 6, 7); } } \
        else { _Pragma("unroll") for (int n = 0; n < 2; ++n) _Pragma("unroll") for (int k = 0; k < 2; ++k) dst[n][k] = *(const PG8_LAS bf16x8*)(lds + PG8_SB(b, h) + boff + n * 2048 + k * 1024); } } while (0)
#define PG8_MMA(ai, bj, At, Bt) do { __builtin_amdgcn_s_setprio(1); \
        if constexpr (FP8) { _Pragma("unroll") for (int m = 0; m < 4; ++m) _Pragma("unroll") for (int n = 0; n < 2; ++n) \
            asm volatile("v_mfma_f32_16x16x128_f8f6f4 %0, %1, %2, %0" : "+v"(acc[ai][bj][m][n]) : "v"(Bt##8[n]), "v"(At##8[m])); } \
        else { _Pragma("unroll") for (int m = 0; m < 4; ++m) _Pragma("unroll") for (int n = 0; n < 2; ++n) _Pragma("unroll") for (int k = 0; k < 2; ++k) \
            acc[ai][bj][m][n] = __builtin_amdgcn_mfma_f32_16x16x32_bf16(Bt[n][k], At[m][k], acc[ai][bj][m][n], 0, 0, 0); } \
        __builtin_amdgcn_s_setprio(0); } while (0)
#define PG8_WAIT_V(n) asm volatile("s_waitcnt vmcnt(" #n ")" ::: "memory")
#define PG8_WAIT_L(n) asm volatile("s_waitcnt lgkmcnt(" #n ")" ::: "memory")
#define PG8_BAR __builtin_amdgcn_s_barrier()
#define PG8_SCHED __builtin_amdgcn_sched_barrier(0)
    Unit cur, nxt; int ui = 0;
    if (!S.next(0, cur)) return;
    f32x4 acc[2][2][4][2];
#pragma unroll
    for (int a = 0; a < 2; ++a)
#pragma unroll
        for (int b = 0; b < 2; ++b)
#pragma unroll
            for (int m = 0; m < 4; ++m)
#pragma unroll
                for (int n = 0; n < 2; ++n) acc[a][b][m][n] = (f32x4){0.f, 0.f, 0.f, 0.f};
    bf16x8 At[4][2], B0[2][2], B1[2][2]; i32x8 At8[4], B08[2], B18[2];
    const char* cA = (const char*)g.A + (size_t)cur.pm * tstep + (size_t)cur.k0 * kstep; const char* cB = (const char*)g.Bt + (size_t)cur.pn * tstep + (size_t)cur.k0 * kstep;
    S.a_ready(cur);
    if constexpr (SP2) {
        PG8_STAGE(PG8_SB(0, 0), cB, voffB); PG8_STAGE(PG8_SB(0, 1), cB + hstep, voffB); PG8_STAGE(PG8_SA(0, 0), cA, voffA); PG8_STAGE(PG8_SA(0, 1), cA + hstep, voffA);
        if (wr == 1) PG8_BAR;
        PG8_WAIT_V(2); PG8_BAR;
        PG8_STAGE(PG8_SB(1, 0), cB + kstep, voffB); PG8_STAGE(PG8_SA(1, 0), cA + kstep, voffA); PG8_STAGE(PG8_SB(1, 1), cB + hstep + kstep, voffB);
        PG8_WAIT_V(6); PG8_BAR;
    } else {
        PG8_STAGE(PG8_SB(0, 0), cB, voffB); PG8_STAGE(PG8_SA(0, 0), cA, voffA); PG8_STAGE(PG8_SB(0, 1), cB + hstep, voffB); PG8_STAGE(PG8_SA(0, 1), cA + hstep, voffA);
        if (wr == 1) PG8_BAR;
        PG8_WAIT_V(4); PG8_BAR;
        PG8_STAGE(PG8_SB(1, 0), cB + kstep, voffB); PG8_STAGE(PG8_SA(1, 0), cA + kstep, voffA); PG8_STAGE(PG8_SB(1, 1), cB + hstep + kstep, voffB);
        PG8_WAIT_V(6); PG8_BAR;
    }
    for (;;) {
        const bool has_next = S.next(ui + 1, nxt);
        const char* nA = has_next ? (const char*)g.A + (size_t)nxt.pm * tstep + (size_t)nxt.k0 * kstep : cA; const char* nB = has_next ? (const char*)g.Bt + (size_t)nxt.pn * tstep + (size_t)nxt.k0 * kstep : cB;
        const int nt = cur.nt;
#ifndef KREP
#define KREP 1
#endif
        for (int tt_ = 0; tt_ < nt * KREP; tt_ += 2) {
            const int t = (KREP > 1 && tt_ >= nt) ? tt_ - nt : tt_;
            if (KREP > 1 && tt_ == nt) {
#pragma unroll
                for (int a = 0; a < 2; ++a)
#pragma unroll
                    for (int b2_ = 0; b2_ < 2; ++b2_)
#pragma unroll
                        for (int m = 0; m < 4; ++m)
#pragma unroll
                            for (int n = 0; n < 2; ++n) acc[a][b2_][m][n] = (f32x4){0.f, 0.f, 0.f, 0.f}; }
            const bool last = (tt_ == nt * KREP - 2);
            const char* a1 = cA + (size_t)(t + 1) * kstep;
            const int t2 = (KREP > 1 && t + 2 >= nt) ? t + 2 - nt : t + 2;
            const char* a2 = last ? nA : cA + (size_t)t2 * kstep; const char* b2 = last ? nB : cB + (size_t)t2 * kstep;
            const char* a3 = a2 + kstep; const char* b3 = b2 + kstep;
            if (last && has_next) S.a_ready(nxt);
            if constexpr (SP2) {
            PG8_LDB(B0, 0, 0); PG8_LDB(B1, 0, 1); PG8_SCHED; PG8_LDA(At, 0, 0); PG8_STAGE(PG8_SA(1, 1), a1 + hstep, voffA);
            PG8_WAIT_V(8); PG8_WAIT_L(0); PG8_BAR; PG8_MMA(0, 0, At, B0); PG8_MMA(0, 1, At, B1); PG8_BAR; PG8_SCHED;
            PG8_LDA(At, 0, 1); PG8_STAGE(PG8_SB(0, 0), b2, voffB); PG8_STAGE(PG8_SB(0, 1), b2 + hstep, voffB); PG8_STAGE(PG8_SA(0, 0), a2, voffA);
            PG8_WAIT_V(8); PG8_WAIT_L(0); PG8_BAR; PG8_MMA(1, 0, At, B0); PG8_MMA(1, 1, At, B1); PG8_BAR; PG8_SCHED;
            PG8_LDB(B0, 1, 0); PG8_LDB(B1, 1, 1); PG8_SCHED; PG8_LDA(At, 1, 0); PG8_STAGE(PG8_SA(0, 1), a2 + hstep, voffA);
            PG8_WAIT_V(8); PG8_WAIT_L(0); PG8_BAR; PG8_MMA(0, 0, At, B0); PG8_MMA(0, 1, At, B1); PG8_BAR; PG8_SCHED;
            PG8_LDA(At, 1, 1); PG8_STAGE(PG8_SB(1, 0), b3, voffB); PG8_STAGE(PG8_SB(1, 1), b3 + hstep, voffB); PG8_STAGE(PG8_SA(1, 0), a3, voffA);
            PG8_WAIT_V(8); PG8_WAIT_L(0); PG8_BAR; PG8_MMA(1, 0, At, B0); PG8_MMA(1, 1, At, B1); PG8_BAR; PG8_SCHED;
            } else {
            PG8_LDB(B0, 0, 0); PG8_SCHED; PG8_LDA(At, 0, 0); PG8_STAGE(PG8_SA(1, 1), a1 + hstep, voffA);
            PG8_WAIT_L(8); PG8_BAR; PG8_WAIT_L(0); PG8_MMA(0, 0, At, B0); PG8_BAR; PG8_SCHED;
            PG8_LDB(B1, 0, 1); PG8_STAGE(PG8_SB(0, 0), b2, voffB);
            PG8_BAR; PG8_WAIT_L(0); PG8_MMA(0, 1, At, B1); PG8_BAR;
            PG8_LDA(At, 0, 1); PG8_STAGE(PG8_SA(0, 0), a2, voffA);
            PG8_BAR; PG8_WAIT_L(0); PG8_MMA(1, 0, At, B0); PG8_BAR; PG8_SCHED;
            PG8_STAGE(PG8_SB(0, 1), b2 + hstep, voffB);
            PG8_WAIT_V(6); PG8_BAR; PG8_MMA(1, 1, At, B1); PG8_BAR;
            PG8_LDB(B0, 1, 0); PG8_SCHED; PG8_LDA(At, 1, 0); PG8_STAGE(PG8_SA(0, 1), a2 + hstep, voffA);
            PG8_WAIT_L(8); PG8_BAR; PG8_WAIT_L(0); PG8_MMA(0, 0, At, B0); PG8_BAR; PG8_SCHED;
            PG8_LDB(B1, 1, 1); PG8_STAGE(PG8_SB(1, 0), b3, voffB);
            PG8_BAR; PG8_WAIT_L(0); PG8_MMA(0, 1, At, B1); PG8_BAR;
            PG8_LDA(At, 1, 1); PG8_STAGE(PG8_SA(1, 0), a3, voffA);
            PG8_BAR; PG8_WAIT_L(0); PG8_MMA(1, 0, At, B0); PG8_BAR; PG8_SCHED;
            PG8_STAGE(PG8_SB(1, 1), b3 + hstep, voffB);
            PG8_WAIT_V(6); PG8_BAR; PG8_MMA(1, 1, At, B1); PG8_BAR;
            }
        }
        if constexpr (FP8) asm volatile("s_nop 15\n\ts_nop 7" ::: "memory");
        if constexpr (ALIGN_EPI) { if (wr == 0) PG8_BAR; }
        if constexpr (!Epi::AFTER_DRAIN) { E(acc, cur, wr, wc, fr, fq); S.done(cur); }
        if (!has_next) break;
#pragma unroll
        for (int a = 0; a < 2; ++a)
#pragma unroll
            for (int b = 0; b < 2; ++b)
#pragma unroll
                for (int m = 0; m < 4; ++m)
#pragma unroll
                    for (int n = 0; n < 2; ++n) acc[a][b][m][n] = (f32x4){0.f, 0.f, 0.f, 0.f};
        cur = nxt; cA = nA; cB = nB; ++ui;
        if constexpr (ALIGN_EPI) { if (wr == 1) PG8_BAR; }
    }
    PG8_WAIT_V(0);
    if constexpr (!ALIGN_EPI) { if (wr == 0) PG8_BAR; }
    PG8_BAR;
    if constexpr (Epi::AFTER_DRAIN) { E.fused(acc, cur, wr, wc, fr, fq, lds, wid, lane); S.done(cur); }
#undef PG8_SA
#undef PG8_SB
#undef PG8_STAGE
#undef PG8_LDA
#undef PG8_LDB
#undef PG8_MMA
#undef PG8_WAIT_V
#undef PG8_WAIT_L
#undef PG8_BAR
#undef PG8_SCHED
}
}
#ifndef WGM_G2
#define WGM_G2 6
#endif
#ifndef WGM_G4
#define WGM_G4 6
#endif
#ifndef F8_LAST
#define F8_LAST 1
#endif
constexpr float WD8_SCALE = 128.f;
#ifndef REP_P0
#define REP_P0 1
#endif
#ifndef REP_G1
#define REP_G1 1
#endif
#ifndef REP_MIX
#define REP_MIX 1
#endif
#ifndef REP_G2
#define REP_G2 1
#endif
#ifndef REP_G3
#define REP_G3 1
#endif
#ifndef REP_G4
#define REP_G4 1
#endif
#ifndef REP_FIN
#define REP_FIN 1
#endif
#ifndef REP_SYNC
#define REP_SYNC 1
#endif
using pg8::bf16_t; using pg8::bf16x8; using pg8::f32x4; using pg8::u32x4; using pg8::u32x2; using pg8::unpack8; using pg8::unpack4; using pg8::pack8; using pg8::cvt_pk_bf16; using pg8::load8f;
#define LAS __attribute__((address_space(3)))
constexpr int NWAVES = 8, NTHR = 512;
constexpr int D = 1024, DIN = 2048, DFF = 2816, NGU = 2 * DFF, DEPTH = 2;
constexpr int TP = 8 * 8192, TS = 32 * 64, T = TP + TS;
constexpr int LDS_BYTES = 155648, PST_OFF = 131072, MISC_OFF = LDS_BYTES - 64;
constexpr size_t al256(size_t x) { return (x + 255) & ~(size_t)255; }
constexpr size_t SZ_WIN = (size_t)DIN * D * 2, SZ_WOUT = (size_t)D * D * 2, SZ_WGU = (size_t)NGU * D * 2, SZ_WD = (size_t)D * DFF * 2, SZ_WSB = 8 * 128 * 128 * 2, SZ_WPT = 4 * 64 * 64 * 2;
constexpr size_t WS_WIN = 0, WS_WOUT = WS_WIN + DEPTH * SZ_WIN, WS_WGU = WS_WOUT + DEPTH * SZ_WOUT, WS_WD = WS_WGU + DEPTH * SZ_WGU, WS_WSB = WS_WD + DEPTH * SZ_WD, WS_WPT = WS_WSB + DEPTH * SZ_WSB;
constexpr size_t WS_C1IN = WS_WPT + DEPTH * SZ_WPT, WS_C2IN = WS_C1IN + DEPTH * DIN * 4, WS_C1GU = WS_C2IN + DEPTH * DIN * 4, WS_C2GU = WS_C1GU + DEPTH * NGU * 4;
constexpr size_t WS_BAR = al256(WS_C2GU + DEPTH * NGU * 4), BAR_BYTES = 16384;
constexpr size_t WS_ST1P = WS_BAR + BAR_BYTES, WS_ST2P = WS_ST1P + (size_t)T * 32, WS_ST1 = WS_ST2P + (size_t)T * 32, WS_ST2 = WS_ST1 + (size_t)T * 8;
constexpr size_t SZ_ACT = (size_t)T * D * 2;
constexpr size_t WS_XB = al256(WS_ST2 + (size_t)T * 8), WS_P1 = WS_XB + SZ_ACT, WS_P2 = WS_P1 + SZ_ACT, WS_PROJ = WS_P2 + SZ_ACT, WS_CAT = WS_PROJ + 2 * SZ_ACT, WS_HID = WS_PROJ, WS_PART = WS_CAT + SZ_ACT, WS_END = WS_PART + (size_t)pg8::NSPLIT * TS * D * 4;
static_assert((size_t)T * DFF * 2 <= 3 * SZ_ACT, "hid overlays proj|cat");
constexpr size_t O_YP = 0, O_YS = (size_t)TP * D, O_POOLP = (size_t)T * D, O_POOLS = O_POOLP + (size_t)DEPTH * 8 * 15 * 256, O_CONVP = O_POOLS + (size_t)DEPTH * 32 * 15 * 256,
                 O_CONVS = O_CONVP + (size_t)DEPTH * 8 * 2 * 256, O_V = O_CONVS + (size_t)DEPTH * 32 * 2 * 256, O_END = O_V + (size_t)DEPTH * 32 * 64 * 512;

struct Params { const float* in[20]; float* out; unsigned char* ws; };

__device__ __forceinline__ float wave_sum(float v) {
#pragma unroll
    for (int o = 1; o < 64; o <<= 1) v += __shfl_xor(v, o);
    return v;
}
__device__ __forceinline__ float bf2f(bf16_t h) { return __uint_as_float(((unsigned)h) << 16); }
#define LDS_WAIT() asm volatile("s_waitcnt lgkmcnt(0)" ::: "memory")

#define XB_TMO      128
#define XB_XCNT(j)  (256  + 64 * (j))
#define XB_XSUB(j)  (1280 + 64 * (j))
#define XB_XGEN(j)  (2304 + 64 * (j))
#define XB_TOP      3328
#define XB_TOPGEN   3392
#define XCD_BAR_WORDS 3456
#define XB_SPIN_CAP (1u << 18)

__device__ __forceinline__ unsigned xb_ld(unsigned* p)              { return __hip_atomic_load(p, __ATOMIC_RELAXED, __HIP_MEMORY_SCOPE_AGENT); }
__device__ __forceinline__ unsigned xb_add(unsigned* p, unsigned v) { return __hip_atomic_fetch_add(p, v, __ATOMIC_RELAXED, __HIP_MEMORY_SCOPE_AGENT); }
__device__ __forceinline__ unsigned xb_xcc_id() { return (unsigned)__builtin_amdgcn_s_getreg((3 << 11) | 20) & 0xFu; }
#define XB_SPIN(cond, bar) do { unsigned _sp = 0; while (cond) { __builtin_amdgcn_s_sleep(1); \
    if ((++_sp & 255u) == 0u) { if (xb_ld(&(bar)[XB_TMO])) break; if (_sp > XB_SPIN_CAP) { atomicAdd(&(bar)[XB_TMO], 1u); break; } } } } while (0)

struct XcdBarrier {
    unsigned* bar; unsigned x;
    volatile LAS unsigned* st;
};

__device__ __forceinline__ XcdBarrier xcd_barrier_post(unsigned* bar, volatile LAS unsigned* st) {
    XcdBarrier b; b.bar = bar; b.x = xb_xcc_id(); b.st = st;
    if (threadIdx.x == 0) (void)xb_add(&bar[XB_XCNT(b.x)], 1u);
    return b;
}
__device__ __forceinline__ void xcd_barrier_complete(unsigned* bar, unsigned x, unsigned& nloc, unsigned& nx) {
    const unsigned G = gridDim.x * gridDim.y * gridDim.z;
    unsigned sum, cnt, mine, sp = 0u;
    for (;;) {
        sum = 0u; cnt = 0u; mine = 0u;
#pragma unroll
        for (unsigned j = 0; j < 16; ++j) { const unsigned c = xb_ld(&bar[XB_XCNT(j)]); sum += c; cnt += (c > 0u) ? 1u : 0u; mine = (j == x) ? c : mine; }
        if (sum == G) break;
        __builtin_amdgcn_s_sleep(1);
        if ((++sp & 255u) == 0u) { if (xb_ld(&bar[XB_TMO])) break; if (sp > XB_SPIN_CAP) { atomicAdd(&bar[XB_TMO], 1u); break; } }
    }
    nloc = mine > 0u ? mine : 1u; nx = cnt > 0u ? cnt : 1u;
}

__device__ __forceinline__ void xcd_barrier(const XcdBarrier& b) {
    asm volatile("s_waitcnt vmcnt(0)" ::: "memory");
    __syncthreads();
    if (threadIdx.x == 0) {
        unsigned* bar = b.bar;
        __builtin_amdgcn_s_waitcnt(0);
        unsigned nloc = b.st[0], nx = b.st[1];
        if (nloc == 0u) { xcd_barrier_complete(bar, b.x, nloc, nx); b.st[0] = nloc; b.st[1] = nx; }
        const unsigned old = xb_add(&bar[XB_XSUB(b.x)], 1u);
        const unsigned gen = old / nloc;
        if (old + 1u == (gen + 1u) * nloc) {
            __builtin_amdgcn_fence(__ATOMIC_RELEASE, "agent");
            asm volatile("s_waitcnt vmcnt(0)" ::: "memory");
            const unsigned og = xb_add(&bar[XB_TOP], 1u);
            const unsigned tg = og / nx;
            if (og + 1u == (tg + 1u) * nx) xb_add(&bar[XB_TOPGEN], 1u);
            else XB_SPIN(xb_ld(&bar[XB_TOPGEN]) == tg, bar);
            __builtin_amdgcn_fence(__ATOMIC_ACQUIRE, "agent");
            xb_add(&bar[XB_XGEN(b.x)], 1u);
            asm volatile("s_waitcnt vmcnt(0)" ::: "memory");
        } else {
            XB_SPIN(xb_ld(&bar[XB_XGEN(b.x)]) == gen, bar);
            __builtin_amdgcn_fence(__ATOMIC_ACQUIRE, "agent");
            asm volatile("s_waitcnt vmcnt(0)" ::: "memory");
        }
    }
    __syncthreads();
}

__device__ __forceinline__ void p0_tile(const float* W, int srcN, int K, int k0, int n0, bf16_t* WT, int dstrow0, const float* g, const float* bvec, LAS float* scr, int lane, float (&s1)[4], float (&s2)[4], float f8scale = 0.f) {
#pragma unroll 8
    for (int i = 0; i < 32; ++i) { const int kk = 2 * i + (lane >> 5); scr[kk * 33 + (lane & 31)] = W[(size_t)(k0 + kk) * srcN + n0 + (lane & 31)]; }
    LDS_WAIT(); asm volatile("" ::: "memory");
    const int c = lane & 7;
    float gv[8], bv[8];
    if (g) { load8f(g + k0 + 8 * c, gv); load8f(bvec + k0 + 8 * c, bv); }
    else {
#pragma unroll
        for (int q = 0; q < 8; ++q) { gv[q] = 1.f; bv[q] = 0.f; } }
#pragma unroll
    for (int j = 0; j < 4; ++j) { const int n = (lane >> 3) + 8 * j; const LAS float* s = scr + (8 * c) * 33 + n;
        float v[8]; float t2 = 0.f;
#pragma unroll
        for (int q = 0; q < 8; ++q) { const float w = s[q * 33]; v[q] = w * gv[q]; t2 += w * bv[q]; }
        const u32x4 o = pack8(v);
        float r[8]; unpack8(o, r);
        s1[j] += ((r[0] + r[1]) + (r[2] + r[3])) + ((r[4] + r[5]) + (r[6] + r[7])); s2[j] += t2;
        if (f8scale != 0.f) { int w0 = 0, w1 = 0;
            w0 = __builtin_amdgcn_cvt_pk_fp8_f32(v[0] * f8scale, v[1] * f8scale, w0, false); w0 = __builtin_amdgcn_cvt_pk_fp8_f32(v[2] * f8scale, v[3] * f8scale, w0, true);
            w1 = __builtin_amdgcn_cvt_pk_fp8_f32(v[4] * f8scale, v[5] * f8scale, w1, false); w1 = __builtin_amdgcn_cvt_pk_fp8_f32(v[6] * f8scale, v[7] * f8scale, w1, true);
            u32x2 w; w.x = (unsigned)w0; w.y = (unsigned)w1; *(u32x2*)((unsigned char*)WT + (size_t)(dstrow0 + n) * K + k0 + 8 * c) = w; }
        else *(u32x4*)(WT + (size_t)(dstrow0 + n) * K + k0 + 8 * c) = o; }
    LDS_WAIT(); asm volatile("" ::: "memory");
}
__device__ __forceinline__ void p0_phase(const Params& p, LAS unsigned char* lds, int wave, int lane) {
    LAS float* scr = (LAS float*)(lds + wave * 16384);
    const int gw = blockIdx.x * NWAVES + wave, NGW = gridDim.x * NWAVES;
    unsigned char* ws = p.ws;
    constexpr int IA_IN = DIN / 32, IA_GU = NGU / 32, IA_L = IA_IN + IA_GU, IA = DEPTH * IA_L;
    LAS float* red = (LAS float*)(lds + PST_OFF);
    for (int it = blockIdx.x; it < IA; it += gridDim.x) {
        const int l = it / IA_L; int r = it % IA_L;
        const float* W; int srcN, n0, dstrow0; bf16_t* WT; const float* g; const float* bv; float* c1; float* c2;
        if (r < IA_IN) { W = p.in[6] + (size_t)l * D * DIN; srcN = DIN; n0 = 32 * r; dstrow0 = 32 * r; WT = (bf16_t*)(ws + WS_WIN + l * SZ_WIN);
            g = l ? p.in[15] : nullptr; bv = l ? p.in[16] : nullptr;
            c1 = (float*)(ws + WS_C1IN) + l * DIN; c2 = (float*)(ws + WS_C2IN) + l * DIN; }
        else { r -= IA_IN; dstrow0 = 32 * r; const int pn = dstrow0 >> 8, jj = dstrow0 & 255; W = (jj < 128 ? p.in[17] : p.in[18]) + (size_t)l * D * DFF; srcN = DFF; n0 = pn * 128 + (jj & 127);
            WT = (bf16_t*)(ws + WS_WGU + l * SZ_WGU); g = p.in[4] + l * D; bv = p.in[5] + l * D; c1 = (float*)(ws + WS_C1GU) + l * NGU; c2 = (float*)(ws + WS_C2GU) + l * NGU; }
        float s1[4] = {0.f, 0.f, 0.f, 0.f}, s2[4] = {0.f, 0.f, 0.f, 0.f};
        for (int kb = 2 * wave; kb < 2 * wave + 2; ++kb) p0_tile(W, srcN, D, 64 * kb, n0, WT, dstrow0, g, bv, scr, lane, s1, s2);
#pragma unroll
        for (int j = 0; j < 4; ++j) { float a = s1[j], b = s2[j]; a += __shfl_xor(a, 1); a += __shfl_xor(a, 2); a += __shfl_xor(a, 4); b += __shfl_xor(b, 1); b += __shfl_xor(b, 2); b += __shfl_xor(b, 4);
            if ((lane & 7) == 0) { const int n = (lane >> 3) + 8 * j; red[(wave * 32 + n) * 2] = a; red[(wave * 32 + n) * 2 + 1] = b; } }
        __syncthreads();
        if (wave == 0 && lane < 32) { float a = 0.f, b = 0.f;
#pragma unroll
            for (int w8 = 0; w8 < 8; ++w8) { a += red[(w8 * 32 + lane) * 2]; b += red[(w8 * 32 + lane) * 2 + 1]; }
            c1[dstrow0 + lane] = a; c2[dstrow0 + lane] = b; }
        __syncthreads();
    }
    constexpr int IB_O = (D / 64) * (D / 32), IB_D = (DFF / 64) * (D / 32), IB_L = IB_O + IB_D, IB = DEPTH * IB_L;
    for (int it = gw; it < IB; it += NGW) {
        const int l = it / IB_L; int r = it % IB_L; float d1[4] = {0.f, 0.f, 0.f, 0.f}, d2[4] = {0.f, 0.f, 0.f, 0.f};
        if (r < IB_O) { const int kb = r / (D / 32), nb = r % (D / 32); p0_tile(p.in[14] + (size_t)l * D * D, D, D, 64 * kb, 32 * nb, (bf16_t*)(ws + WS_WOUT + l * SZ_WOUT), 32 * nb, nullptr, nullptr, scr, lane, d1, d2); }
        else { r -= IB_O; const int kb = r / (D / 32), nb = r % (D / 32); p0_tile(p.in[19] + (size_t)l * DFF * D, D, DFF, 64 * kb, 32 * nb, (bf16_t*)(ws + WS_WD + l * SZ_WD), 32 * nb, nullptr, nullptr, scr, lane, d1, d2, (F8_LAST && l == DEPTH - 1) ? WD8_SCALE : 0.f); }
    }
    const int gt = blockIdx.x * NTHR + wave * 64 + lane, GT = gridDim.x * NTHR;
    { bf16_t* wsb = (bf16_t*)(ws + WS_WSB); const float* src = p.in[9];
      for (int i = gt; i < DEPTH * 8 * 128 * 128 / 2; i += GT) { const int e = 2 * i, jj = e & 127, ii = (e >> 7) & 127; const bool keep = (jj >> 6) <= (ii >> 6);
          const float a = keep ? src[e] : 0.f, b = keep ? src[e + 1] : 0.f; ((unsigned*)wsb)[i] = cvt_pk_bf16(a, b); }
      bf16_t* wpt = (bf16_t*)(ws + WS_WPT); const float* wp = p.in[11];
      for (int i = gt; i < DEPTH * 4 * 64 * 64; i += GT) { const int c = i & 63, e = (i >> 6) & 63, lg = i >> 12; wpt[i] = (bf16_t)(cvt_pk_bf16(wp[((size_t)lg * 64 + c) * 64 + e], 0.f) & 0xffffu); } }
    { bf16_t* xb = (bf16_t*)(ws + WS_XB); constexpr int NCH = T * D / 8, PCH = TP * D / 8;
#pragma unroll 4
      for (int i = gt; i < NCH; i += GT) { const float* s = (i < PCH) ? p.in[0] + (size_t)i * 8 : p.in[1] + (size_t)(i - PCH) * 8; float f[8]; load8f(s, f); *(u32x4*)(xb + (size_t)i * 8) = pack8(f); } }
}

struct MixArgs {
    const bf16_t* proj; bf16_t* cat; const float* vg; const float* vb; const bf16_t* wsb; const float* bsp; const bf16_t* wpt; const float* pscale; const float* convw;
    const float* st_pool; const float* st_conv; float* o_pool_p; float* o_pool_s; float* o_conv_p; float* o_conv_s; float* o_v;
};
constexpr int VT_S = 136, XS = 264, VSTAT_OFF = 8 * 64 * VT_S * 2;
static_assert(VSTAT_OFF + 8192 <= MISC_OFF && 79 * XS * 2 <= MISC_OFF, "MIX LDS map");
__device__ __forceinline__ void mix_chunk_unit(LAS unsigned char* lds, const MixArgs& A, int u, int tid_in, int wid_in, int lane_in) {
    int tid = tid_in; asm volatile("" : "+v"(tid)); const int lane = tid & 63, wid = __builtin_amdgcn_readfirstlane(tid >> 6); (void)wid_in; (void)lane_in;
    const int fr = lane & 15, fq = lane >> 4;
    const int r0 = u * 128; const bool prompt = u < 512;
    const bf16_t* proj = A.proj;
    typedef float f32x2v __attribute__((ext_vector_type(2)));
    LAS f32x2v* part = (LAS f32x2v*)(lds + VSTAT_OFF);
    const int h = wid; LAS bf16_t* vt = (LAS bf16_t*)lds + h * 64 * VT_S;
    const int j0 = 2 * lane;
    u32x4 ra[8], rb[8];
    {
      LAS unsigned char* stg = (LAS unsigned char*)vt;
      u32x4 t[16];
      const unsigned goff = ((unsigned)(r0 + (lane >> 3)) * DIN + 512u + (unsigned)(h * 64 + (lane & 7) * 8)) * 2u;
#pragma unroll
      for (int k = 0; k < 16; ++k) t[k] = *(const u32x4*)((const char*)proj + (size_t)(goff + (unsigned)(8 * k * DIN) * 2u));
#pragma unroll
      for (int k = 0; k < 16; ++k) { const int r = (lane >> 3) + 8 * k; *(LAS u32x4*)(stg + r * 128 + (((lane & 7) ^ ((r >> 1) & 7)) * 16)) = t[k]; }
      LDS_WAIT(); asm volatile("" ::: "memory");
#pragma unroll
      for (int dc = 0; dc < 8; ++dc) { ra[dc] = *(const LAS u32x4*)(stg + (2 * lane) * 128 + ((dc ^ (lane & 7)) * 16)); rb[dc] = *(const LAS u32x4*)(stg + (2 * lane + 1) * 128 + ((dc ^ (lane & 7)) * 16)); }
      LDS_WAIT(); asm volatile("" ::: "memory");
    }
    { float s0 = 0.f, q0 = 0.f, s1 = 0.f, q1 = 0.f;
#pragma unroll
      for (int dc = 0; dc < 8; ++dc) { float a[8], b[8]; unpack8(ra[dc], a); unpack8(rb[dc], b);
#pragma unroll
          for (int q = 0; q < 8; ++q) { s0 += a[q]; q0 += a[q] * a[q]; s1 += b[q]; q1 += b[q] * b[q]; } }
      part[h * 128 + j0] = (f32x2v){s0, q0}; part[h * 128 + j0 + 1] = (f32x2v){s1, q1}; }
    __syncthreads();
    float mu0, rs0, mu1, rs1;
    { float s0 = 0.f, q0 = 0.f, s1 = 0.f, q1 = 0.f;
#pragma unroll
      for (int hh = 0; hh < 8; ++hh) { const f32x2v a = part[hh * 128 + j0], b = part[hh * 128 + j0 + 1]; s0 += a[0]; q0 += a[1]; s1 += b[0]; q1 += b[1]; }
      mu0 = s0 * (1.f / 512.f); rs0 = rsqrtf(fmaxf(q0 * (1.f / 512.f) - mu0 * mu0, 0.f) + pg8::LN_EPS);
      mu1 = s1 * (1.f / 512.f); rs1 = rsqrtf(fmaxf(q1 * (1.f / 512.f) - mu1 * mu1, 0.f) + pg8::LN_EPS); }
#pragma unroll
    for (int dc = 0; dc < 8; ++dc) { float a[8], b[8], gv[8], bv[8]; unpack8(ra[dc], a); unpack8(rb[dc], b);
        load8f(A.vg + h * 64 + dc * 8, gv); load8f(A.vb + h * 64 + dc * 8, bv);
#pragma unroll
        for (int q = 0; q < 8; ++q) { a[q] = (a[q] - mu0) * rs0 * gv[q] + bv[q]; b[q] = (b[q] - mu1) * rs1 * gv[q] + bv[q]; }
        if (!prompt) { float* o = A.o_v + (size_t)(r0 - TP + j0) * 512 + h * 64 + dc * 8;
            *(f32x4*)o = (f32x4){a[0], a[1], a[2], a[3]}; *(f32x4*)(o + 4) = (f32x4){a[4], a[5], a[6], a[7]}; *(f32x4*)(o + 512) = (f32x4){b[0], b[1], b[2], b[3]}; *(f32x4*)(o + 516) = (f32x4){b[4], b[5], b[6], b[7]}; }
#pragma unroll
        for (int q = 0; q < 8; ++q) *(LAS unsigned*)(vt + (dc * 8 + q) * VT_S + j0) = cvt_pk_bf16(a[q], b[q]); }
    LDS_WAIT(); asm volatile("" ::: "memory");
#pragma unroll 1
    for (int ob = 0; ob < 2; ++ob) {
        const int wsr0 = prompt ? ob * 64 : 0, vr0 = prompt ? 0 : ob * 64, nk = (prompt && ob) ? 4 : 2;
        u32x2 uw[4][4];
#pragma unroll
        for (int it = 0; it < 4; ++it)
#pragma unroll
            for (int dt = 0; dt < 4; ++dt) uw[it][dt] = *(const u32x2*)(proj + ((size_t)r0 + ob * 64 + it * 16 + fr) * DIN + h * 64 + dt * 16 + fq * 4);
#pragma unroll
        for (int it = 0; it < 4; ++it) {
            const int wrow = wsr0 + it * 16 + fr; const size_t row = (size_t)r0 + ob * 64 + it * 16 + fr;
            const float bs = A.bsp[h * 128 + wrow];
            bf16x8 wf[4];
#pragma unroll
            for (int ks = 0; ks < 4; ++ks) if (ks < nk) wf[ks] = *(const bf16x8*)(A.wsb + ((size_t)h * 128 + wrow) * 128 + ks * 32 + fq * 8);
            f32x4 acc[4];
#pragma unroll
            for (int b = 0; b < 4; ++b) acc[b] = (f32x4){0.f, 0.f, 0.f, 0.f};
#pragma unroll
            for (int ks = 0; ks < 4; ++ks) if (ks < nk) { bf16x8 vf[4];
#pragma unroll
                for (int dt = 0; dt < 4; ++dt) vf[dt] = *(const LAS bf16x8*)(vt + (dt * 16 + fr) * VT_S + vr0 + ks * 32 + fq * 8);
#pragma unroll
                for (int dt = 0; dt < 4; ++dt) acc[dt] = __builtin_amdgcn_mfma_f32_16x16x32_bf16(vf[dt], wf[ks], acc[dt], 0, 0, 0); }
#pragma unroll
            for (int dt = 0; dt < 4; ++dt) { const int d = h * 64 + dt * 16 + fq * 4; float uu[4]; unpack4(uw[it][dt], uu);
                u32x2 o; o.x = cvt_pk_bf16(uu[0] * (acc[dt][0] + bs), uu[1] * (acc[dt][1] + bs)); o.y = cvt_pk_bf16(uu[2] * (acc[dt][2] + bs), uu[3] * (acc[dt][3] + bs));
                *(u32x2*)(A.cat + row * D + d) = o; }
        }
    }
    __syncthreads();
}
__device__ __forceinline__ void mix_pool_conv_block(LAS unsigned char* lds, const MixArgs& A, int blk, int tid_in, int wid_in, int lane_in) {
    int tid = tid_in; asm volatile("" : "+v"(tid)); const int lane = tid & 63, wid = __builtin_amdgcn_readfirstlane(tid >> 6); (void)wid_in; (void)lane_in;
    const int fr = lane & 15, fq = lane >> 4;
    const int r0 = blk * 64; const bool prompt = blk < 1024; const int bi = blk & 127, sb = blk - 1024;
    const int t0 = prompt ? bi * 64 : 0;
    const bf16_t* proj = A.proj;
    LAS bf16_t* xt = (LAS bf16_t*)lds;
    const int g = wid >> 1, half = wid & 1, w = 2 << g;
    bf16x8 wf[2][4];
#pragma unroll
    for (int ks = 0; ks < 2; ++ks)
#pragma unroll
        for (int et = 0; et < 4; ++et) wf[ks][et] = *(const bf16x8*)(A.wpt + ((size_t)g * 64 + et * 16 + fr) * 64 + ks * 32 + fq * 8);
    u32x4 tw[5];
#pragma unroll
    for (int i = 0; i < 5; ++i) { const int idx = tid + i * NTHR, tr = idx >> 5, cc = idx & 31; u32x4 wv = (u32x4){0u, 0u, 0u, 0u};
        if (idx < 79 * 32) {
            if (tr >= 15 || (prompt && bi != 0)) wv = *(const u32x4*)(proj + (size_t)(r0 - 15 + tr) * DIN + 1024 + cc * 8);
            else if (!prompt) { float f[8]; load8f(A.st_pool + ((size_t)sb * 15 + tr) * 256 + cc * 8, f); wv = pack8(f); } }
        tw[i] = wv; }
    const int cj = tid >> 5, cc8 = (tid & 31) * 8;
#pragma unroll 1
    for (int hb = 0; hb < 2; ++hb) {
        u32x4 cgb[2], cgc[2][3], chh[2][3];
#pragma unroll
        for (int i2 = 0; i2 < 2; ++i2) { const int j = cj + 16 * (2 * hb + i2), t = t0 + j; const bf16_t* pr = proj + ((size_t)r0 + j) * DIN;
            cgb[i2] = *(const u32x4*)(pr + 1280 + cc8);
#pragma unroll
            for (int k = 0; k < 3; ++k) { const bool ok = t >= k; const bf16_t* q = pr - (ok ? k : 0) * DIN;
                cgc[i2][k] = *(const u32x4*)(q + 1536 + cc8); chh[i2][k] = *(const u32x4*)(q + 1792 + cc8); } }
        float w0[8], w1[8], w2[8]; load8f(A.convw + cc8, w0); load8f(A.convw + 256 + cc8, w1); load8f(A.convw + 512 + cc8, w2);
#pragma unroll
        for (int i2 = 0; i2 < 2; ++i2) { const int j = cj + 16 * (2 * hb + i2), t = t0 + j; const size_t row = (size_t)r0 + j;
            float gb[8], gc[8], hh[8], z0[8], z1[8], z2[8];
            unpack8(cgb[i2], gb); unpack8(cgc[i2][0], gc); unpack8(chh[i2][0], hh);
#pragma unroll
            for (int q = 0; q < 8; ++q) z0[q] = gc[q] * hh[q];
            unpack8(cgc[i2][1], gc); unpack8(chh[i2][1], hh);
#pragma unroll
            for (int q = 0; q < 8; ++q) z1[q] = gc[q] * hh[q];
            unpack8(cgc[i2][2], gc); unpack8(chh[i2][2], hh);
#pragma unroll
            for (int q = 0; q < 8; ++q) z2[q] = gc[q] * hh[q];
            if (t < 2) {
                if (t < 1) { if (!prompt) load8f(A.st_conv + ((size_t)sb * 2 + 1) * 256 + cc8, z1); else {
#pragma unroll
                        for (int q = 0; q < 8; ++q) z1[q] = 0.f; } }
                if (!prompt) load8f(A.st_conv + ((size_t)sb * 2 + t) * 256 + cc8, z2); else {
#pragma unroll
                    for (int q = 0; q < 8; ++q) z2[q] = 0.f; } }
            float o[8];
#pragma unroll
            for (int q = 0; q < 8; ++q) o[q] = gb[q] * (w0[q] * z2[q] + w1[q] * z1[q] + w2[q] * z0[q]);
            *(u32x4*)(A.cat + row * D + 768 + cc8) = pack8(o);
            const int tl = prompt ? 8190 : 62;
            if (t >= tl) { float* o2 = (prompt ? A.o_conv_p + ((size_t)(blk >> 7) * 2 + (t - tl)) * 256 : A.o_conv_s + ((size_t)sb * 2 + (t - tl)) * 256) + cc8;
                *(f32x4*)o2 = (f32x4){z0[0], z0[1], z0[2], z0[3]}; *(f32x4*)(o2 + 4) = (f32x4){z0[4], z0[5], z0[6], z0[7]}; } }
    }
#pragma unroll
    for (int i = 0; i < 5; ++i) { const int idx = tid + i * NTHR, tr = idx >> 5, cc = idx & 31; if (idx < 79 * 32) *(LAS u32x4*)(xt + tr * XS + cc * 8) = tw[i]; }
    __syncthreads();
#pragma unroll 1
    for (int tt = 0; tt < 2; ++tt) {
        f32x4 acc[4];
#pragma unroll
        for (int b = 0; b < 4; ++b) acc[b] = (f32x4){0.f, 0.f, 0.f, 0.f};
        const int j = half * 32 + tt * 16 + fr, ti = 15 + j;
        const int pos = t0 + j; const float cnt = prompt ? (float)min(pos + 1, w) : (float)w; const float inv = 1.f / cnt;
#pragma unroll
        for (int ks = 0; ks < 2; ++ks) { const int c = g * 64 + ks * 32 + fq * 8;
            float sum[8] = {0.f, 0.f, 0.f, 0.f, 0.f, 0.f, 0.f, 0.f}, x0[8];
#pragma unroll 2
            for (int k = 0; k < w; ++k) { float x[8]; unpack8(*(const LAS u32x4*)(xt + (ti - k) * XS + c), x);
#pragma unroll
                for (int q = 0; q < 8; ++q) sum[q] += x[q]; }
            unpack8(*(const LAS u32x4*)(xt + ti * XS + c), x0);
            float df[8];
#pragma unroll
            for (int q = 0; q < 8; ++q) df[q] = sum[q] * inv - x0[q];
            const u32x4 dw = pack8(df); bf16x8 dfr; __builtin_memcpy(&dfr, &dw, 16);
#pragma unroll
            for (int et = 0; et < 4; ++et) acc[et] = __builtin_amdgcn_mfma_f32_16x16x32_bf16(wf[ks][et], dfr, acc[et], 0, 0, 0); }
        const size_t row = (size_t)r0 + j;
#pragma unroll
        for (int et = 0; et < 4; ++et) { const int e = g * 64 + et * 16 + fq * 4; const f32x4 sc = *(const f32x4*)(A.pscale + e);
            u32x2 o; o.x = cvt_pk_bf16(acc[et][0] * sc[0], acc[et][1] * sc[1]); o.y = cvt_pk_bf16(acc[et][2] * sc[2], acc[et][3] * sc[3]);
            *(u32x2*)(A.cat + row * D + 512 + e) = o; } }
    if (!prompt || bi == 127) { float* dst = prompt ? A.o_pool_p + (size_t)(blk >> 7) * 15 * 256 : A.o_pool_s + (size_t)sb * 15 * 256;
        for (int idx = tid; idx < 15 * 256; idx += NTHR) { const int i = idx >> 8, c = idx & 255; dst[i * 256 + c] = bf2f(xt[(15 + 49 + i) * XS + c]); } }
    __syncthreads();
}
__device__ __forceinline__ void mix_phase(LAS unsigned char* lds, const MixArgs& A, int tid, int wid, int lane) {
    const int c = blockIdx.x, G = gridDim.x;
    constexpr int NA = T / 128, NB = T / 64;
    const int nA = (NA + G - 1) / G, nB = (NB + G - 1) / G;
#pragma unroll 1
    for (int i = 0; i < nA + nB; ++i) {
        int type = -1, idx = 0;
        if (G == 256) {
            if (i < 2) { type = 0; idx = c + 256 * i; }
            else if (c < 16) { if (i == 2) { type = 0; idx = 512 + c; } else if (i < 5) { type = 1; idx = 2 * c + (i - 3); } }
            else { const int j = c - 16; if (i < 6) { type = 1; idx = 32 + j + 240 * (i - 2); } else if (i == 6 && j < 64) { type = 1; idx = 992 + j; } }
        } else {
            if (i < nA) { idx = c + G * i; type = idx < NA ? 0 : -1; } else { idx = c + G * (i - nA); type = idx < NB ? 1 : -1; }
        }
        type = __builtin_amdgcn_readfirstlane(type); idx = __builtin_amdgcn_readfirstlane(idx);
#ifndef REP_MIXA
#define REP_MIXA 1
#endif
#ifndef REP_MIXB
#define REP_MIXB 1
#endif
        if (type == 0) { for (int r = 0; r < REP_MIXA; ++r) mix_chunk_unit(lds, A, idx, tid, wid, lane); }
        else if (type == 1) { for (int r = 0; r < REP_MIXB; ++r) mix_pool_conv_block(lds, A, idx, tid, wid, lane); }
    }
}

__device__ __forceinline__ void finalize_stats(const float* part, float* fin, int nrows) {
    typedef float f32x2v __attribute__((ext_vector_type(2)));
    for (int row = blockIdx.x * NTHR + threadIdx.x; row < nrows; row += gridDim.x * NTHR) {
        const f32x4 a = *(const f32x4*)(part + (size_t)row * 8), b = *(const f32x4*)(part + (size_t)row * 8 + 4);
        const float S = (a[0] + a[2]) + (b[0] + b[2]), Q = (a[1] + a[3]) + (b[1] + b[3]);
        const float mu = S * (1.f / 1024.f), var = fmaxf(Q * (1.f / 1024.f) - mu * mu, 0.f);
        *(f32x2v*)(fin + (size_t)row * 2) = (f32x2v){mu, rsqrtf(var + pg8::LN_EPS)};
    }
}
__device__ __forceinline__ bool split_on(int G) { return pg8::split_ok(T, TP, D, G); }
__device__ __forceinline__ void finalize_sample(const float* part, const bf16_t* R, const float* stats_in, const float* g, const float* b, bf16_t* O, float* fin) {
    typedef float f32x2v __attribute__((ext_vector_type(2)));
    int tid_ = threadIdx.x; asm volatile("" : "+v"(tid_)); const int lane = tid_ & 63, wave = __builtin_amdgcn_readfirstlane(tid_ >> 6);
    for (int lr = blockIdx.x * NWAVES + wave; lr < TS; lr += gridDim.x * NWAVES) {
        const size_t row = (size_t)TP + lr; float mu = 0.f, rs = 1.f; if (stats_in) pg8::row_stats(stats_in, (int)row, mu, rs);
        float v[2][8], s = 0.f, q = 0.f;
#pragma unroll
        for (int hh = 0; hh < 2; ++hh) { const int c = hh * 512 + lane * 8; float r[8], gg[8], bb[8]; unpack8(*(const u32x4*)(R + row * D + c), r);
            if (stats_in) { load8f(g + c, gg); load8f(b + c, bb); }
#pragma unroll
            for (int k = 0; k < 8; ++k) v[hh][k] = pg8::ALPHA * (stats_in ? (r[k] - mu) * rs * gg[k] + bb[k] : r[k]);
#pragma unroll
            for (int sp = 0; sp < pg8::NSPLIT; ++sp) { float p8[8]; load8f(part + ((size_t)sp * TS + lr) * D + c, p8);
#pragma unroll
                for (int k = 0; k < 8; ++k) v[hh][k] += p8[k]; }
#pragma unroll
            for (int k = 0; k < 8; ++k) { s += v[hh][k]; q += v[hh][k] * v[hh][k]; }
            *(u32x4*)(O + row * D + c) = pack8(v[hh]); }
        s = wave_sum(s); q = wave_sum(q);
        const float m2 = s * (1.f / 1024.f), var = fmaxf(q * (1.f / 1024.f) - m2 * m2, 0.f);
        if (lane == 0) *(f32x2v*)(fin + row * 2) = (f32x2v){m2, rsqrtf(var + pg8::LN_EPS)};
    }
}
typedef const __attribute__((address_space(4))) Params* ParamsPtr;
#define GETP() ParamsPtr pp; { auto kp_ = __builtin_amdgcn_kernarg_segment_ptr(); asm volatile("" : "+s"(kp_)); pp = (ParamsPtr)kp_; } unsigned char* ws = pp->ws; int l = lc; asm volatile("" : "+s"(l));
__global__ void __launch_bounds__(NTHR, 2) fwd_megakernel(Params p_unused) {
    extern __shared__ __attribute__((aligned(16))) unsigned char lds_raw[];
    LAS unsigned char* lds = (LAS unsigned char*)lds_raw;
    cg::grid_group grid = cg::this_grid();
    const int tid = threadIdx.x;
    if (gridDim.x == 0x7fffffffu) grid.sync();
    volatile LAS unsigned* MISC = (volatile LAS unsigned*)(lds + MISC_OFF);
    if (tid < 16) MISC[tid] = 0u;
    __syncthreads();
    { auto kp0 = __builtin_amdgcn_kernarg_segment_ptr(); (void)xcd_barrier_post((unsigned*)(((ParamsPtr)kp0)->ws + WS_BAR), MISC); }
#define GRIDBAR() do { auto kpb_ = __builtin_amdgcn_kernarg_segment_ptr(); asm volatile("" : "+s"(kpb_)); XcdBarrier xb_; xb_.bar = (unsigned*)(((ParamsPtr)kpb_)->ws + WS_BAR); xb_.x = xb_xcc_id(); \
        xb_.st = (volatile LAS unsigned*)((LAS unsigned char*)lds_raw + MISC_OFF); xcd_barrier(xb_); } while (0)
#ifndef NO_P0
    for (int rep = 0; rep < REP_P0; ++rep) { const int lc = 0; GETP(); (void)l; (void)ws; Params p; for (int i = 0; i < 20; ++i) p.in[i] = pp->in[i]; p.out = pp->out; p.ws = pp->ws;
      int tid0 = threadIdx.x; asm volatile("" : "+v"(tid0)); p0_phase(p, lds, __builtin_amdgcn_readfirstlane(tid0 >> 6), tid0 & 63); }
#endif
    GRIDBAR();

    for (int lc = 0; lc < DEPTH; ++lc) {
#ifndef NO_G1
        for (int rep = 0; rep < REP_G1; ++rep) { GETP(); const int G = gridDim.x;
          pg8::Gemm g{(const bf16_t*)(ws + (l ? WS_P2 : WS_XB)), (const bf16_t*)(ws + WS_WIN + l * SZ_WIN), T, DIN, D}; pg8::StaticOrder S; S.init(T, DIN, D, G, (int)blockIdx.x);
          pg8::EpiProj E{(bf16_t*)(ws + WS_PROJ), DIN, l ? (const float*)(ws + WS_ST2) : nullptr, (const float*)(ws + WS_C1IN) + l * DIN, (const float*)(ws + WS_C2IN) + l * DIN};
          pg8::gemm_phase<pg8::EpiProj, pg8::StaticOrder, true, true>(lds, g, S, E); }
#endif
        GRIDBAR();
#ifndef NO_MIX
        for (int rep = 0; rep < REP_MIX; ++rep) { GETP(); const int G = gridDim.x; float* out = pp->out;
          MixArgs A; A.proj = (const bf16_t*)(ws + WS_PROJ); A.cat = (bf16_t*)(ws + WS_CAT); A.vg = pp->in[7] + l * 512; A.vb = pp->in[8] + l * 512; A.wsb = (const bf16_t*)(ws + WS_WSB + l * SZ_WSB); A.bsp = pp->in[10] + l * 8 * 128;
          A.wpt = (const bf16_t*)(ws + WS_WPT + l * SZ_WPT); A.pscale = pp->in[12] + l * 256; A.convw = pp->in[13] + l * 3 * 256; A.st_pool = pp->in[2] + (size_t)l * 32 * 15 * 256; A.st_conv = pp->in[3] + (size_t)l * 32 * 2 * 256;
          A.o_pool_p = out + O_POOLP + (size_t)l * 8 * 15 * 256; A.o_pool_s = out + O_POOLS + (size_t)l * 32 * 15 * 256; A.o_conv_p = out + O_CONVP + (size_t)l * 8 * 2 * 256; A.o_conv_s = out + O_CONVS + (size_t)l * 32 * 2 * 256;
          A.o_v = out + O_V + (size_t)l * 32 * 64 * 512;
          int tid2 = threadIdx.x; asm volatile("" : "+v"(tid2)); const int lane2 = tid2 & 63, wid2 = __builtin_amdgcn_readfirstlane(tid2 >> 6);
          (void)G; mix_phase(lds, A, tid2, wid2, lane2); }
#endif
        GRIDBAR();
#ifndef NO_G2
        for (int rep = 0; rep < REP_G2; ++rep) { GETP(); const int G = gridDim.x;
          pg8::Gemm g{(const bf16_t*)(ws + WS_CAT), (const bf16_t*)(ws + WS_WOUT + l * SZ_WOUT), T, D, D}; const bool sp = split_on(G); pg8::StaticOrder S; S.init(sp ? TP : T, D, D, G, (int)blockIdx.x, WGM_G2);
          pg8::EpiRes<4> E{(bf16_t*)(ws + WS_P1), (const bf16_t*)(ws + (l ? WS_P2 : WS_XB)), l ? (const float*)(ws + WS_ST2) : nullptr, pp->in[15] + (l - 1) * D, pp->in[16] + (l - 1) * D, (float*)(ws + WS_ST1P), (LAS float*)(lds + PST_OFF), 1.f};
          pg8::gemm_phase<pg8::EpiRes<4>, pg8::StaticOrder, true, true>(lds, g, S, E);
          if (sp) { pg8::TailSplitOrder S2; S2.init(TP, D, D, (int)blockIdx.x); pg8::EpiPart E2{(float*)(ws + WS_PART), TP, TS, 1.f}; pg8::gemm_phase<pg8::EpiPart, pg8::TailSplitOrder, true, true>(lds, g, S2, E2); } }
#endif
        GRIDBAR();
        { GETP(); const bool sp = split_on((int)gridDim.x); finalize_stats((const float*)(ws + WS_ST1P), (float*)(ws + WS_ST1), sp ? TP : T);
          if (sp) finalize_sample((const float*)(ws + WS_PART), (const bf16_t*)(ws + (l ? WS_P2 : WS_XB)), l ? (const float*)(ws + WS_ST2) : nullptr, pp->in[15] + (l - 1) * D, pp->in[16] + (l - 1) * D, (bf16_t*)(ws + WS_P1), (float*)(ws + WS_ST1)); }
        GRIDBAR();
#ifndef NO_G3
        for (int rep = 0; rep < REP_G3; ++rep) { GETP(); const int G = gridDim.x;
          pg8::Gemm g{(const bf16_t*)(ws + WS_P1), (const bf16_t*)(ws + WS_WGU + l * SZ_WGU), T, NGU, D}; pg8::StaticOrder S; S.init(T, NGU, D, G, (int)blockIdx.x);
          if (F8_LAST && l == DEPTH - 1) { pg8::EpiSwiGLU<true> E{(bf16_t*)(ws + WS_HID), DFF, (const float*)(ws + WS_ST1), (const float*)(ws + WS_C1GU) + l * NGU, (const float*)(ws + WS_C2GU) + l * NGU};
              pg8::gemm_phase<pg8::EpiSwiGLU<true>, pg8::StaticOrder, true, true>(lds, g, S, E); }
          else { pg8::EpiSwiGLU<false> E{(bf16_t*)(ws + WS_HID), DFF, (const float*)(ws + WS_ST1), (const float*)(ws + WS_C1GU) + l * NGU, (const float*)(ws + WS_C2GU) + l * NGU};
              pg8::gemm_phase<pg8::EpiSwiGLU<false>, pg8::StaticOrder, true, true>(lds, g, S, E); } }
#endif
        GRIDBAR();
#ifndef NO_G4
        for (int rep = 0; rep < REP_G4; ++rep) { GETP(); const int G = gridDim.x;
          const bool sp = split_on(G);
          if (F8_LAST && l == DEPTH - 1) {
              pg8::Gemm g{(const bf16_t*)(ws + WS_HID), (const bf16_t*)(ws + WS_WD + l * SZ_WD), T, D, DFF / 2}; pg8::StaticOrder S; S.init(T, D, DFF / 2, G, (int)blockIdx.x, WGM_G4);
              pg8::EpiRaw E{(bf16_t*)(ws + WS_P2), D, 1.f / WD8_SCALE};
              pg8::gemm_phase<pg8::EpiRaw, pg8::StaticOrder, true, true, true>(lds, g, S, E);
          } else {
              pg8::Gemm g{(const bf16_t*)(ws + WS_HID), (const bf16_t*)(ws + WS_WD + l * SZ_WD), T, D, DFF}; pg8::StaticOrder S; S.init(sp ? TP : T, D, DFF, G, (int)blockIdx.x, WGM_G4);
              pg8::EpiRes<4> E{(bf16_t*)(ws + WS_P2), (const bf16_t*)(ws + WS_P1), (const float*)(ws + WS_ST1), pp->in[4] + l * D, pp->in[5] + l * D, (float*)(ws + WS_ST2P), (LAS float*)(lds + PST_OFF), 1.f};
              pg8::gemm_phase<pg8::EpiRes<4>, pg8::StaticOrder, true, true>(lds, g, S, E);
              if (sp) { pg8::TailSplitOrder S2; S2.init(TP, D, DFF, (int)blockIdx.x); pg8::EpiPart E2{(float*)(ws + WS_PART), TP, TS, 1.f}; pg8::gemm_phase<pg8::EpiPart, pg8::TailSplitOrder, true, true>(lds, g, S2, E2); } } }
#endif
        GRIDBAR();
        if (!(F8_LAST && lc == DEPTH - 1)) {
        { GETP(); const bool sp = split_on((int)gridDim.x); finalize_stats((const float*)(ws + WS_ST2P), (float*)(ws + WS_ST2), sp ? TP : T);
          if (sp) finalize_sample((const float*)(ws + WS_PART), (const bf16_t*)(ws + WS_P1), (const float*)(ws + WS_ST1), pp->in[4] + l * D, pp->in[5] + l * D, (bf16_t*)(ws + WS_P2), (float*)(ws + WS_ST2)); }
        GRIDBAR();
        }
        for (int rep = 1; rep < REP_SYNC; ++rep) GRIDBAR();
    }
    for (int rep = 0; rep < REP_FIN; ++rep) { const int lc = DEPTH - 1; GETP(); const int G = gridDim.x; float* out = pp->out;
      const float* gF = pp->in[15] + l * D; const float* bF = pp->in[16] + l * D; const bf16_t* P2 = (const bf16_t*)(ws + WS_P2); const float* ST2 = (const float*)(ws + WS_ST2);
      int tidf = threadIdx.x; asm volatile("" : "+v"(tidf)); const int lane = tidf & 63, wid = __builtin_amdgcn_readfirstlane(tidf >> 6);
      const int gw = blockIdx.x * NWAVES + wid, NGW = G * NWAVES;
      float gv[2][8], bv[2][8]; load8f(gF + lane * 8, gv[0]); load8f(gF + 512 + lane * 8, gv[1]); load8f(bF + lane * 8, bv[0]); load8f(bF + 512 + lane * 8, bv[1]);
#if F8_LAST
      const float* gM = pp->in[4] + l * D; const float* bM = pp->in[5] + l * D; const bf16_t* P1 = (const bf16_t*)(ws + WS_P1); const float* ST1 = (const float*)(ws + WS_ST1);
      float g1[2][8], b1[2][8]; load8f(gM + lane * 8, g1[0]); load8f(gM + 512 + lane * 8, g1[1]); load8f(bM + lane * 8, b1[0]); load8f(bM + 512 + lane * 8, b1[1]);
#pragma unroll 2
      for (int row = gw; row < T; row += NGW) { float mu1, rs1; pg8::row_stats(ST1, row, mu1, rs1);
          float v[2][8], s = 0.f, q2 = 0.f;
#pragma unroll
          for (int hh = 0; hh < 2; ++hh) { float p[8], f[8]; unpack8(*(const u32x4*)(P1 + (size_t)row * D + hh * 512 + lane * 8), p); unpack8(*(const u32x4*)(P2 + (size_t)row * D + hh * 512 + lane * 8), f);
#pragma unroll
              for (int q = 0; q < 8; ++q) { const float x = pg8::ALPHA * ((p[q] - mu1) * rs1 * g1[hh][q] + b1[hh][q]) + f[q]; v[hh][q] = x; s += x; q2 += x * x; } }
          s = wave_sum(s); q2 = wave_sum(q2);
          const float mu = s * (1.f / 1024.f), rs = rsqrtf(fmaxf(q2 * (1.f / 1024.f) - mu * mu, 0.f) + pg8::LN_EPS);
#pragma unroll
          for (int hh = 0; hh < 2; ++hh) { float* o = out + (size_t)row * D + hh * 512 + lane * 8; float f[8];
#pragma unroll
              for (int q = 0; q < 8; ++q) f[q] = (v[hh][q] - mu) * rs * gv[hh][q] + bv[hh][q];
              *(f32x4*)o = (f32x4){f[0], f[1], f[2], f[3]}; *(f32x4*)(o + 4) = (f32x4){f[4], f[5], f[6], f[7]}; } }
      (void)ST2;
#else
#pragma unroll 2
      for (int row = gw; row < T; row += NGW) { float mu, rs; pg8::row_stats(ST2, row, mu, rs);
#pragma unroll
          for (int hh = 0; hh < 2; ++hh) { float f[8]; unpack8(*(const u32x4*)(P2 + (size_t)row * D + hh * 512 + lane * 8), f); float* o = out + (size_t)row * D + hh * 512 + lane * 8;
#pragma unroll
              for (int q = 0; q < 8; ++q) f[q] = (f[q] - mu) * rs * gv[hh][q] + bv[hh][q];
              *(f32x4*)o = (f32x4){f[0], f[1], f[2], f[3]}; *(f32x4*)(o + 4) = (f32x4){f[4], f[5], f[6], f[7]}; } }
#endif
    }
}

extern "C" void kernel_launch(void* const* d_in, const int* in_sizes, int n_in, void* d_out, int out_size, void* d_ws, size_t ws_size, hipStream_t stream) {
    static int grid = 0;
    if (grid == 0) {
        if (n_in != 20 || (size_t)out_size != O_END || ws_size < WS_END) { fprintf(stderr, "kernel_launch: unexpected sizes n_in %d out %d (want %zu) ws %zu (want %zu)\n", n_in, out_size, (size_t)O_END, ws_size, (size_t)WS_END); grid = -1; return; }
        int dev = 0, cus = 0, per_cu = 0;
        if (hipGetDevice(&dev) != hipSuccess || hipDeviceGetAttribute(&cus, hipDeviceAttributeMultiprocessorCount, dev) != hipSuccess) { grid = -1; return; }
        if (hipFuncSetAttribute((const void*)fwd_megakernel, hipFuncAttributeMaxDynamicSharedMemorySize, LDS_BYTES) != hipSuccess) { fprintf(stderr, "kernel_launch: hipFuncSetAttribute failed\n"); grid = -1; return; }
        if (hipOccupancyMaxActiveBlocksPerMultiprocessor(&per_cu, (const void*)fwd_megakernel, NTHR, LDS_BYTES) != hipSuccess || per_cu < 1) { fprintf(stderr, "kernel_launch: occupancy query reports %d\n", per_cu); (void)hipGetLastError(); per_cu = 1; }
        grid = cus;
    }
    if (grid < 0) return;
    if (hipMemsetAsync((char*)d_ws + WS_BAR, 0, BAR_BYTES, stream) != hipSuccess) { fprintf(stderr, "kernel_launch: memset of the barrier words failed\n"); return; }
    Params p{};
    for (int i = 0; i < 20; ++i) p.in[i] = (const float*)d_in[i];
    p.out = (float*)d_out; p.ws = (unsigned char*)d_ws;
    void* args[] = {&p};
    const hipError_t e = hipLaunchCooperativeKernel((const void*)fwd_megakernel, dim3(grid), dim3(NTHR), args, LDS_BYTES, stream);
    if (e != hipSuccess) fprintf(stderr, "kernel_launch: cooperative launch failed: %s (grid %d)\n", hipGetErrorString(e), grid);
}
```

```cpp
#include <hip/hip_runtime.h>
#include <hip/hip_cooperative_groups.h>
#include <cstdio>
#include <cstdint>
namespace cg = cooperative_groups;
#define WGM_G2 8
#define WGM_G4 8
namespace pg8 {
#define PG8_LAS __attribute__((address_space(3)))
typedef unsigned short bf16_t;
typedef short bf16x8 __attribute__((ext_vector_type(8)));
typedef float f32x4 __attribute__((ext_vector_type(4)));
typedef unsigned u32x4 __attribute__((ext_vector_type(4)));
typedef int i32x4 __attribute__((ext_vector_type(4)));
typedef int i32x8 __attribute__((ext_vector_type(8)));
constexpr int BM = 256, BK = 64, HALF = 128, HTB = HALF * BK * 2  , STAGE_BYTES = 8 * HTB, NXCD = 8, WGM = 6;

__host__ __device__ __forceinline__ int lds_byte(int r, int c) { const int st = (r >> 4) * 2 + (c >> 5), rr = r & 15, cc = c & 31, ob = rr * 64 + cc * 2; return st * 1024 + (ob ^ (((ob >> 9) & 1) << 5)); }
__host__ __device__ __forceinline__ void stage_rc(int b, int& R, int& C) { const int st = b / 1024, sb = b % 1024, swz = sb ^ (((sb >> 9) & 1) << 5); R = (st >> 1) * 16 + swz / 64; C = (st & 1) * 32 + (swz % 64) / 2; }
__host__ __device__ __forceinline__ int perm32(int rho) { const int n = rho >> 4, i = rho & 15; return 8 * (i >> 2) + 4 * n + (i & 3); }

struct Unit { int pm, pn, k0, nt, split; };
struct Gemm { const bf16_t* A; const bf16_t* Bt; int M, N, K; };

struct StaticOrder {
    int nM, nN, nwg, G, c, ntf, wgm;
    __host__ __device__ void init(int M, int N, int K, int G_, int c_, int wgm_ = WGM) { nM = M / BM; nN = N / BM; nwg = nM * nN; G = G_; c = c_; ntf = K / BK; wgm = wgm_; }
    __host__ __device__ bool next(int i, Unit& u) const {
        const long L = (long)i * G + c; if (L >= nwg) return false;
        int wgid = (int)L; { const int q = nwg / NXCD, r = nwg % NXCD, xcd = wgid % NXCD, off = wgid / NXCD; wgid = (xcd < r ? xcd * (q + 1) : r * (q + 1) + (xcd - r) * q) + off; }
        const int nig = wgm * nN, gid = wgid / nig, fm = gid * wgm, gsz = (nM - fm) < wgm ? (nM - fm) : wgm;
        u.pm = fm + ((wgid % nig) % gsz); u.pn = (wgid % nig) / gsz; u.k0 = 0; u.nt = ntf; u.split = -1; return true;
    }
    __device__ __forceinline__ void a_ready(const Unit&) const {}
    __device__ __forceinline__ void done(const Unit&) const {}
};
constexpr int NSPLIT = 4;
__host__ __device__ __forceinline__ bool split_ok(int Mfull, int Mprompt, int N, int G) { const int nN = N / BM; return (G >= 8 * nN * NSPLIT) && ((Mprompt / BM * nN) % G == 0) && ((Mfull - Mprompt) / BM == 8); }
struct TailSplitOrder {
    int pm0, nN, c, q, rem;
    __host__ __device__ void init(int Mprompt, int N, int K, int c_) { nN = N / BM; pm0 = Mprompt / BM; c = c_; const int ntf = K / BK; q = (ntf / NSPLIT) & ~1; rem = ntf - q * NSPLIT; }
    __host__ __device__ bool next(int i, Unit& u) const {
        if (i > 0 || c >= 8 * nN * NSPLIT) return false;
        const int tu = c % (8 * nN), s = c / (8 * nN), first_big = NSPLIT - rem / 2;
        u.pm = pm0 + tu / nN; u.pn = tu % nN; u.k0 = s * q + (s > first_big ? 2 * (s - first_big) : 0); u.nt = q + (s >= first_big ? 2 : 0); u.split = s; return true;
    }
    __device__ __forceinline__ void a_ready(const Unit&) const {}
    __device__ __forceinline__ void done(const Unit&) const {}
};
__device__ __forceinline__ unsigned cvt_pk_bf16(float lo, float hi) { unsigned r; asm volatile("v_cvt_pk_bf16_f32 %0, %1, %2" : "=v"(r) : "v"(lo), "v"(hi)); return r; }
constexpr float LN_EPS = 1e-5f;
constexpr float ALPHA = 1.41421356237309515f;
typedef unsigned u32x2 __attribute__((ext_vector_type(2)));
__device__ __forceinline__ void unpack8(const u32x4 w, float (&f)[8]) {
    f[0] = __uint_as_float(w.x << 16); f[1] = __uint_as_float(w.x & 0xffff0000u); f[2] = __uint_as_float(w.y << 16); f[3] = __uint_as_float(w.y & 0xffff0000u);
    f[4] = __uint_as_float(w.z << 16); f[5] = __uint_as_float(w.z & 0xffff0000u); f[6] = __uint_as_float(w.w << 16); f[7] = __uint_as_float(w.w & 0xffff0000u);
}
__device__ __forceinline__ void unpack4(const u32x2 w, float (&f)[4]) {
    f[0] = __uint_as_float(w.x << 16); f[1] = __uint_as_float(w.x & 0xffff0000u); f[2] = __uint_as_float(w.y << 16); f[3] = __uint_as_float(w.y & 0xffff0000u);
}
__device__ __forceinline__ u32x4 pack8(const float (&f)[8]) { u32x4 w; w.x = cvt_pk_bf16(f[0], f[1]); w.y = cvt_pk_bf16(f[2], f[3]); w.z = cvt_pk_bf16(f[4], f[5]); w.w = cvt_pk_bf16(f[6], f[7]); return w; }
__device__ __forceinline__ void row_stats(const float* st, int row, float& mu, float& rstd) {
    typedef float f32x2v __attribute__((ext_vector_type(2)));
    const f32x2v a = *(const f32x2v*)(st + (size_t)row * 2); mu = a[0]; rstd = a[1];
}
__device__ __forceinline__ void load8f(const float* p, float (&f)[8]) { const f32x4 a = *(const f32x4*)p, b = *(const f32x4*)(p + 4); f[0] = a[0]; f[1] = a[1]; f[2] = a[2]; f[3] = a[3]; f[4] = b[0]; f[5] = b[1]; f[6] = b[2]; f[7] = b[3]; }

struct EpiProj {
    static constexpr bool PERM = true, AFTER_DRAIN = false;
    bf16_t* O; int ldo; const float* stats; const float* c1; const float* c2;
    __device__ __forceinline__ void operator()(f32x4 (&acc)[2][2][4][2], const Unit& u, int wr, int wc, int fr, int fq) const {
        const int row0 = u.pm * BM + wr * 64 + fr, col0 = u.pn * BM + wc * 32 + 8 * fq;
        const bool ln = stats != nullptr;
        float rs8[8], nm8[8];
#pragma unroll
        for (int i = 0; i < 8; ++i) { float mu = 0.f; rs8[i] = 1.f; if (ln) row_stats(stats, row0 + (i >> 2) * HALF + (i & 3) * 16, mu, rs8[i]); nm8[i] = -rs8[i] * mu; }
#pragma unroll
        for (int bj = 0; bj < 2; ++bj) {
            float k1[8], k2[8];
            if (ln) { load8f(c1 + col0 + bj * HALF, k1); load8f(c2 + col0 + bj * HALF, k2); }
            else {
#pragma unroll
                for (int q = 0; q < 8; ++q) { k1[q] = 0.f; k2[q] = 0.f; } }
#pragma unroll
            for (int ai = 0; ai < 2; ++ai)
#pragma unroll
                for (int m = 0; m < 4; ++m) {
                    const float rs = rs8[ai * 4 + m], nm = nm8[ai * 4 + m];
#pragma unroll
                    for (int q = 0; q < 4; ++q) { acc[ai][bj][m][0][q] = rs * acc[ai][bj][m][0][q] + (nm * k1[q] + k2[q]); acc[ai][bj][m][1][q] = rs * acc[ai][bj][m][1][q] + (nm * k1[4 + q] + k2[4 + q]); }
                }
        }
        asm volatile("" ::: "memory");
#pragma unroll
        for (int ai = 0; ai < 2; ++ai)
#pragma unroll
            for (int m = 0; m < 4; ++m) {
                const int row = row0 + ai * HALF + m * 16;
#pragma unroll
                for (int bj = 0; bj < 2; ++bj) { u32x4 w; w.x = cvt_pk_bf16(acc[ai][bj][m][0][0], acc[ai][bj][m][0][1]); w.y = cvt_pk_bf16(acc[ai][bj][m][0][2], acc[ai][bj][m][0][3]);
                    w.z = cvt_pk_bf16(acc[ai][bj][m][1][0], acc[ai][bj][m][1][1]); w.w = cvt_pk_bf16(acc[ai][bj][m][1][2], acc[ai][bj][m][1][3]);
                    *(u32x4*)(O + (size_t)row * ldo + col0 + bj * HALF) = w; }
            }
    }
};
template <bool F8OUT> struct EpiSwiGLU {
    static constexpr bool PERM = true, AFTER_DRAIN = false;
    bf16_t* O; int ldo; const float* stats; const float* c1; const float* c2;
    __device__ __forceinline__ void operator()(f32x4 (&acc)[2][2][4][2], const Unit& u, int wr, int wc, int fr, int fq) const {
        const int row0 = u.pm * BM + wr * 64 + fr, cidx = u.pn * BM + wc * 32 + 8 * fq, ocol = u.pn * HALF + wc * 32 + 8 * fq;
        float rs8[8], nm8[8];
#pragma unroll
        for (int i = 0; i < 8; ++i) { float mu; row_stats(stats, row0 + (i >> 2) * HALF + (i & 3) * 16, mu, rs8[i]); nm8[i] = -rs8[i] * mu; }
        float k1g[8], k2g[8], k1u[8], k2u[8];
        load8f(c1 + cidx, k1g); load8f(c2 + cidx, k2g); load8f(c1 + cidx + HALF, k1u); load8f(c2 + cidx + HALF, k2u);
#pragma unroll
        for (int ai = 0; ai < 2; ++ai)
#pragma unroll
            for (int m = 0; m < 4; ++m) {
                const int row = row0 + ai * HALF + m * 16;
                const float rs = rs8[ai * 4 + m], nm = nm8[ai * 4 + m];
                float o[8];
#pragma unroll
                for (int q = 0; q < 8; ++q) {
                    const float ga = (q < 4) ? acc[ai][0][m][0][q & 3] : acc[ai][0][m][1][q & 3], ua = (q < 4) ? acc[ai][1][m][0][q & 3] : acc[ai][1][m][1][q & 3];
                    const float g = rs * ga + (nm * k1g[q] + k2g[q]), up = rs * ua + (nm * k1u[q] + k2u[q]);
                    o[q] = g * __builtin_amdgcn_rcpf(1.f + __expf(-g)) * up;
                }
                if constexpr (F8OUT) { int w0 = 0, w1 = 0; w0 = __builtin_amdgcn_cvt_pk_fp8_f32(o[0], o[1], w0, false); w0 = __builtin_amdgcn_cvt_pk_fp8_f32(o[2], o[3], w0, true);
                    w1 = __builtin_amdgcn_cvt_pk_fp8_f32(o[4], o[5], w1, false); w1 = __builtin_amdgcn_cvt_pk_fp8_f32(o[6], o[7], w1, true);
                    u32x2 w; w.x = (unsigned)w0; w.y = (unsigned)w1; *(u32x2*)((unsigned char*)O + (size_t)row * ldo + ocol) = w; }
                else *(u32x4*)(O + (size_t)row * ldo + ocol) = pack8(o);
            }
    }
};
template <int RB> struct EpiRes {
    static constexpr bool PERM = true, AFTER_DRAIN = false;
    bf16_t* O; const bf16_t* R; const float* stats_in; const float* g; const float* b; float* stats_out; PG8_LAS float* pst; float accscale;
    __device__ __forceinline__ void operator()(f32x4 (&acc)[2][2][4][2], const Unit& u, int wr, int wc, int fr, int fq) const {
        const int row0 = u.pm * BM + wr * 64 + fr, col0 = u.pn * BM + wc * 32 + 8 * fq;
        const bool ln = stats_in != nullptr;
#pragma unroll
        for (int bj = 0; bj < 2; ++bj) {
            float gg[8], bb[8];
            if (ln) { load8f(g + col0 + bj * HALF, gg); load8f(b + col0 + bj * HALF, bb); }
            else {
#pragma unroll
                for (int q = 0; q < 8; ++q) { gg[q] = 1.f; bb[q] = 0.f; } }
#pragma unroll
            for (int ai = 0; ai < 2; ++ai)
#pragma unroll
            for (int mh = 0; mh < 4; mh += RB) {
                u32x4 rw[RB];
                asm volatile("" ::: "memory");
#pragma unroll
                for (int mm = 0; mm < RB; ++mm) rw[mm] = *(const u32x4*)((const char*)R + (size_t)(((unsigned)(row0 + ai * HALF + (mh + mm) * 16) * 1024u + (unsigned)(col0 + bj * HALF)) * 2u));
                float mu4[RB], rs4[RB];
#pragma unroll
                for (int mm = 0; mm < RB; ++mm) { mu4[mm] = 0.f; rs4[mm] = 1.f; if (ln) row_stats(stats_in, row0 + ai * HALF + (mh + mm) * 16, mu4[mm], rs4[mm]); }
#pragma unroll
                for (int mm = 0; mm < RB; ++mm) { const int m = mh + mm;
                    const float mu = mu4[mm], rs = rs4[mm];
                    float r[8]; unpack8(rw[mm], r);
#pragma unroll
                    for (int n = 0; n < 2; ++n)
#pragma unroll
                        for (int q4 = 0; q4 < 4; ++q4) { const int q = n * 4 + q4;
                            const float xr = (r[q] - mu) * rs * gg[q] + bb[q];
                            const float a = ALPHA * xr + accscale * acc[ai][bj][m][n][q4];
                            acc[ai][bj][m][n][q4] = a; }
                }
                if constexpr (RB == 4) asm volatile("" : "+v"(acc[ai][bj][0][0]), "+v"(acc[ai][bj][0][1]), "+v"(acc[ai][bj][1][0]), "+v"(acc[ai][bj][1][1]), "+v"(acc[ai][bj][2][0]), "+v"(acc[ai][bj][2][1]), "+v"(acc[ai][bj][3][0]), "+v"(acc[ai][bj][3][1]) :: "memory");
                else asm volatile("" : "+v"(acc[ai][bj][mh][0]), "+v"(acc[ai][bj][mh][1]), "+v"(acc[ai][bj][mh + 1][0]), "+v"(acc[ai][bj][mh + 1][1]) :: "memory");
            }
        }
        asm volatile("" ::: "memory");
#pragma unroll
        for (int ai = 0; ai < 2; ++ai)
#pragma unroll
            for (int m = 0; m < 4; ++m) {
                const int row = row0 + ai * HALF + m * 16;
                float s = 0.f, q2 = 0.f;
#pragma unroll
                for (int bj = 0; bj < 2; ++bj) {
#pragma unroll
                    for (int n = 0; n < 2; ++n)
#pragma unroll
                        for (int q4 = 0; q4 < 4; ++q4) { const float a = acc[ai][bj][m][n][q4]; s += a; q2 += a * a; }
                    u32x4 w; w.x = cvt_pk_bf16(acc[ai][bj][m][0][0], acc[ai][bj][m][0][1]); w.y = cvt_pk_bf16(acc[ai][bj][m][0][2], acc[ai][bj][m][0][3]);
                    w.z = cvt_pk_bf16(acc[ai][bj][m][1][0], acc[ai][bj][m][1][1]); w.w = cvt_pk_bf16(acc[ai][bj][m][1][2], acc[ai][bj][m][1][3]);
                    *(u32x4*)((char*)O + (size_t)(((unsigned)row * 1024u + (unsigned)(col0 + bj * HALF)) * 2u)) = w; }
                s += __shfl_xor(s, 16); s += __shfl_xor(s, 32); q2 += __shfl_xor(q2, 16); q2 += __shfl_xor(q2, 32);
                if (fq == 0) { PG8_LAS float* p = pst + ((ai * HALF + wr * 64 + m * 16 + fr) * 4 + wc) * 2; p[0] = s; p[1] = q2; }
            }
        asm volatile("s_waitcnt lgkmcnt(0)" ::: "memory"); __builtin_amdgcn_s_barrier(); asm volatile("" ::: "memory");
        if (threadIdx.x < 256) {
            const int row = threadIdx.x; const PG8_LAS f32x4* p = (const PG8_LAS f32x4*)(pst + row * 8);
            const f32x4 a = p[0], c = p[1];
            typedef float f32x2v __attribute__((ext_vector_type(2)));
            *(f32x2v*)(stats_out + ((size_t)(u.pm * BM + row) * 4 + u.pn) * 2) = (f32x2v){(a[0] + a[2]) + (c[0] + c[2]), (a[1] + a[3]) + (c[1] + c[3])};
        }
    }
};

struct EpiPart {
    static constexpr bool PERM = true, AFTER_DRAIN = false;
    float* part; int part_row0, part_rows; float accscale;
    __device__ __forceinline__ void operator()(f32x4 (&acc)[2][2][4][2], const Unit& u, int wr, int wc, int fr, int fq) const {
        const int row0 = u.pm * BM + wr * 64 + fr, col0 = u.pn * BM + wc * 32 + 8 * fq;
        const unsigned pb = (((unsigned)u.split * (unsigned)part_rows + (unsigned)(row0 - part_row0)) * 1024u + (unsigned)col0) * 4u;
#pragma unroll
        for (int ai = 0; ai < 2; ++ai)
#pragma unroll
            for (int m = 0; m < 4; ++m)
#pragma unroll
                for (int bj = 0; bj < 2; ++bj) { float* p = (float*)((char*)part + (size_t)(pb + (unsigned)((ai * HALF + m * 16) * 1024 + bj * HALF) * 4u)); *(f32x4*)p = acc[ai][bj][m][0] * accscale; *(f32x4*)(p + 4) = acc[ai][bj][m][1] * accscale; }
    }
};

struct EpiRaw {
    static constexpr bool PERM = true, AFTER_DRAIN = false;
    __device__ __forceinline__ void prefetch(const Unit&, PG8_LAS unsigned char*, int) const {}
    bf16_t* O; int ldo; float scale;
    __device__ __forceinline__ void operator()(f32x4 (&acc)[2][2][4][2], const Unit& u, int wr, int wc, int fr, int fq) const {
        const int row0 = u.pm * BM + wr * 64 + fr, col0 = u.pn * BM + wc * 32 + 8 * fq;
#pragma unroll
        for (int ai = 0; ai < 2; ++ai)
#pragma unroll
            for (int m = 0; m < 4; ++m)
#pragma unroll
                for (int bj = 0; bj < 2; ++bj) { u32x4 w; const f32x4 a = acc[ai][bj][m][0] * scale, b = acc[ai][bj][m][1] * scale;
                    w.x = cvt_pk_bf16(a[0], a[1]); w.y = cvt_pk_bf16(a[2], a[3]); w.z = cvt_pk_bf16(b[0], b[1]); w.w = cvt_pk_bf16(b[2], b[3]);
                    *(u32x4*)((char*)O + (size_t)(((unsigned)(row0 + ai * HALF + m * 16) * (unsigned)ldo + (unsigned)(col0 + bj * HALF)) * 2u)) = w; }
    }
};
template <class Epi, class Sched, bool ALIGN_EPI = false, bool SP2 = false, bool FP8 = false>
__device__ __forceinline__ void gemm_phase(PG8_LAS unsigned char* lds, const Gemm g, const Sched& S, const Epi& E) {
    int tid_ = threadIdx.x; asm volatile("" : "+v"(tid_));
    const int tid = tid_, wid = __builtin_amdgcn_readfirstlane(tid >> 6), lane = tid & 63, wr = wid >> 2, wc = wid & 3, fr = lane & 15, fq = lane >> 4;
    const int K = g.K;
    unsigned voffA[2], voffB[2];
#pragma unroll
    for (int i = 0; i < 2; ++i) { int R, C; stage_rc(tid * 16 + i * 8192, R, C); const int Rb = Epi::PERM ? ((R & ~31) + perm32(R & 31)) : R;
        voffA[i] = (unsigned)(R * K + C) * 2u; voffB[i] = (unsigned)(Rb * K + C) * 2u; }
    const size_t kstep = (size_t)(BK * 2);
    const size_t hstep = (size_t)HALF * K * 2;
    const size_t tstep = 2 * hstep;
    const unsigned ldsw = (unsigned)wid * 1024u;
    const int aoff = lds_byte(wr * 64 + fr, fq * 8), boff = lds_byte(wc * 32 + fr, fq * 8);
#define PG8_SA(b, h) (((b) * 2 + (h)) * HTB)
#define PG8_SB(b, h) ((4 + (b) * 2 + (h)) * HTB)
#define PG8_STAGE(bufoff, gbase, voff) do { _Pragma("unroll") for (int _i = 0; _i < 2; ++_i) \
        __builtin_amdgcn_global_load_lds((const unsigned*)((const char*)(gbase) + (voff)[_i]), (PG8_LAS unsigned*)(lds + (bufoff) + ldsw + _i * 8192), 16, 0, 0); } while (0)
#define PG8_LDA(dst, b, h) do { if constexpr (FP8) { _Pragma("unroll") for (int m = 0; m < 4; ++m) { const i32x4 lo_ = *(const PG8_LAS i32x4*)(lds + PG8_SA(b, h) + aoff + m * 2048), hi_ = *(const PG8_LAS i32x4*)(lds + PG8_SA(b, h) + aoff + m * 2048 + 1024); \
            dst##8[m] = __builtin_shufflevector(lo_, hi_, 0, 1, 2, 3, 4, 5, 6, 7); } } \
        else { _Pragma("unroll") for (int m = 0; m < 4; ++m) _Pragma("unroll") for (int k = 0; k < 2; ++k) dst[m][k] = *(const PG8_LAS bf16x8*)(lds + PG8_SA(b, h) + aoff + m * 2048 + k * 1024); } } while (0)
#define PG8_LDB(dst, b, h) do { if constexpr (FP8) { _Pragma("unroll") for (int n = 0; n < 2; ++n) { const i32x4 lo_ = *(const PG8_LAS i32x4*)(lds + PG8_SB(b, h) + boff + n * 2048), hi_ = *(const PG8_LAS i32x4*)(lds + PG8_SB(b, h) + boff + n * 2048 + 1024); \
            dst##8[n] = __builtin_shufflevector(lo_, hi_, 0, 1, 2, 3, 4, 5, 6, 7); } } \
        else { _Pragma("unroll") for (int n = 0; n < 2; ++n) _Pragma("unroll") for (int k = 0; k < 2; ++k) dst[n][k] = *(const PG8_LAS bf16x8*)(lds + PG8_SB(b, h) + boff + n * 2048 + k * 1024); } } while (0)
#define PG8_MMA(ai, bj, At, Bt) do { __builtin_amdgcn_s_setprio(1); \
        if constexpr (FP8) { _Pragma("unroll") for (int m = 0; m < 4; ++m) _Pragma("unroll") for (int n = 0; n < 2; ++n) \
            asm volatile("v_mfma_f32_16x16x128_f8f6f4 %0, %1, %2, %0" : "+v"(acc[ai][bj][m][n]) : "v"(Bt##8[n]), "v"(At##8[m])); } \
        else { _Pragma("unroll") for (int m = 0; m < 4; ++m) _Pragma("unroll") for (int n = 0; n < 2; ++n) _Pragma("unroll") for (int k = 0; k < 2; ++k) \
            acc[ai][bj][m][n] = __builtin_amdgcn_mfma_f32_16x16x32_bf16(Bt[n][k], At[m][k], acc[ai][bj][m][n], 0, 0, 0); } \
        __builtin_amdgcn_s_setprio(0); } while (0)
#define PG8_WAIT_V(n) asm volatile("s_waitcnt vmcnt(" #n ")" ::: "memory")
#define PG8_WAIT_L(n) asm volatile("s_waitcnt lgkmcnt(" #n ")" ::: "memory")
#define PG8_BAR __builtin_amdgcn_s_barrier()
#define PG8_SCHED __builtin_amdgcn_sched_barrier(0)
    Unit cur, nxt; int ui = 0;
    if (!S.next(0, cur)) return;
    f32x4 acc[2][2][4][2];
#pragma unroll
    for (int a = 0; a < 2; ++a)
#pragma unroll
        for (int b = 0; b < 2; ++b)
#pragma unroll
            for (int m = 0; m < 4; ++m)
#pragma unroll
                for (int n = 0; n < 2; ++n) acc[a][b][m][n] = (f32x4){0.f, 0.f, 0.f, 0.f};
    bf16x8 At[4][2], B0[2][2], B1[2][2]; i32x8 At8[4], B08[2], B18[2];
    const char* cA = (const char*)g.A + (size_t)cur.pm * tstep + (size_t)cur.k0 * kstep; const char* cB = (const char*)g.Bt + (size_t)cur.pn * tstep + (size_t)cur.k0 * kstep;
    S.a_ready(cur);
    if constexpr (SP2) {
        PG8_STAGE(PG8_SB(0, 0), cB, voffB); PG8_STAGE(PG8_SB(0, 1), cB + hstep, voffB); PG8_STAGE(PG8_SA(0, 0), cA, voffA); PG8_STAGE(PG8_SA(0, 1), cA + hstep, voffA);
        if (wr == 1) PG8_BAR;
        PG8_WAIT_V(2); PG8_BAR;
        PG8_STAGE(PG8_SB(1, 0), cB + kstep, voffB); PG8_STAGE(PG8_SA(1, 0), cA + kstep, voffA); PG8_STAGE(PG8_SB(1, 1), cB + hstep + kstep, voffB);
        PG8_WAIT_V(6); PG8_BAR;
    } else {
        PG8_STAGE(PG8_SB(0, 0), cB, voffB); PG8_STAGE(PG8_SA(0, 0), cA, voffA); PG8_STAGE(PG8_SB(0, 1), cB + hstep, voffB); PG8_STAGE(PG8_SA(0, 1), cA + hstep, voffA);
        if (wr == 1) PG8_BAR;
        PG8_WAIT_V(4); PG8_BAR;
        PG8_STAGE(PG8_SB(1, 0), cB + kstep, voffB); PG8_STAGE(PG8_SA(1, 0), cA + kstep, voffA); PG8_STAGE(PG8_SB(1, 1), cB + hstep + kstep, voffB);
        PG8_WAIT_V(6); PG8_BAR;
    }
    for (;;) {
        const bool has_next = S.next(ui + 1, nxt);
        const char* nA = has_next ? (const char*)g.A + (size_t)nxt.pm * tstep + (size_t)nxt.k0 * kstep : cA; const char* nB = has_next ? (const char*)g.Bt + (size_t)nxt.pn * tstep + (size_t)nxt.k0 * kstep : cB;
        const int nt = cur.nt;
#ifndef KREP
#define KREP 1
#endif
        for (int tt_ = 0; tt_ < nt * KREP; tt_ += 2) {
            const int t = (KREP > 1 && tt_ >= nt) ? tt_ - nt : tt_;
            if (KREP > 1 && tt_ == nt) {
#pragma unroll
                for (int a = 0; a < 2; ++a)
#pragma unroll
                    for (int b2_ = 0; b2_ < 2; ++b2_)
#pragma unroll
                        for (int m = 0; m < 4; ++m)
#pragma unroll
                            for (int n = 0; n < 2; ++n) acc[a][b2_][m][n] = (f32x4){0.f, 0.f, 0.f, 0.f}; }
            const bool last = (tt_ == nt * KREP - 2);
            const char* a1 = cA + (size_t)(t + 1) * kstep;
            const int t2 = (KREP > 1 && t + 2 >= nt) ? t + 2 - nt : t + 2;
            const char* a2 = last ? nA : cA + (size_t)t2 * kstep; const char* b2 = last ? nB : cB + (size_t)t2 * kstep;
            const char* a3 = a2 + kstep; const char* b3 = b2 + kstep;
            if (last && has_next) S.a_ready(nxt);
            if constexpr (SP2) {
            PG8_LDB(B0, 0, 0); PG8_LDB(B1, 0, 1); PG8_SCHED; PG8_LDA(At, 0, 0); PG8_STAGE(PG8_SA(1, 1), a1 + hstep, voffA);
            PG8_WAIT_V(8); PG8_WAIT_L(0); PG8_BAR; PG8_MMA(0, 0, At, B0); PG8_MMA(0, 1, At, B1); PG8_BAR; PG8_SCHED;
            PG8_LDA(At, 0, 1); PG8_STAGE(PG8_SB(0, 0), b2, voffB); PG8_STAGE(PG8_SB(0, 1), b2 + hstep, voffB); PG8_STAGE(PG8_SA(0, 0), a2, voffA);
            PG8_WAIT_V(8); PG8_WAIT_L(0); PG8_BAR; PG8_MMA(1, 0, At, B0); PG8_MMA(1, 1, At, B1); PG8_BAR; PG8_SCHED;
            PG8_LDB(B0, 1, 0); PG8_LDB(B1, 1, 1); PG8_SCHED; PG8_LDA(At, 1, 0); PG8_STAGE(PG8_SA(0, 1), a2 + hstep, voffA);
            PG8_WAIT_V(8); PG8_WAIT_L(0); PG8_BAR; PG8_MMA(0, 0, At, B0); PG8_MMA(0, 1, At, B1); PG8_BAR; PG8_SCHED;
            PG8_LDA(At, 1, 1); PG8_STAGE(PG8_SB(1, 0), b3, voffB); PG8_STAGE(PG8_SB(1, 1), b3 + hstep, voffB); PG8_STAGE(PG8_SA(1, 0), a3, voffA);
            PG8_WAIT_V(8); PG8_WAIT_L(0); PG8_BAR; PG8_MMA(1, 0, At, B0); PG8_MMA(1, 1, At, B1); PG8_BAR; PG8_SCHED;
            } else {
            PG8_LDB(B0, 0, 0); PG8_SCHED; PG8_LDA(At, 0, 0); PG8_STAGE(PG8_SA(1, 1), a1 + hstep, voffA);
            PG8_WAIT_L(8); PG8_BAR; PG8_WAIT_L(0); PG8_MMA(0, 0, At, B0); PG8_BAR; PG8_SCHED;
            PG8_LDB(B1, 0, 1); PG8_STAGE(PG8_SB(0, 0), b2, voffB);
            PG8_BAR; PG8_WAIT_L(0); PG8_MMA(0, 1, At, B1); PG8_BAR;
            PG8_LDA(At, 0, 1); PG8_STAGE(PG8_SA(0, 0), a2, voffA);
            PG8_BAR; PG8_WAIT_L(0); PG8_MMA(1, 0, At, B0); PG8_BAR; PG8_SCHED;
            PG8_STAGE(PG8_SB(0, 1), b2 + hstep, voffB);
            PG8_WAIT_V(6); PG8_BAR; PG8_MMA(1, 1, At, B1); PG8_BAR;
            PG8_LDB(B0, 1, 0); PG8_SCHED; PG8_LDA(At, 1, 0); PG8_STAGE(PG8_SA(0, 1), a2 + hstep, voffA);
            PG8_WAIT_L(8); PG8_BAR; PG8_WAIT_L(0); PG8_MMA(0, 0, At, B0); PG8_BAR; PG8_SCHED;
            PG8_LDB(B1, 1, 1); PG8_STAGE(PG8_SB(1, 0), b3, voffB);
            PG8_BAR; PG8_WAIT_L(0); PG8_MMA(0, 1, At, B1); PG8_BAR;
            PG8_LDA(At, 1, 1); PG8_STAGE(PG8_SA(1, 0), a3, voffA);
            PG8_BAR; PG8_WAIT_L(0); PG8_MMA(1, 0, At, B0); PG8_BAR; PG8_SCHED;
            PG8_STAGE(PG8_SB(1, 1), b3 + hstep, voffB);
            PG8_WAIT_V(6); PG8_BAR; PG8_MMA(1, 1, At, B1); PG8_BAR;
            }
        }
        if constexpr (FP8) asm volatile("s_nop 15\n\ts_nop 7" ::: "memory");
        if constexpr (ALIGN_EPI) { if (wr == 0) PG8_BAR; }
        if constexpr (!Epi::AFTER_DRAIN) { E(acc, cur, wr, wc, fr, fq); S.done(cur); }
        if (!has_next) break;
#pragma unroll
        for (int a = 0; a < 2; ++a)
#pragma unroll
            for (int b = 0; b < 2; ++b)
#pragma unroll
                for (int m = 0; m < 4; ++m)
#pragma unroll
                    for (int n = 0; n < 2; ++n) acc[a][b][m][n] = (f32x4){0.f, 0.f, 0.f, 0.f};
        cur = nxt; cA = nA; cB = nB; ++ui;
        if constexpr (ALIGN_EPI) { if (wr == 1) PG8_BAR; }
    }
    PG8_WAIT_V(0);
    if constexpr (!ALIGN_EPI) { if (wr == 0) PG8_BAR; }
    PG8_BAR;
    if constexpr (Epi::AFTER_DRAIN) { E.fused(acc, cur, wr, wc, fr, fq, lds, wid, lane); S.done(cur); }
#undef PG8_SA
#undef PG8_SB
#undef PG8_STAGE
#undef PG8_LDA
#undef PG8_LDB
#undef PG8_MMA
#undef PG8_WAIT_V
#undef PG8_WAIT_L
#undef PG8_BAR
#undef PG8_SCHED
}
}
#ifndef WGM_G2
#define WGM_G2 6
#endif
#ifndef WGM_G4
#define WGM_G4 6
#endif
#ifndef F8_ALL
#define F8_ALL 1
#endif
#ifndef F8_LAST
#define F8_LAST 1
#endif
constexpr float WD8_SCALE = 128.f;
#ifndef REP_P0
#define REP_P0 1
#endif
#ifndef REP_G1
#define REP_G1 1
#endif
#ifndef REP_MIX
#define REP_MIX 1
#endif
#ifndef REP_G2
#define REP_G2 1
#endif
#ifndef REP_G3
#define REP_G3 1
#endif
#ifndef REP_G4
#define REP_G4 1
#endif
#ifndef REP_FIN
#define REP_FIN 1
#endif
#ifndef REP_SYNC
#define REP_SYNC 1
#endif
using pg8::bf16_t; using pg8::bf16x8; using pg8::f32x4; using pg8::u32x4; using pg8::u32x2; using pg8::unpack8; using pg8::unpack4; using pg8::pack8; using pg8::cvt_pk_bf16; using pg8::load8f;
#define LAS __attribute__((address_space(3)))
constexpr int NWAVES = 8, NTHR = 512;
constexpr int D = 1024, DIN = 2048, DFF = 2816, NGU = 2 * DFF, DEPTH = 2;
constexpr int TP = 8 * 8192, TS = 32 * 64, T = TP + TS;
constexpr int LDS_BYTES = 155648, PST_OFF = 131072, MISC_OFF = LDS_BYTES - 64;
constexpr size_t al256(size_t x) { return (x + 255) & ~(size_t)255; }
constexpr size_t SZ_WIN = (size_t)DIN * D * 2, SZ_WOUT = (size_t)D * D * 2, SZ_WGU = (size_t)NGU * D * 2, SZ_WD = (size_t)D * DFF * 2, SZ_WSB = 8 * 128 * 128 * 2, SZ_WPT = 4 * 64 * 64 * 2;
constexpr size_t WS_WIN = 0, WS_WOUT = WS_WIN + DEPTH * SZ_WIN, WS_WGU = WS_WOUT + DEPTH * SZ_WOUT, WS_WD = WS_WGU + DEPTH * SZ_WGU, WS_WSB = WS_WD + DEPTH * SZ_WD, WS_WPT = WS_WSB + DEPTH * SZ_WSB;
constexpr size_t WS_C1IN = WS_WPT + DEPTH * SZ_WPT, WS_C2IN = WS_C1IN + DEPTH * DIN * 4, WS_C1GU = WS_C2IN + DEPTH * DIN * 4, WS_C2GU = WS_C1GU + DEPTH * NGU * 4;
constexpr size_t WS_BAR = al256(WS_C2GU + DEPTH * NGU * 4), BAR_BYTES = 16384;
constexpr size_t WS_ST1P = WS_BAR + BAR_BYTES, WS_ST2P = WS_ST1P + (size_t)T * 32, WS_ST1 = WS_ST2P + (size_t)T * 32, WS_ST2 = WS_ST1 + (size_t)T * 8;
constexpr size_t SZ_ACT = (size_t)T * D * 2;
constexpr size_t WS_XB = al256(WS_ST2 + (size_t)T * 8), WS_P1 = WS_XB + SZ_ACT, WS_P2 = WS_P1 + SZ_ACT, WS_PROJ = WS_P2 + SZ_ACT, WS_CAT = WS_PROJ + 2 * SZ_ACT, WS_HID = WS_PROJ, WS_PART = WS_CAT + SZ_ACT, WS_END = WS_PART + (size_t)pg8::NSPLIT * TS * D * 4;
static_assert((size_t)T * DFF * 2 <= 3 * SZ_ACT, "hid overlays proj|cat");
constexpr size_t O_YP = 0, O_YS = (size_t)TP * D, O_POOLP = (size_t)T * D, O_POOLS = O_POOLP + (size_t)DEPTH * 8 * 15 * 256, O_CONVP = O_POOLS + (size_t)DEPTH * 32 * 15 * 256,
                 O_CONVS = O_CONVP + (size_t)DEPTH * 8 * 2 * 256, O_V = O_CONVS + (size_t)DEPTH * 32 * 2 * 256, O_END = O_V + (size_t)DEPTH * 32 * 64 * 512;

struct Params { const float* in[20]; float* out; unsigned char* ws; };

__device__ __forceinline__ float wave_sum(float v) {
#pragma unroll
    for (int o = 1; o < 64; o <<= 1) v += __shfl_xor(v, o);
    return v;
}
__device__ __forceinline__ float bf2f(bf16_t h) { return __uint_as_float(((unsigned)h) << 16); }
#define LDS_WAIT() asm volatile("s_waitcnt lgkmcnt(0)" ::: "memory")

#define XB_TMO      128
#define XB_XCNT(j)  (256  + 64 * (j))
#define XB_XSUB(j)  (1280 + 64 * (j))
#define XB_XGEN(j)  (2304 + 64 * (j))
#define XB_TOP      3328
#define XB_TOPGEN   3392
#define XCD_BAR_WORDS 3456
#define XB_SPIN_CAP (1u << 18)

__device__ __forceinline__ unsigned xb_ld(unsigned* p)              { return __hip_atomic_load(p, __ATOMIC_RELAXED, __HIP_MEMORY_SCOPE_AGENT); }
__device__ __forceinline__ unsigned xb_add(unsigned* p, unsigned v) { return __hip_atomic_fetch_add(p, v, __ATOMIC_RELAXED, __HIP_MEMORY_SCOPE_AGENT); }
__device__ __forceinline__ unsigned xb_xcc_id() { return (unsigned)__builtin_amdgcn_s_getreg((3 << 11) | 20) & 0xFu; }
#define XB_SPIN(cond, bar) do { unsigned _sp = 0; while (cond) { __builtin_amdgcn_s_sleep(1); \
    if ((++_sp & 255u) == 0u) { if (xb_ld(&(bar)[XB_TMO])) break; if (_sp > XB_SPIN_CAP) { atomicAdd(&(bar)[XB_TMO], 1u); break; } } } } while (0)

struct XcdBarrier {
    unsigned* bar; unsigned x;
    volatile LAS unsigned* st;
};

__device__ __forceinline__ XcdBarrier xcd_barrier_post(unsigned* bar, volatile LAS unsigned* st) {
    XcdBarrier b; b.bar = bar; b.x = xb_xcc_id(); b.st = st;
    if (threadIdx.x == 0) (void)xb_add(&bar[XB_XCNT(b.x)], 1u);
    return b;
}
__device__ __forceinline__ void xcd_barrier_complete(unsigned* bar, unsigned x, unsigned& nloc, unsigned& nx) {
    const unsigned G = gridDim.x * gridDim.y * gridDim.z;
    unsigned sum, cnt, mine, sp = 0u;
    for (;;) {
        sum = 0u; cnt = 0u; mine = 0u;
#pragma unroll
        for (unsigned j = 0; j < 16; ++j) { const unsigned c = xb_ld(&bar[XB_XCNT(j)]); sum += c; cnt += (c > 0u) ? 1u : 0u; mine = (j == x) ? c : mine; }
        if (sum == G) break;
        __builtin_amdgcn_s_sleep(1);
        if ((++sp & 255u) == 0u) { if (xb_ld(&bar[XB_TMO])) break; if (sp > XB_SPIN_CAP) { atomicAdd(&bar[XB_TMO], 1u); break; } }
    }
    nloc = mine > 0u ? mine : 1u; nx = cnt > 0u ? cnt : 1u;
}

__device__ __forceinline__ void xcd_barrier(const XcdBarrier& b) {
    asm volatile("s_waitcnt vmcnt(0)" ::: "memory");
    __syncthreads();
    if (threadIdx.x == 0) {
        unsigned* bar = b.bar;
        __builtin_amdgcn_s_waitcnt(0);
        unsigned nloc = b.st[0], nx = b.st[1];
        if (nloc == 0u) { xcd_barrier_complete(bar, b.x, nloc, nx); b.st[0] = nloc; b.st[1] = nx; }
        const unsigned old = xb_add(&bar[XB_XSUB(b.x)], 1u);
        const unsigned gen = old / nloc;
        if (old + 1u == (gen + 1u) * nloc) {
            __builtin_amdgcn_fence(__ATOMIC_RELEASE, "agent");
            asm volatile("s_waitcnt vmcnt(0)" ::: "memory");
            const unsigned og = xb_add(&bar[XB_TOP], 1u);
            const unsigned tg = og / nx;
            if (og + 1u == (tg + 1u) * nx) xb_add(&bar[XB_TOPGEN], 1u);
            else XB_SPIN(xb_ld(&bar[XB_TOPGEN]) == tg, bar);
            __builtin_amdgcn_fence(__ATOMIC_ACQUIRE, "agent");
            xb_add(&bar[XB_XGEN(b.x)], 1u);
            asm volatile("s_waitcnt vmcnt(0)" ::: "memory");
        } else {
            XB_SPIN(xb_ld(&bar[XB_XGEN(b.x)]) == gen, bar);
            __builtin_amdgcn_fence(__ATOMIC_ACQUIRE, "agent");
            asm volatile("s_waitcnt vmcnt(0)" ::: "memory");
        }
    }
    __syncthreads();
}

__device__ __forceinline__ void p0_tile(const float* W, int srcN, int K, int k0, int n0, bf16_t* WT, int dstrow0, const float* g, const float* bvec, LAS float* scr, int lane, float (&s1)[4], float (&s2)[4], float f8scale = 0.f) {
#pragma unroll 8
    for (int i = 0; i < 32; ++i) { const int kk = 2 * i + (lane >> 5); scr[kk * 33 + (lane & 31)] = W[(size_t)(k0 + kk) * srcN + n0 + (lane & 31)]; }
    LDS_WAIT(); asm volatile("" ::: "memory");
    const int c = lane & 7;
    float gv[8], bv[8];
    if (g) { load8f(g + k0 + 8 * c, gv); load8f(bvec + k0 + 8 * c, bv); }
    else {
#pragma unroll
        for (int q = 0; q < 8; ++q) { gv[q] = 1.f; bv[q] = 0.f; } }
#pragma unroll
    for (int j = 0; j < 4; ++j) { const int n = (lane >> 3) + 8 * j; const LAS float* s = scr + (8 * c) * 33 + n;
        float v[8]; float t2 = 0.f;
#pragma unroll
        for (int q = 0; q < 8; ++q) { const float w = s[q * 33]; v[q] = w * gv[q]; t2 += w * bv[q]; }
        const u32x4 o = pack8(v);
        float r[8]; unpack8(o, r);
        s1[j] += ((r[0] + r[1]) + (r[2] + r[3])) + ((r[4] + r[5]) + (r[6] + r[7])); s2[j] += t2;
        if (f8scale != 0.f) { int w0 = 0, w1 = 0;
            w0 = __builtin_amdgcn_cvt_pk_fp8_f32(v[0] * f8scale, v[1] * f8scale, w0, false); w0 = __builtin_amdgcn_cvt_pk_fp8_f32(v[2] * f8scale, v[3] * f8scale, w0, true);
            w1 = __builtin_amdgcn_cvt_pk_fp8_f32(v[4] * f8scale, v[5] * f8scale, w1, false); w1 = __builtin_amdgcn_cvt_pk_fp8_f32(v[6] * f8scale, v[7] * f8scale, w1, true);
            u32x2 w; w.x = (unsigned)w0; w.y = (unsigned)w1; *(u32x2*)((unsigned char*)WT + (size_t)(dstrow0 + n) * K + k0 + 8 * c) = w; }
        else *(u32x4*)(WT + (size_t)(dstrow0 + n) * K + k0 + 8 * c) = o; }
    LDS_WAIT(); asm volatile("" ::: "memory");
}
__device__ __forceinline__ void p0_phase(const Params& p, LAS unsigned char* lds, int wave, int lane) {
    LAS float* scr = (LAS float*)(lds + wave * 16384);
    const int gw = blockIdx.x * NWAVES + wave, NGW = gridDim.x * NWAVES;
    unsigned char* ws = p.ws;
    constexpr int IA_IN = DIN / 32, IA_GU = NGU / 32, IA_L = IA_IN + IA_GU, IA = DEPTH * IA_L;
    LAS float* red = (LAS float*)(lds + PST_OFF);
    for (int it = blockIdx.x; it < IA; it += gridDim.x) {
        const int l = it / IA_L; int r = it % IA_L;
        const float* W; int srcN, n0, dstrow0; bf16_t* WT; const float* g; const float* bv; float* c1; float* c2;
        if (r < IA_IN) { W = p.in[6] + (size_t)l * D * DIN; srcN = DIN; n0 = 32 * r; dstrow0 = 32 * r; WT = (bf16_t*)(ws + WS_WIN + l * SZ_WIN);
            g = l ? p.in[15] : nullptr; bv = l ? p.in[16] : nullptr;
            c1 = (float*)(ws + WS_C1IN) + l * DIN; c2 = (float*)(ws + WS_C2IN) + l * DIN; }
        else { r -= IA_IN; dstrow0 = 32 * r; const int pn = dstrow0 >> 8, jj = dstrow0 & 255; W = (jj < 128 ? p.in[17] : p.in[18]) + (size_t)l * D * DFF; srcN = DFF; n0 = pn * 128 + (jj & 127);
            WT = (bf16_t*)(ws + WS_WGU + l * SZ_WGU); g = p.in[4] + l * D; bv = p.in[5] + l * D; c1 = (float*)(ws + WS_C1GU) + l * NGU; c2 = (float*)(ws + WS_C2GU) + l * NGU; }
        float s1[4] = {0.f, 0.f, 0.f, 0.f}, s2[4] = {0.f, 0.f, 0.f, 0.f};
        for (int kb = 2 * wave; kb < 2 * wave + 2; ++kb) p0_tile(W, srcN, D, 64 * kb, n0, WT, dstrow0, g, bv, scr, lane, s1, s2);
#pragma unroll
        for (int j = 0; j < 4; ++j) { float a = s1[j], b = s2[j]; a += __shfl_xor(a, 1); a += __shfl_xor(a, 2); a += __shfl_xor(a, 4); b += __shfl_xor(b, 1); b += __shfl_xor(b, 2); b += __shfl_xor(b, 4);
            if ((lane & 7) == 0) { const int n = (lane >> 3) + 8 * j; red[(wave * 32 + n) * 2] = a; red[(wave * 32 + n) * 2 + 1] = b; } }
        __syncthreads();
        if (wave == 0 && lane < 32) { float a = 0.f, b = 0.f;
#pragma unroll
            for (int w8 = 0; w8 < 8; ++w8) { a += red[(w8 * 32 + lane) * 2]; b += red[(w8 * 32 + lane) * 2 + 1]; }
            c1[dstrow0 + lane] = a; c2[dstrow0 + lane] = b; }
        __syncthreads();
    }
    constexpr int IB_O = (D / 64) * (D / 32), IB_D = (DFF / 64) * (D / 32), IB_L = IB_O + IB_D, IB = DEPTH * IB_L;
    for (int it = gw; it < IB; it += NGW) {
        const int l = it / IB_L; int r = it % IB_L; float d1[4] = {0.f, 0.f, 0.f, 0.f}, d2[4] = {0.f, 0.f, 0.f, 0.f};
        if (r < IB_O) { const int kb = r / (D / 32), nb = r % (D / 32); p0_tile(p.in[14] + (size_t)l * D * D, D, D, 64 * kb, 32 * nb, (bf16_t*)(ws + WS_WOUT + l * SZ_WOUT), 32 * nb, nullptr, nullptr, scr, lane, d1, d2); }
        else { r -= IB_O; const int kb = r / (D / 32), nb = r % (D / 32); p0_tile(p.in[19] + (size_t)l * DFF * D, D, DFF, 64 * kb, 32 * nb, (bf16_t*)(ws + WS_WD + l * SZ_WD), 32 * nb, nullptr, nullptr, scr, lane, d1, d2, (F8_LAST && (F8_ALL || l == DEPTH - 1)) ? WD8_SCALE : 0.f); }
    }
    const int gt = blockIdx.x * NTHR + wave * 64 + lane, GT = gridDim.x * NTHR;
    { bf16_t* wsb = (bf16_t*)(ws + WS_WSB); const float* src = p.in[9];
      for (int i = gt; i < DEPTH * 8 * 128 * 128 / 2; i += GT) { const int e = 2 * i, jj = e & 127, ii = (e >> 7) & 127; const bool keep = (jj >> 6) <= (ii >> 6);
          const float a = keep ? src[e] : 0.f, b = keep ? src[e + 1] : 0.f; ((unsigned*)wsb)[i] = cvt_pk_bf16(a, b); }
      bf16_t* wpt = (bf16_t*)(ws + WS_WPT); const float* wp = p.in[11];
      for (int i = gt; i < DEPTH * 4 * 64 * 64; i += GT) { const int c = i & 63, e = (i >> 6) & 63, lg = i >> 12; wpt[i] = (bf16_t)(cvt_pk_bf16(wp[((size_t)lg * 64 + c) * 64 + e], 0.f) & 0xffffu); } }
    { bf16_t* xb = (bf16_t*)(ws + WS_XB); constexpr int NCH = T * D / 8, PCH = TP * D / 8;
#pragma unroll 4
      for (int i = gt; i < NCH; i += GT) { const float* s = (i < PCH) ? p.in[0] + (size_t)i * 8 : p.in[1] + (size_t)(i - PCH) * 8; float f[8]; load8f(s, f); *(u32x4*)(xb + (size_t)i * 8) = pack8(f); } }
}

struct MixArgs {
    const bf16_t* proj; bf16_t* cat; const float* vg; const float* vb; const bf16_t* wsb; const float* bsp; const bf16_t* wpt; const float* pscale; const float* convw;
    const float* st_pool; const float* st_conv; float* o_pool_p; float* o_pool_s; float* o_conv_p; float* o_conv_s; float* o_v;
};
constexpr int VT_S = 136, XS = 264, VSTAT_OFF = 8 * 64 * VT_S * 2;
static_assert(VSTAT_OFF + 8192 <= MISC_OFF && 79 * XS * 2 <= MISC_OFF, "MIX LDS map");
__device__ __forceinline__ void mix_chunk_unit(LAS unsigned char* lds, const MixArgs& A, int u, int tid_in, int wid_in, int lane_in) {
    int tid = tid_in; asm volatile("" : "+v"(tid)); const int lane = tid & 63, wid = __builtin_amdgcn_readfirstlane(tid >> 6); (void)wid_in; (void)lane_in;
    const int fr = lane & 15, fq = lane >> 4;
    const int r0 = u * 128; const bool prompt = u < 512;
    const bf16_t* proj = A.proj;
    typedef float f32x2v __attribute__((ext_vector_type(2)));
    LAS f32x2v* part = (LAS f32x2v*)(lds + VSTAT_OFF);
    const int h = wid; LAS bf16_t* vt = (LAS bf16_t*)lds + h * 64 * VT_S;
    const int j0 = 2 * lane;
    u32x4 ra[8], rb[8];
    {
      LAS unsigned char* stg = (LAS unsigned char*)vt;
      u32x4 t[16];
      const unsigned goff = ((unsigned)(r0 + (lane >> 3)) * DIN + 512u + (unsigned)(h * 64 + (lane & 7) * 8)) * 2u;
#pragma unroll
      for (int k = 0; k < 16; ++k) t[k] = *(const u32x4*)((const char*)proj + (size_t)(goff + (unsigned)(8 * k * DIN) * 2u));
#pragma unroll
      for (int k = 0; k < 16; ++k) { const int r = (lane >> 3) + 8 * k; *(LAS u32x4*)(stg + r * 128 + (((lane & 7) ^ ((r >> 1) & 7)) * 16)) = t[k]; }
      LDS_WAIT(); asm volatile("" ::: "memory");
#pragma unroll
      for (int dc = 0; dc < 8; ++dc) { ra[dc] = *(const LAS u32x4*)(stg + (2 * lane) * 128 + ((dc ^ (lane & 7)) * 16)); rb[dc] = *(const LAS u32x4*)(stg + (2 * lane + 1) * 128 + ((dc ^ (lane & 7)) * 16)); }
      LDS_WAIT(); asm volatile("" ::: "memory");
    }
    { float s0 = 0.f, q0 = 0.f, s1 = 0.f, q1 = 0.f;
#pragma unroll
      for (int dc = 0; dc < 8; ++dc) { float a[8], b[8]; unpack8(ra[dc], a); unpack8(rb[dc], b);
#pragma unroll
          for (int q = 0; q < 8; ++q) { s0 += a[q]; q0 += a[q] * a[q]; s1 += b[q]; q1 += b[q] * b[q]; } }
      part[h * 128 + j0] = (f32x2v){s0, q0}; part[h * 128 + j0 + 1] = (f32x2v){s1, q1}; }
    __syncthreads();
    float mu0, rs0, mu1, rs1;
    { float s0 = 0.f, q0 = 0.f, s1 = 0.f, q1 = 0.f;
#pragma unroll
      for (int hh = 0; hh < 8; ++hh) { const f32x2v a = part[hh * 128 + j0], b = part[hh * 128 + j0 + 1]; s0 += a[0]; q0 += a[1]; s1 += b[0]; q1 += b[1]; }
      mu0 = s0 * (1.f / 512.f); rs0 = rsqrtf(fmaxf(q0 * (1.f / 512.f) - mu0 * mu0, 0.f) + pg8::LN_EPS);
      mu1 = s1 * (1.f / 512.f); rs1 = rsqrtf(fmaxf(q1 * (1.f / 512.f) - mu1 * mu1, 0.f) + pg8::LN_EPS); }
#pragma unroll
    for (int dc = 0; dc < 8; ++dc) { float a[8], b[8], gv[8], bv[8]; unpack8(ra[dc], a); unpack8(rb[dc], b);
        load8f(A.vg + h * 64 + dc * 8, gv); load8f(A.vb + h * 64 + dc * 8, bv);
#pragma unroll
        for (int q = 0; q < 8; ++q) { a[q] = (a[q] - mu0) * rs0 * gv[q] + bv[q]; b[q] = (b[q] - mu1) * rs1 * gv[q] + bv[q]; }
        if (!prompt) { float* o = A.o_v + (size_t)(r0 - TP + j0) * 512 + h * 64 + dc * 8;
            *(f32x4*)o = (f32x4){a[0], a[1], a[2], a[3]}; *(f32x4*)(o + 4) = (f32x4){a[4], a[5], a[6], a[7]}; *(f32x4*)(o + 512) = (f32x4){b[0], b[1], b[2], b[3]}; *(f32x4*)(o + 516) = (f32x4){b[4], b[5], b[6], b[7]}; }
#pragma unroll
        for (int q = 0; q < 8; ++q) *(LAS unsigned*)(vt + (dc * 8 + q) * VT_S + j0) = cvt_pk_bf16(a[q], b[q]); }
    LDS_WAIT(); asm volatile("" ::: "memory");
#pragma unroll 1
    for (int ob = 0; ob < 2; ++ob) {
        const int wsr0 = prompt ? ob * 64 : 0, vr0 = prompt ? 0 : ob * 64, nk = (prompt && ob) ? 4 : 2;
        u32x2 uw[4][4];
#pragma unroll
        for (int it = 0; it < 4; ++it)
#pragma unroll
            for (int dt = 0; dt < 4; ++dt) uw[it][dt] = *(const u32x2*)(proj + ((size_t)r0 + ob * 64 + it * 16 + fr) * DIN + h * 64 + dt * 16 + fq * 4);
#pragma unroll
        for (int it = 0; it < 4; ++it) {
            const int wrow = wsr0 + it * 16 + fr; const size_t row = (size_t)r0 + ob * 64 + it * 16 + fr;
            const float bs = A.bsp[h * 128 + wrow];
            bf16x8 wf[4];
#pragma unroll
            for (int ks = 0; ks < 4; ++ks) if (ks < nk) wf[ks] = *(const bf16x8*)(A.wsb + ((size_t)h * 128 + wrow) * 128 + ks * 32 + fq * 8);
            f32x4 acc[4];
#pragma unroll
            for (int b = 0; b < 4; ++b) acc[b] = (f32x4){0.f, 0.f, 0.f, 0.f};
#pragma unroll
            for (int ks = 0; ks < 4; ++ks) if (ks < nk) { bf16x8 vf[4];
#pragma unroll
                for (int dt = 0; dt < 4; ++dt) vf[dt] = *(const LAS bf16x8*)(vt + (dt * 16 + fr) * VT_S + vr0 + ks * 32 + fq * 8);
#pragma unroll
                for (int dt = 0; dt < 4; ++dt) acc[dt] = __builtin_amdgcn_mfma_f32_16x16x32_bf16(vf[dt], wf[ks], acc[dt], 0, 0, 0); }
#pragma unroll
            for (int dt = 0; dt < 4; ++dt) { const int d = h * 64 + dt * 16 + fq * 4; float uu[4]; unpack4(uw[it][dt], uu);
                u32x2 o; o.x = cvt_pk_bf16(uu[0] * (acc[dt][0] + bs), uu[1] * (acc[dt][1] + bs)); o.y = cvt_pk_bf16(uu[2] * (acc[dt][2] + bs), uu[3] * (acc[dt][3] + bs));
                *(u32x2*)(A.cat + row * D + d) = o; }
        }
    }
    __syncthreads();
}
__device__ __forceinline__ void mix_pool_conv_block(LAS unsigned char* lds, const MixArgs& A, int blk, int tid_in, int wid_in, int lane_in) {
    int tid = tid_in; asm volatile("" : "+v"(tid)); const int lane = tid & 63, wid = __builtin_amdgcn_readfirstlane(tid >> 6); (void)wid_in; (void)lane_in;
    const int fr = lane & 15, fq = lane >> 4;
    const int r0 = blk * 64; const bool prompt = blk < 1024; const int bi = blk & 127, sb = blk - 1024;
    const int t0 = prompt ? bi * 64 : 0;
    const bf16_t* proj = A.proj;
    LAS bf16_t* xt = (LAS bf16_t*)lds;
    const int g = wid >> 1, half = wid & 1, w = 2 << g;
    bf16x8 wf[2][4];
#pragma unroll
    for (int ks = 0; ks < 2; ++ks)
#pragma unroll
        for (int et = 0; et < 4; ++et) wf[ks][et] = *(const bf16x8*)(A.wpt + ((size_t)g * 64 + et * 16 + fr) * 64 + ks * 32 + fq * 8);
    u32x4 tw[5];
#pragma unroll
    for (int i = 0; i < 5; ++i) { const int idx = tid + i * NTHR, tr = idx >> 5, cc = idx & 31; u32x4 wv = (u32x4){0u, 0u, 0u, 0u};
        if (idx < 79 * 32) {
            if (tr >= 15 || (prompt && bi != 0)) wv = *(const u32x4*)(proj + (size_t)(r0 - 15 + tr) * DIN + 1024 + cc * 8);
            else if (!prompt) { float f[8]; load8f(A.st_pool + ((size_t)sb * 15 + tr) * 256 + cc * 8, f); wv = pack8(f); } }
        tw[i] = wv; }
    const int cj = tid >> 5, cc8 = (tid & 31) * 8;
#pragma unroll 1
    for (int hb = 0; hb < 2; ++hb) {
        u32x4 cgb[2], cgc[2][3], chh[2][3];
#pragma unroll
        for (int i2 = 0; i2 < 2; ++i2) { const int j = cj + 16 * (2 * hb + i2), t = t0 + j; const bf16_t* pr = proj + ((size_t)r0 + j) * DIN;
            cgb[i2] = *(const u32x4*)(pr + 1280 + cc8);
#pragma unroll
            for (int k = 0; k < 3; ++k) { const bool ok = t >= k; const bf16_t* q = pr - (ok ? k : 0) * DIN;
                cgc[i2][k] = *(const u32x4*)(q + 1536 + cc8); chh[i2][k] = *(const u32x4*)(q + 1792 + cc8); } }
        float w0[8], w1[8], w2[8]; load8f(A.convw + cc8, w0); load8f(A.convw + 256 + cc8, w1); load8f(A.convw + 512 + cc8, w2);
#pragma unroll
        for (int i2 = 0; i2 < 2; ++i2) { const int j = cj + 16 * (2 * hb + i2), t = t0 + j; const size_t row = (size_t)r0 + j;
            float gb[8], gc[8], hh[8], z0[8], z1[8], z2[8];
            unpack8(cgb[i2], gb); unpack8(cgc[i2][0], gc); unpack8(chh[i2][0], hh);
#pragma unroll
            for (int q = 0; q < 8; ++q) z0[q] = gc[q] * hh[q];
            unpack8(cgc[i2][1], gc); unpack8(chh[i2][1], hh);
#pragma unroll
            for (int q = 0; q < 8; ++q) z1[q] = gc[q] * hh[q];
            unpack8(cgc[i2][2], gc); unpack8(chh[i2][2], hh);
#pragma unroll
            for (int q = 0; q < 8; ++q) z2[q] = gc[q] * hh[q];
            if (t < 2) {
                if (t < 1) { if (!prompt) load8f(A.st_conv + ((size_t)sb * 2 + 1) * 256 + cc8, z1); else {
#pragma unroll
                        for (int q = 0; q < 8; ++q) z1[q] = 0.f; } }
                if (!prompt) load8f(A.st_conv + ((size_t)sb * 2 + t) * 256 + cc8, z2); else {
#pragma unroll
                    for (int q = 0; q < 8; ++q) z2[q] = 0.f; } }
            float o[8];
#pragma unroll
            for (int q = 0; q < 8; ++q) o[q] = gb[q] * (w0[q] * z2[q] + w1[q] * z1[q] + w2[q] * z0[q]);
            *(u32x4*)(A.cat + row * D + 768 + cc8) = pack8(o);
            const int tl = prompt ? 8190 : 62;
            if (t >= tl) { float* o2 = (prompt ? A.o_conv_p + ((size_t)(blk >> 7) * 2 + (t - tl)) * 256 : A.o_conv_s + ((size_t)sb * 2 + (t - tl)) * 256) + cc8;
                *(f32x4*)o2 = (f32x4){z0[0], z0[1], z0[2], z0[3]}; *(f32x4*)(o2 + 4) = (f32x4){z0[4], z0[5], z0[6], z0[7]}; } }
    }
#pragma unroll
    for (int i = 0; i < 5; ++i) { const int idx = tid + i * NTHR, tr = idx >> 5, cc = idx & 31; if (idx < 79 * 32) *(LAS u32x4*)(xt + tr * XS + cc * 8) = tw[i]; }
    __syncthreads();
#pragma unroll 1
    for (int tt = 0; tt < 2; ++tt) {
        f32x4 acc[4];
#pragma unroll
        for (int b = 0; b < 4; ++b) acc[b] = (f32x4){0.f, 0.f, 0.f, 0.f};
        const int j = half * 32 + tt * 16 + fr, ti = 15 + j;
        const int pos = t0 + j; const float cnt = prompt ? (float)min(pos + 1, w) : (float)w; const float inv = 1.f / cnt;
#pragma unroll
        for (int ks = 0; ks < 2; ++ks) { const int c = g * 64 + ks * 32 + fq * 8;
            float sum[8] = {0.f, 0.f, 0.f, 0.f, 0.f, 0.f, 0.f, 0.f}, x0[8];
#pragma unroll 2
            for (int k = 0; k < w; ++k) { float x[8]; unpack8(*(const LAS u32x4*)(xt + (ti - k) * XS + c), x);
#pragma unroll
                for (int q = 0; q < 8; ++q) sum[q] += x[q]; }
            unpack8(*(const LAS u32x4*)(xt + ti * XS + c), x0);
            float df[8];
#pragma unroll
            for (int q = 0; q < 8; ++q) df[q] = sum[q] * inv - x0[q];
            const u32x4 dw = pack8(df); bf16x8 dfr; __builtin_memcpy(&dfr, &dw, 16);
#pragma unroll
            for (int et = 0; et < 4; ++et) acc[et] = __builtin_amdgcn_mfma_f32_16x16x32_bf16(wf[ks][et], dfr, acc[et], 0, 0, 0); }
        const size_t row = (size_t)r0 + j;
#pragma unroll
        for (int et = 0; et < 4; ++et) { const int e = g * 64 + et * 16 + fq * 4; const f32x4 sc = *(const f32x4*)(A.pscale + e);
            u32x2 o; o.x = cvt_pk_bf16(acc[et][0] * sc[0], acc[et][1] * sc[1]); o.y = cvt_pk_bf16(acc[et][2] * sc[2], acc[et][3] * sc[3]);
            *(u32x2*)(A.cat + row * D + 512 + e) = o; } }
    if (!prompt || bi == 127) { float* dst = prompt ? A.o_pool_p + (size_t)(blk >> 7) * 15 * 256 : A.o_pool_s + (size_t)sb * 15 * 256;
        for (int idx = tid; idx < 15 * 256; idx += NTHR) { const int i = idx >> 8, c = idx & 255; dst[i * 256 + c] = bf2f(xt[(15 + 49 + i) * XS + c]); } }
    __syncthreads();
}
__device__ __forceinline__ void mix_phase(LAS unsigned char* lds, const MixArgs& A, int tid, int wid, int lane) {
    const int c = blockIdx.x, G = gridDim.x;
    constexpr int NA = T / 128, NB = T / 64;
    const int nA = (NA + G - 1) / G, nB = (NB + G - 1) / G;
#pragma unroll 1
    for (int i = 0; i < nA + nB; ++i) {
        int type = -1, idx = 0;
        if (G == 256) {
            if (i < 2) { type = 0; idx = c + 256 * i; }
            else if (c < 16) { if (i == 2) { type = 0; idx = 512 + c; } else if (i < 5) { type = 1; idx = 2 * c + (i - 3); } }
            else { const int j = c - 16; if (i < 6) { type = 1; idx = 32 + j + 240 * (i - 2); } else if (i == 6 && j < 64) { type = 1; idx = 992 + j; } }
        } else {
            if (i < nA) { idx = c + G * i; type = idx < NA ? 0 : -1; } else { idx = c + G * (i - nA); type = idx < NB ? 1 : -1; }
        }
        type = __builtin_amdgcn_readfirstlane(type); idx = __builtin_amdgcn_readfirstlane(idx);
#ifndef REP_MIXA
#define REP_MIXA 1
#endif
#ifndef REP_MIXB
#define REP_MIXB 1
#endif
        if (type == 0) { for (int r = 0; r < REP_MIXA; ++r) mix_chunk_unit(lds, A, idx, tid, wid, lane); }
        else if (type == 1) { for (int r = 0; r < REP_MIXB; ++r) mix_pool_conv_block(lds, A, idx, tid, wid, lane); }
    }
}

__device__ __forceinline__ void finalize_stats(const float* part, float* fin, int nrows) {
    typedef float f32x2v __attribute__((ext_vector_type(2)));
    for (int row = blockIdx.x * NTHR + threadIdx.x; row < nrows; row += gridDim.x * NTHR) {
        const f32x4 a = *(const f32x4*)(part + (size_t)row * 8), b = *(const f32x4*)(part + (size_t)row * 8 + 4);
        const float S = (a[0] + a[2]) + (b[0] + b[2]), Q = (a[1] + a[3]) + (b[1] + b[3]);
        const float mu = S * (1.f / 1024.f), var = fmaxf(Q * (1.f / 1024.f) - mu * mu, 0.f);
        *(f32x2v*)(fin + (size_t)row * 2) = (f32x2v){mu, rsqrtf(var + pg8::LN_EPS)};
    }
}
__device__ __forceinline__ bool split_on(int G) { return pg8::split_ok(T, TP, D, G); }
__device__ __forceinline__ void finalize_sample(const float* part, const bf16_t* R, const float* stats_in, const float* g, const float* b, bf16_t* O, float* fin) {
    typedef float f32x2v __attribute__((ext_vector_type(2)));
    int tid_ = threadIdx.x; asm volatile("" : "+v"(tid_)); const int lane = tid_ & 63, wave = __builtin_amdgcn_readfirstlane(tid_ >> 6);
    for (int lr = blockIdx.x * NWAVES + wave; lr < TS; lr += gridDim.x * NWAVES) {
        const size_t row = (size_t)TP + lr; float mu = 0.f, rs = 1.f; if (stats_in) pg8::row_stats(stats_in, (int)row, mu, rs);
        float v[2][8], s = 0.f, q = 0.f;
#pragma unroll
        for (int hh = 0; hh < 2; ++hh) { const int c = hh * 512 + lane * 8; float r[8], gg[8], bb[8]; unpack8(*(const u32x4*)(R + row * D + c), r);
            if (stats_in) { load8f(g + c, gg); load8f(b + c, bb); }
#pragma unroll
            for (int k = 0; k < 8; ++k) v[hh][k] = pg8::ALPHA * (stats_in ? (r[k] - mu) * rs * gg[k] + bb[k] : r[k]);
#pragma unroll
            for (int sp = 0; sp < pg8::NSPLIT; ++sp) { float p8[8]; load8f(part + ((size_t)sp * TS + lr) * D + c, p8);
#pragma unroll
                for (int k = 0; k < 8; ++k) v[hh][k] += p8[k]; }
#pragma unroll
            for (int k = 0; k < 8; ++k) { s += v[hh][k]; q += v[hh][k] * v[hh][k]; }
            *(u32x4*)(O + row * D + c) = pack8(v[hh]); }
        s = wave_sum(s); q = wave_sum(q);
        const float m2 = s * (1.f / 1024.f), var = fmaxf(q * (1.f / 1024.f) - m2 * m2, 0.f);
        if (lane == 0) *(f32x2v*)(fin + row * 2) = (f32x2v){m2, rsqrtf(var + pg8::LN_EPS)};
    }
}
typedef const __attribute__((address_space(4))) Params* ParamsPtr;
#define GETP() ParamsPtr pp; { auto kp_ = __builtin_amdgcn_kernarg_segment_ptr(); asm volatile("" : "+s"(kp_)); pp = (ParamsPtr)kp_; } unsigned char* ws = pp->ws; int l = lc; asm volatile("" : "+s"(l));
__global__ void __launch_bounds__(NTHR, 2) fwd_megakernel(Params p_unused) {
    extern __shared__ __attribute__((aligned(16))) unsigned char lds_raw[];
    LAS unsigned char* lds = (LAS unsigned char*)lds_raw;
    cg::grid_group grid = cg::this_grid();
    const int tid = threadIdx.x;
    if (gridDim.x == 0x7fffffffu) grid.sync();
    volatile LAS unsigned* MISC = (volatile LAS unsigned*)(lds + MISC_OFF);
    if (tid < 16) MISC[tid] = 0u;
    __syncthreads();
    { auto kp0 = __builtin_amdgcn_kernarg_segment_ptr(); (void)xcd_barrier_post((unsigned*)(((ParamsPtr)kp0)->ws + WS_BAR), MISC); }
#define GRIDBAR() do { auto kpb_ = __builtin_amdgcn_kernarg_segment_ptr(); asm volatile("" : "+s"(kpb_)); XcdBarrier xb_; xb_.bar = (unsigned*)(((ParamsPtr)kpb_)->ws + WS_BAR); xb_.x = xb_xcc_id(); \
        xb_.st = (volatile LAS unsigned*)((LAS unsigned char*)lds_raw + MISC_OFF); xcd_barrier(xb_); } while (0)
#ifndef NO_P0
    for (int rep = 0; rep < REP_P0; ++rep) { const int lc = 0; GETP(); (void)l; (void)ws; Params p; for (int i = 0; i < 20; ++i) p.in[i] = pp->in[i]; p.out = pp->out; p.ws = pp->ws;
      int tid0 = threadIdx.x; asm volatile("" : "+v"(tid0)); p0_phase(p, lds, __builtin_amdgcn_readfirstlane(tid0 >> 6), tid0 & 63); }
#endif
    GRIDBAR();

    for (int lc = 0; lc < DEPTH; ++lc) {
#ifndef NO_G1
        for (int rep = 0; rep < REP_G1; ++rep) { GETP(); const int G = gridDim.x;
          pg8::Gemm g{(const bf16_t*)(ws + (l ? WS_P2 : WS_XB)), (const bf16_t*)(ws + WS_WIN + l * SZ_WIN), T, DIN, D}; pg8::StaticOrder S; S.init(T, DIN, D, G, (int)blockIdx.x);
          pg8::EpiProj E{(bf16_t*)(ws + WS_PROJ), DIN, l ? (const float*)(ws + WS_ST2) : nullptr, (const float*)(ws + WS_C1IN) + l * DIN, (const float*)(ws + WS_C2IN) + l * DIN};
          pg8::gemm_phase<pg8::EpiProj, pg8::StaticOrder, true, true>(lds, g, S, E); }
#endif
        GRIDBAR();
#ifndef NO_MIX
        for (int rep = 0; rep < REP_MIX; ++rep) { GETP(); const int G = gridDim.x; float* out = pp->out;
          MixArgs A; A.proj = (const bf16_t*)(ws + WS_PROJ); A.cat = (bf16_t*)(ws + WS_CAT); A.vg = pp->in[7] + l * 512; A.vb = pp->in[8] + l * 512; A.wsb = (const bf16_t*)(ws + WS_WSB + l * SZ_WSB); A.bsp = pp->in[10] + l * 8 * 128;
          A.wpt = (const bf16_t*)(ws + WS_WPT + l * SZ_WPT); A.pscale = pp->in[12] + l * 256; A.convw = pp->in[13] + l * 3 * 256; A.st_pool = pp->in[2] + (size_t)l * 32 * 15 * 256; A.st_conv = pp->in[3] + (size_t)l * 32 * 2 * 256;
          A.o_pool_p = out + O_POOLP + (size_t)l * 8 * 15 * 256; A.o_pool_s = out + O_POOLS + (size_t)l * 32 * 15 * 256; A.o_conv_p = out + O_CONVP + (size_t)l * 8 * 2 * 256; A.o_conv_s = out + O_CONVS + (size_t)l * 32 * 2 * 256;
          A.o_v = out + O_V + (size_t)l * 32 * 64 * 512;
          int tid2 = threadIdx.x; asm volatile("" : "+v"(tid2)); const int lane2 = tid2 & 63, wid2 = __builtin_amdgcn_readfirstlane(tid2 >> 6);
          (void)G; mix_phase(lds, A, tid2, wid2, lane2); }
#endif
        GRIDBAR();
#ifndef NO_G2
        for (int rep = 0; rep < REP_G2; ++rep) { GETP(); const int G = gridDim.x;
          pg8::Gemm g{(const bf16_t*)(ws + WS_CAT), (const bf16_t*)(ws + WS_WOUT + l * SZ_WOUT), T, D, D}; const bool sp = split_on(G); pg8::StaticOrder S; S.init(sp ? TP : T, D, D, G, (int)blockIdx.x, WGM_G2);
          pg8::EpiRes<4> E{(bf16_t*)(ws + WS_P1), (const bf16_t*)(ws + (l ? WS_P2 : WS_XB)), l ? (const float*)(ws + WS_ST2) : nullptr, pp->in[15] + (l - 1) * D, pp->in[16] + (l - 1) * D, (float*)(ws + WS_ST1P), (LAS float*)(lds + PST_OFF), 1.f};
          pg8::gemm_phase<pg8::EpiRes<4>, pg8::StaticOrder, true, true>(lds, g, S, E);
          if (sp) { pg8::TailSplitOrder S2; S2.init(TP, D, D, (int)blockIdx.x); pg8::EpiPart E2{(float*)(ws + WS_PART), TP, TS, 1.f}; pg8::gemm_phase<pg8::EpiPart, pg8::TailSplitOrder, true, true>(lds, g, S2, E2); } }
#endif
        GRIDBAR();
        { GETP(); const bool sp = split_on((int)gridDim.x); finalize_stats((const float*)(ws + WS_ST1P), (float*)(ws + WS_ST1), sp ? TP : T);
          if (sp) finalize_sample((const float*)(ws + WS_PART), (const bf16_t*)(ws + (l ? WS_P2 : WS_XB)), l ? (const float*)(ws + WS_ST2) : nullptr, pp->in[15] + (l - 1) * D, pp->in[16] + (l - 1) * D, (bf16_t*)(ws + WS_P1), (float*)(ws + WS_ST1)); }
        GRIDBAR();
#ifndef NO_G3
        for (int rep = 0; rep < REP_G3; ++rep) { GETP(); const int G = gridDim.x;
          pg8::Gemm g{(const bf16_t*)(ws + WS_P1), (const bf16_t*)(ws + WS_WGU + l * SZ_WGU), T, NGU, D}; pg8::StaticOrder S; S.init(T, NGU, D, G, (int)blockIdx.x);
          if (F8_LAST && (F8_ALL || l == DEPTH - 1)) { pg8::EpiSwiGLU<true> E{(bf16_t*)(ws + WS_HID), DFF, (const float*)(ws + WS_ST1), (const float*)(ws + WS_C1GU) + l * NGU, (const float*)(ws + WS_C2GU) + l * NGU};
              pg8::gemm_phase<pg8::EpiSwiGLU<true>, pg8::StaticOrder, true, true>(lds, g, S, E); }
          else { pg8::EpiSwiGLU<false> E{(bf16_t*)(ws + WS_HID), DFF, (const float*)(ws + WS_ST1), (const float*)(ws + WS_C1GU) + l * NGU, (const float*)(ws + WS_C2GU) + l * NGU};
              pg8::gemm_phase<pg8::EpiSwiGLU<false>, pg8::StaticOrder, true, true>(lds, g, S, E); } }
#endif
        GRIDBAR();
#ifndef NO_G4
        for (int rep = 0; rep < REP_G4; ++rep) { GETP(); const int G = gridDim.x;
          const bool sp = split_on(G);
          if (F8_LAST && l == DEPTH - 1) {
              pg8::Gemm g{(const bf16_t*)(ws + WS_HID), (const bf16_t*)(ws + WS_WD + l * SZ_WD), T, D, DFF / 2}; pg8::StaticOrder S; S.init(T, D, DFF / 2, G, (int)blockIdx.x, WGM_G4);
              pg8::EpiRaw E{(bf16_t*)(ws + WS_P2), D, 1.f / WD8_SCALE};
              pg8::gemm_phase<pg8::EpiRaw, pg8::StaticOrder, true, true, true>(lds, g, S, E);
          } else if (F8_LAST && F8_ALL) {
              pg8::Gemm g{(const bf16_t*)(ws + WS_HID), (const bf16_t*)(ws + WS_WD + l * SZ_WD), T, D, DFF / 2}; pg8::StaticOrder S; S.init(sp ? TP : T, D, DFF / 2, G, (int)blockIdx.x, WGM_G4);
              pg8::EpiRes<4> E{(bf16_t*)(ws + WS_P2), (const bf16_t*)(ws + WS_P1), (const float*)(ws + WS_ST1), pp->in[4] + l * D, pp->in[5] + l * D, (float*)(ws + WS_ST2P), (LAS float*)(lds + PST_OFF), 1.f / WD8_SCALE};
              pg8::gemm_phase<pg8::EpiRes<4>, pg8::StaticOrder, true, true, true>(lds, g, S, E);
              if (sp) { pg8::TailSplitOrder S2; S2.init(TP, D, DFF / 2, (int)blockIdx.x); pg8::EpiPart E2{(float*)(ws + WS_PART), TP, TS, 1.f / WD8_SCALE}; pg8::gemm_phase<pg8::EpiPart, pg8::TailSplitOrder, true, true, true>(lds, g, S2, E2); }
          } else {
              pg8::Gemm g{(const bf16_t*)(ws + WS_HID), (const bf16_t*)(ws + WS_WD + l * SZ_WD), T, D, DFF}; pg8::StaticOrder S; S.init(sp ? TP : T, D, DFF, G, (int)blockIdx.x, WGM_G4);
              pg8::EpiRes<4> E{(bf16_t*)(ws + WS_P2), (const bf16_t*)(ws + WS_P1), (const float*)(ws + WS_ST1), pp->in[4] + l * D, pp->in[5] + l * D, (float*)(ws + WS_ST2P), (LAS float*)(lds + PST_OFF), 1.f};
              pg8::gemm_phase<pg8::EpiRes<4>, pg8::StaticOrder, true, true>(lds, g, S, E);
              if (sp) { pg8::TailSplitOrder S2; S2.init(TP, D, DFF, (int)blockIdx.x); pg8::EpiPart E2{(float*)(ws + WS_PART), TP, TS, 1.f}; pg8::gemm_phase<pg8::EpiPart, pg8::TailSplitOrder, true, true>(lds, g, S2, E2); } } }
#endif
        GRIDBAR();
        if (!(F8_LAST && lc == DEPTH - 1)) {
        { GETP(); const bool sp = split_on((int)gridDim.x); finalize_stats((const float*)(ws + WS_ST2P), (float*)(ws + WS_ST2), sp ? TP : T);
          if (sp) finalize_sample((const float*)(ws + WS_PART), (const bf16_t*)(ws + WS_P1), (const float*)(ws + WS_ST1), pp->in[4] + l * D, pp->in[5] + l * D, (bf16_t*)(ws + WS_P2), (float*)(ws + WS_ST2)); }
        GRIDBAR();
        }
        for (int rep = 1; rep < REP_SYNC; ++rep) GRIDBAR();
    }
    for (int rep = 0; rep < REP_FIN; ++rep) { const int lc = DEPTH - 1; GETP(); const int G = gridDim.x; float* out = pp->out;
      const float* gF = pp->in[15] + l * D; const float* bF = pp->in[16] + l * D; const bf16_t* P2 = (const bf16_t*)(ws + WS_P2); const float* ST2 = (const float*)(ws + WS_ST2);
      int tidf = threadIdx.x; asm volatile("" : "+v"(tidf)); const int lane = tidf & 63, wid = __builtin_amdgcn_readfirstlane(tidf >> 6);
      const int gw = blockIdx.x * NWAVES + wid, NGW = G * NWAVES;
      float gv[2][8], bv[2][8]; load8f(gF + lane * 8, gv[0]); load8f(gF + 512 + lane * 8, gv[1]); load8f(bF + lane * 8, bv[0]); load8f(bF + 512 + lane * 8, bv[1]);
#if F8_LAST
      const float* gM = pp->in[4] + l * D; const float* bM = pp->in[5] + l * D; const bf16_t* P1 = (const bf16_t*)(ws + WS_P1); const float* ST1 = (const float*)(ws + WS_ST1);
      float g1[2][8], b1[2][8]; load8f(gM + lane * 8, g1[0]); load8f(gM + 512 + lane * 8, g1[1]); load8f(bM + lane * 8, b1[0]); load8f(bM + 512 + lane * 8, b1[1]);
#pragma unroll 2
      for (int row = gw; row < T; row += NGW) { float mu1, rs1; pg8::row_stats(ST1, row, mu1, rs1);
          float v[2][8], s = 0.f, q2 = 0.f;
#pragma unroll
          for (int hh = 0; hh < 2; ++hh) { float p[8], f[8]; unpack8(*(const u32x4*)(P1 + (size_t)row * D + hh * 512 + lane * 8), p); unpack8(*(const u32x4*)(P2 + (size_t)row * D + hh * 512 + lane * 8), f);
#pragma unroll
              for (int q = 0; q < 8; ++q) { const float x = pg8::ALPHA * ((p[q] - mu1) * rs1 * g1[hh][q] + b1[hh][q]) + f[q]; v[hh][q] = x; s += x; q2 += x * x; } }
          s = wave_sum(s); q2 = wave_sum(q2);
          const float mu = s * (1.f / 1024.f), rs = rsqrtf(fmaxf(q2 * (1.f / 1024.f) - mu * mu, 0.f) + pg8::LN_EPS);
#pragma unroll
          for (int hh = 0; hh < 2; ++hh) { float* o = out + (size_t)row * D + hh * 512 + lane * 8; float f[8];
#pragma unroll
              for (int q = 0; q < 8; ++q) f[q] = (v[hh][q] - mu) * rs * gv[hh][q] + bv[hh][q];
              *(f32x4*)o = (f32x4){f[0], f[1], f[2], f[3]}; *(f32x4*)(o + 4) = (f32x4){f[4], f[5], f[6], f[7]}; } }
      (void)ST2;
#else
#pragma unroll 2
      for (int row = gw; row < T; row += NGW) { float mu, rs; pg8::row_stats(ST2, row, mu, rs);
#pragma unroll
          for (int hh = 0; hh < 2; ++hh) { float f[8]; unpack8(*(const u32x4*)(P2 + (size_t)row * D + hh * 512 + lane * 8), f); float* o = out + (size_t)row * D + hh * 512 + lane * 8;
#pragma unroll
              for (int q = 0; q < 8; ++q) f[q] = (f[q] - mu) * rs * gv[hh][q] + bv[hh][q];
              *(f32x4*)o = (f32x4){f[0], f[1], f[2], f[3]}; *(f32x4*)(o + 4) = (f32x4){f[4], f[5], f[6], f[7]}; } }
#endif
    }
}

extern "C" void kernel_launch(void* const* d_in, const int* in_sizes, int n_in, void* d_out, int out_size, void* d_ws, size_t ws_size, hipStream_t stream) {
    static int grid = 0;
    if (grid == 0) {
        if (n_in != 20 || (size_t)out_size != O_END || ws_size < WS_END) { fprintf(stderr, "kernel_launch: unexpected sizes n_in %d out %d (want %zu) ws %zu (want %zu)\n", n_in, out_size, (size_t)O_END, ws_size, (size_t)WS_END); grid = -1; return; }
        int dev = 0, cus = 0, per_cu = 0;
        if (hipGetDevice(&dev) != hipSuccess || hipDeviceGetAttribute(&cus, hipDeviceAttributeMultiprocessorCount, dev) != hipSuccess) { grid = -1; return; }
        if (hipFuncSetAttribute((const void*)fwd_megakernel, hipFuncAttributeMaxDynamicSharedMemorySize, LDS_BYTES) != hipSuccess) { fprintf(stderr, "kernel_launch: hipFuncSetAttribute failed\n"); grid = -1; return; }
        if (hipOccupancyMaxActiveBlocksPerMultiprocessor(&per_cu, (const void*)fwd_megakernel, NTHR, LDS_BYTES) != hipSuccess || per_cu < 1) { fprintf(stderr, "kernel_launch: occupancy query reports %d\n", per_cu); (void)hipGetLastError(); per_cu = 1; }
        grid = cus;
    }
    if (grid < 0) return;
    if (hipMemsetAsync((char*)d_ws + WS_BAR, 0, BAR_BYTES, stream) != hipSuccess) { fprintf(stderr, "kernel_launch: memset of the barrier words failed\n"); return; }
    Params p{};
    for (int i = 0; i < 20; ++i) p.in[i] = (const float*)d_in[i];
    p.out = (float*)d_out; p.ws = (unsigned char*)d_ws;
    void* args[] = {&p};
    const hipError_t e = hipLaunchCooperativeKernel((const void*)fwd_megakernel, dim3(grid), dim3(NTHR), args, LDS_BYTES, stream);
    if (e != hipSuccess) fprintf(stderr, "kernel_launch: cooperative launch failed: %s (grid %d)\n", hipGetErrorString(e), grid);
}
```

```cpp
#include <hip/hip_runtime.h>
#include <hip/hip_cooperative_groups.h>
#include <cstdio>
#include <cstdint>
namespace cg = cooperative_groups;
#define WGM_G2 8
#define WGM_G4 8
namespace pg8 {
#define PG8_LAS __attribute__((address_space(3)))
typedef unsigned short bf16_t;
typedef short bf16x8 __attribute__((ext_vector_type(8)));
typedef float f32x4 __attribute__((ext_vector_type(4)));
typedef unsigned u32x4 __attribute__((ext_vector_type(4)));
typedef int i32x4 __attribute__((ext_vector_type(4)));
typedef int i32x8 __attribute__((ext_vector_type(8)));
constexpr int BM = 256, BK = 64, HALF = 128, HTB = HALF * BK * 2  , STAGE_BYTES = 8 * HTB, NXCD = 8, WGM = 6;

__host__ __device__ __forceinline__ int lds_byte(int r, int c) { const int st = (r >> 4) * 2 + (c >> 5), rr = r & 15, cc = c & 31, ob = rr * 64 + cc * 2; return st * 1024 + (ob ^ (((ob >> 9) & 1) << 5)); }
__host__ __device__ __forceinline__ void stage_rc(int b, int& R, int& C) { const int st = b / 1024, sb = b % 1024, swz = sb ^ (((sb >> 9) & 1) << 5); R = (st >> 1) * 16 + swz / 64; C = (st & 1) * 32 + (swz % 64) / 2; }
__host__ __device__ __forceinline__ int perm32(int rho) { const int n = rho >> 4, i = rho & 15; return 8 * (i >> 2) + 4 * n + (i & 3); }

struct Unit { int pm, pn, k0, nt, split; };
struct Gemm { const bf16_t* A; const bf16_t* Bt; int M, N, K; };

struct StaticOrder {
    int nM, nN, nwg, G, c, ntf, wgm;
    __host__ __device__ void init(int M, int N, int K, int G_, int c_, int wgm_ = WGM) { nM = M / BM; nN = N / BM; nwg = nM * nN; G = G_; c = c_; ntf = K / BK; wgm = wgm_; }
    __host__ __device__ bool next(int i, Unit& u) const {
        const long L = (long)i * G + c; if (L >= nwg) return false;
        int wgid = (int)L; { const int q = nwg / NXCD, r = nwg % NXCD, xcd = wgid % NXCD, off = wgid / NXCD; wgid = (xcd < r ? xcd * (q + 1) : r * (q + 1) + (xcd - r) * q) + off; }
        const int nig = wgm * nN, gid = wgid / nig, fm = gid * wgm, gsz = (nM - fm) < wgm ? (nM - fm) : wgm;
        u.pm = fm + ((wgid % nig) % gsz); u.pn = (wgid % nig) / gsz; u.k0 = 0; u.nt = ntf; u.split = -1; return true;
    }
    __device__ __forceinline__ void a_ready(const Unit&) const {}
    __device__ __forceinline__ void done(const Unit&) const {}
};
constexpr int NSPLIT = 4;
__host__ __device__ __forceinline__ bool split_ok(int Mfull, int Mprompt, int N, int G) { const int nN = N / BM; return (G >= 8 * nN * NSPLIT) && ((Mprompt / BM * nN) % G == 0) && ((Mfull - Mprompt) / BM == 8); }
struct TailSplitOrder {
    int pm0, nN, c, q, rem;
    __host__ __device__ void init(int Mprompt, int N, int K, int c_) { nN = N / BM; pm0 = Mprompt / BM; c = c_; const int ntf = K / BK; q = (ntf / NSPLIT) & ~1; rem = ntf - q * NSPLIT; }
    __host__ __device__ bool next(int i, Unit& u) const {
        if (i > 0 || c >= 8 * nN * NSPLIT) return false;
        const int tu = c % (8 * nN), s = c / (8 * nN), first_big = NSPLIT - rem / 2;
        u.pm = pm0 + tu / nN; u.pn = tu % nN; u.k0 = s * q + (s > first_big ? 2 * (s - first_big) : 0); u.nt = q + (s >= first_big ? 2 : 0); u.split = s; return true;
    }
    __device__ __forceinline__ void a_ready(const Unit&) const {}
    __device__ __forceinline__ void done(const Unit&) const {}
};
__device__ __forceinline__ unsigned cvt_pk_bf16(float lo, float hi) { unsigned r; asm volatile("v_cvt_pk_bf16_f32 %0, %1, %2" : "=v"(r) : "v"(lo), "v"(hi)); return r; }
constexpr float LN_EPS = 1e-5f;
constexpr float ALPHA = 1.41421356237309515f;
typedef unsigned u32x2 __attribute__((ext_vector_type(2)));
__device__ __forceinline__ void unpack8(const u32x4 w, float (&f)[8]) {
    f[0] = __uint_as_float(w.x << 16); f[1] = __uint_as_float(w.x & 0xffff0000u); f[2] = __uint_as_float(w.y << 16); f[3] = __uint_as_float(w.y & 0xffff0000u);
    f[4] = __uint_as_float(w.z << 16); f[5] = __uint_as_float(w.z & 0xffff0000u); f[6] = __uint_as_float(w.w << 16); f[7] = __uint_as_float(w.w & 0xffff0000u);
}
__device__ __forceinline__ void unpack4(const u32x2 w, float (&f)[4]) {
    f[0] = __uint_as_float(w.x << 16); f[1] = __uint_as_float(w.x & 0xffff0000u); f[2] = __uint_as_float(w.y << 16); f[3] = __uint_as_float(w.y & 0xffff0000u);
}
__device__ __forceinline__ u32x4 pack8(const float (&f)[8]) { u32x4 w; w.x = cvt_pk_bf16(f[0], f[1]); w.y = cvt_pk_bf16(f[2], f[3]); w.z = cvt_pk_bf16(f[4], f[5]); w.w = cvt_pk_bf16(f[6], f[7]); return w; }
__device__ __forceinline__ void row_stats(const float* st, int row, float& mu, float& rstd) {
    typedef float f32x2v __attribute__((ext_vector_type(2)));
    const f32x2v a = *(const f32x2v*)(st + (size_t)row * 2); mu = a[0]; rstd = a[1];
}
__device__ __forceinline__ void load8f(const float* p, float (&f)[8]) { const f32x4 a = *(const f32x4*)p, b = *(const f32x4*)(p + 4); f[0] = a[0]; f[1] = a[1]; f[2] = a[2]; f[3] = a[3]; f[4] = b[0]; f[5] = b[1]; f[6] = b[2]; f[7] = b[3]; }

struct EpiProj {
    static constexpr bool PERM = true, AFTER_DRAIN = false;
    bf16_t* O; int ldo; const float* stats; const float* c1; const float* c2;
    __device__ __forceinline__ void operator()(f32x4 (&acc)[2][2][4][2], const Unit& u, int wr, int wc, int fr, int fq) const {
        const int row0 = u.pm * BM + wr * 64 + fr, col0 = u.pn * BM + wc * 32 + 8 * fq;
        const bool ln = stats != nullptr;
        float rs8[8], nm8[8];
#pragma unroll
        for (int i = 0; i < 8; ++i) { float mu = 0.f; rs8[i] = 1.f; if (ln) row_stats(stats, row0 + (i >> 2) * HALF + (i & 3) * 16, mu, rs8[i]); nm8[i] = -rs8[i] * mu; }
#pragma unroll
        for (int bj = 0; bj < 2; ++bj) {
            float k1[8], k2[8];
            if (ln) { load8f(c1 + col0 + bj * HALF, k1); load8f(c2 + col0 + bj * HALF, k2); }
            else {
#pragma unroll
                for (int q = 0; q < 8; ++q) { k1[q] = 0.f; k2[q] = 0.f; } }
#pragma unroll
            for (int ai = 0; ai < 2; ++ai)
#pragma unroll
                for (int m = 0; m < 4; ++m) {
                    const float rs = rs8[ai * 4 + m], nm = nm8[ai * 4 + m];
#pragma unroll
                    for (int q = 0; q < 4; ++q) { acc[ai][bj][m][0][q] = rs * acc[ai][bj][m][0][q] + (nm * k1[q] + k2[q]); acc[ai][bj][m][1][q] = rs * acc[ai][bj][m][1][q] + (nm * k1[4 + q] + k2[4 + q]); }
                }
        }
        asm volatile("" ::: "memory");
#pragma unroll
        for (int ai = 0; ai < 2; ++ai)
#pragma unroll
            for (int m = 0; m < 4; ++m) {
                const int row = row0 + ai * HALF + m * 16;
#pragma unroll
                for (int bj = 0; bj < 2; ++bj) { u32x4 w; w.x = cvt_pk_bf16(acc[ai][bj][m][0][0], acc[ai][bj][m][0][1]); w.y = cvt_pk_bf16(acc[ai][bj][m][0][2], acc[ai][bj][m][0][3]);
                    w.z = cvt_pk_bf16(acc[ai][bj][m][1][0], acc[ai][bj][m][1][1]); w.w = cvt_pk_bf16(acc[ai][bj][m][1][2], acc[ai][bj][m][1][3]);
                    *(u32x4*)(O + (size_t)row * ldo + col0 + bj * HALF) = w; }
            }
    }
};
template <bool F8OUT> struct EpiSwiGLU {
    static constexpr bool PERM = true, AFTER_DRAIN = false;
    bf16_t* O; int ldo; const float* stats; const float* c1; const float* c2;
    __device__ __forceinline__ void operator()(f32x4 (&acc)[2][2][4][2], const Unit& u, int wr, int wc, int fr, int fq) const {
        const int row0 = u.pm * BM + wr * 64 + fr, cidx = u.pn * BM + wc * 32 + 8 * fq, ocol = u.pn * HALF + wc * 32 + 8 * fq;
        float rs8[8], nm8[8];
#pragma unroll
        for (int i = 0; i < 8; ++i) { float mu; row_stats(stats, row0 + (i >> 2) * HALF + (i & 3) * 16, mu, rs8[i]); nm8[i] = -rs8[i] * mu; }
        float k1g[8], k2g[8], k1u[8], k2u[8];
        load8f(c1 + cidx, k1g); load8f(c2 + cidx, k2g); load8f(c1 + cidx + HALF, k1u); load8f(c2 + cidx + HALF, k2u);
#pragma unroll
        for (int ai = 0; ai < 2; ++ai)
#pragma unroll
            for (int m = 0; m < 4; ++m) {
                const int row = row0 + ai * HALF + m * 16;
                const float rs = rs8[ai * 4 + m], nm = nm8[ai * 4 + m];
                float o[8];
#pragma unroll
                for (int q = 0; q < 8; ++q) {
                    const float ga = (q < 4) ? acc[ai][0][m][0][q & 3] : acc[ai][0][m][1][q & 3], ua = (q < 4) ? acc[ai][1][m][0][q & 3] : acc[ai][1][m][1][q & 3];
                    const float g = rs * ga + (nm * k1g[q] + k2g[q]), up = rs * ua + (nm * k1u[q] + k2u[q]);
                    o[q] = g * __builtin_amdgcn_rcpf(1.f + __expf(-g)) * up;
                }
                if constexpr (F8OUT) { int w0 = 0, w1 = 0; w0 = __builtin_amdgcn_cvt_pk_fp8_f32(o[0], o[1], w0, false); w0 = __builtin_amdgcn_cvt_pk_fp8_f32(o[2], o[3], w0, true);
                    w1 = __builtin_amdgcn_cvt_pk_fp8_f32(o[4], o[5], w1, false); w1 = __builtin_amdgcn_cvt_pk_fp8_f32(o[6], o[7], w1, true);
                    u32x2 w; w.x = (unsigned)w0; w.y = (unsigned)w1; *(u32x2*)((unsigned char*)O + (size_t)row * ldo + ocol) = w; }
                else *(u32x4*)(O + (size_t)row * ldo + ocol) = pack8(o);
            }
    }
};
template <int RB> struct EpiRes {
    static constexpr bool PERM = true, AFTER_DRAIN = false;
    bf16_t* O; const bf16_t* R; const float* stats_in; const float* g; const float* b; float* stats_out; PG8_LAS float* pst; float accscale;
    __device__ __forceinline__ void operator()(f32x4 (&acc)[2][2][4][2], const Unit& u, int wr, int wc, int fr, int fq) const {
        const int row0 = u.pm * BM + wr * 64 + fr, col0 = u.pn * BM + wc * 32 + 8 * fq;
        const bool ln = stats_in != nullptr;
#pragma unroll
        for (int bj = 0; bj < 2; ++bj) {
            float gg[8], bb[8];
            if (ln) { load8f(g + col0 + bj * HALF, gg); load8f(b + col0 + bj * HALF, bb); }
            else {
#pragma unroll
                for (int q = 0; q < 8; ++q) { gg[q] = 1.f; bb[q] = 0.f; } }
#pragma unroll
            for (int ai = 0; ai < 2; ++ai)
#pragma unroll
            for (int mh = 0; mh < 4; mh += RB) {
                u32x4 rw[RB];
                asm volatile("" ::: "memory");
#pragma unroll
                for (int mm = 0; mm < RB; ++mm) rw[mm] = *(const u32x4*)((const char*)R + (size_t)(((unsigned)(row0 + ai * HALF + (mh + mm) * 16) * 1024u + (unsigned)(col0 + bj * HALF)) * 2u));
                float mu4[RB], rs4[RB];
#pragma unroll
                for (int mm = 0; mm < RB; ++mm) { mu4[mm] = 0.f; rs4[mm] = 1.f; if (ln) row_stats(stats_in, row0 + ai * HALF + (mh + mm) * 16, mu4[mm], rs4[mm]); }
#pragma unroll
                for (int mm = 0; mm < RB; ++mm) { const int m = mh + mm;
                    const float mu = mu4[mm], rs = rs4[mm];
                    float r[8]; unpack8(rw[mm], r);
#pragma unroll
                    for (int n = 0; n < 2; ++n)
#pragma unroll
                        for (int q4 = 0; q4 < 4; ++q4) { const int q = n * 4 + q4;
                            const float xr = (r[q] - mu) * rs * gg[q] + bb[q];
                            const float a = ALPHA * xr + accscale * acc[ai][bj][m][n][q4];
                            acc[ai][bj][m][n][q4] = a; }
                }
                if constexpr (RB == 4) asm volatile("" : "+v"(acc[ai][bj][0][0]), "+v"(acc[ai][bj][0][1]), "+v"(acc[ai][bj][1][0]), "+v"(acc[ai][bj][1][1]), "+v"(acc[ai][bj][2][0]), "+v"(acc[ai][bj][2][1]), "+v"(acc[ai][bj][3][0]), "+v"(acc[ai][bj][3][1]) :: "memory");
                else asm volatile("" : "+v"(acc[ai][bj][mh][0]), "+v"(acc[ai][bj][mh][1]), "+v"(acc[ai][bj][mh + 1][0]), "+v"(acc[ai][bj][mh + 1][1]) :: "memory");
            }
        }
        asm volatile("" ::: "memory");
#pragma unroll
        for (int ai = 0; ai < 2; ++ai)
#pragma unroll
            for (int m = 0; m < 4; ++m) {
                const int row = row0 + ai * HALF + m * 16;
                float s = 0.f, q2 = 0.f;
#pragma unroll
                for (int bj = 0; bj < 2; ++bj) {
#pragma unroll
                    for (int n = 0; n < 2; ++n)
#pragma unroll
                        for (int q4 = 0; q4 < 4; ++q4) { const float a = acc[ai][bj][m][n][q4]; s += a; q2 += a * a; }
                    u32x4 w; w.x = cvt_pk_bf16(acc[ai][bj][m][0][0], acc[ai][bj][m][0][1]); w.y = cvt_pk_bf16(acc[ai][bj][m][0][2], acc[ai][bj][m][0][3]);
                    w.z = cvt_pk_bf16(acc[ai][bj][m][1][0], acc[ai][bj][m][1][1]); w.w = cvt_pk_bf16(acc[ai][bj][m][1][2], acc[ai][bj][m][1][3]);
                    *(u32x4*)((char*)O + (size_t)(((unsigned)row * 1024u + (unsigned)(col0 + bj * HALF)) * 2u)) = w; }
                s += __shfl_xor(s, 16); s += __shfl_xor(s, 32); q2 += __shfl_xor(q2, 16); q2 += __shfl_xor(q2, 32);
                if (fq == 0) { PG8_LAS float* p = pst + ((ai * HALF + wr * 64 + m * 16 + fr) * 4 + wc) * 2; p[0] = s; p[1] = q2; }
            }
        asm volatile("s_waitcnt lgkmcnt(0)" ::: "memory"); __builtin_amdgcn_s_barrier(); asm volatile("" ::: "memory");
        if (threadIdx.x < 256) {
            const int row = threadIdx.x; const PG8_LAS f32x4* p = (const PG8_LAS f32x4*)(pst + row * 8);
            const f32x4 a = p[0], c = p[1];
            typedef float f32x2v __attribute__((ext_vector_type(2)));
            *(f32x2v*)(stats_out + ((size_t)(u.pm * BM + row) * 4 + u.pn) * 2) = (f32x2v){(a[0] + a[2]) + (c[0] + c[2]), (a[1] + a[3]) + (c[1] + c[3])};
        }
    }
};

struct EpiPart {
    static constexpr bool PERM = true, AFTER_DRAIN = false;
    float* part; int part_row0, part_rows; float accscale;
    __device__ __forceinline__ void operator()(f32x4 (&acc)[2][2][4][2], const Unit& u, int wr, int wc, int fr, int fq) const {
        const int row0 = u.pm * BM + wr * 64 + fr, col0 = u.pn * BM + wc * 32 + 8 * fq;
        const unsigned pb = (((unsigned)u.split * (unsigned)part_rows + (unsigned)(row0 - part_row0)) * 1024u + (unsigned)col0) * 4u;
#pragma unroll
        for (int ai = 0; ai < 2; ++ai)
#pragma unroll
            for (int m = 0; m < 4; ++m)
#pragma unroll
                for (int bj = 0; bj < 2; ++bj) { float* p = (float*)((char*)part + (size_t)(pb + (unsigned)((ai * HALF + m * 16) * 1024 + bj * HALF) * 4u)); *(f32x4*)p = acc[ai][bj][m][0] * accscale; *(f32x4*)(p + 4) = acc[ai][bj][m][1] * accscale; }
    }
};

struct EpiRaw {
    static constexpr bool PERM = true, AFTER_DRAIN = false;
    __device__ __forceinline__ void prefetch(const Unit&, PG8_LAS unsigned char*, int) const {}
    bf16_t* O; int ldo; float scale;
    __device__ __forceinline__ void operator()(f32x4 (&acc)[2][2][4][2], const Unit& u, int wr, int wc, int fr, int fq) const {
        const int row0 = u.pm * BM + wr * 64 + fr, col0 = u.pn * BM + wc * 32 + 8 * fq;
#pragma unroll
        for (int ai = 0; ai < 2; ++ai)
#pragma unroll
            for (int m = 0; m < 4; ++m)
#pragma unroll
                for (int bj = 0; bj < 2; ++bj) { u32x4 w; const f32x4 a = acc[ai][bj][m][0] * scale, b = acc[ai][bj][m][1] * scale;
                    w.x = cvt_pk_bf16(a[0], a[1]); w.y = cvt_pk_bf16(a[2], a[3]); w.z = cvt_pk_bf16(b[0], b[1]); w.w = cvt_pk_bf16(b[2], b[3]);
                    *(u32x4*)((char*)O + (size_t)(((unsigned)(row0 + ai * HALF + m * 16) * (unsigned)ldo + (unsigned)(col0 + bj * HALF)) * 2u)) = w; }
    }
};
template <class Epi, class Sched, bool ALIGN_EPI = false, bool SP2 = false, bool FP8 = false>
__device__ __forceinline__ void gemm_phase(PG8_LAS unsigned char* lds, const Gemm g, const Sched& S, const Epi& E) {
    int tid_ = threadIdx.x; asm volatile("" : "+v"(tid_));
    const int tid = tid_, wid = __builtin_amdgcn_readfirstlane(tid >> 6), lane = tid & 63, wr = wid >> 2, wc = wid & 3, fr = lane & 15, fq = lane >> 4;
    const int K = g.K;
    unsigned voffA[2], voffB[2];
#pragma unroll
    for (int i = 0; i < 2; ++i) { int R, C; stage_rc(tid * 16 + i * 8192, R, C); const int Rb = Epi::PERM ? ((R & ~31) + perm32(R & 31)) : R;
        voffA[i] = (unsigned)(R * K + C) * 2u; voffB[i] = (unsigned)(Rb * K + C) * 2u; }
    const size_t kstep = (size_t)(BK * 2);
    const size_t hstep = (size_t)HALF * K * 2;
    const size_t tstep = 2 * hstep;
    const unsigned ldsw = (unsigned)wid * 1024u;
    const int aoff = lds_byte(wr * 64 + fr, fq * 8), boff = lds_byte(wc * 32 + fr, fq * 8);
#define PG8_SA(b, h) (((b) * 2 + (h)) * HTB)
#define PG8_SB(b, h) ((4 + (b) * 2 + (h)) * HTB)
#define PG8_STAGE(bufoff, gbase, voff) do { _Pragma("unroll") for (int _i = 0; _i < 2; ++_i) \
        __builtin_amdgcn_global_load_lds((const unsigned*)((const char*)(gbase) + (voff)[_i]), (PG8_LAS unsigned*)(lds + (bufoff) + ldsw + _i * 8192), 16, 0, 0); } while (0)
#define PG8_LDA(dst, b, h) do { if constexpr (FP8) { _Pragma("unroll") for (int m = 0; m < 4; ++m) { const i32x4 lo_ = *(const PG8_LAS i32x4*)(lds + PG8_SA(b, h) + aoff + m * 2048), hi_ = *(const PG8_LAS i32x4*)(lds + PG8_SA(b, h) + aoff + m * 2048 + 1024); \
            dst##8[m] = __builtin_shufflevector(lo_, hi_, 0, 1, 2, 3, 4, 5, 6, 7); } } \
        else { _Pragma("unroll") for (int m = 0; m < 4; ++m) _Pragma("unroll") for (int k = 0; k < 2; ++k) dst[m][k] = *(const PG8_LAS bf16x8*)(lds + PG8_SA(b, h) + aoff + m * 2048 + k * 1024); } } while (0)
#define PG8_LDB(dst, b, h) do { if constexpr (FP8) { _Pragma("unroll") for (int n = 0; n < 2; ++n) { const i32x4 lo_ = *(const PG8_LAS i32x4*)(lds + PG8_SB(b, h) + boff + n * 2048), hi_ = *(const PG8_LAS i32x4*)(lds + PG8_SB(b, h) + boff + n * 2048 + 1024); \
            dst##8[n] = __builtin_shufflevector(lo_, hi_, 0, 1, 2, 3, 4, 5, 6, 7); } } \
        else { _Pragma("unroll") for (int n = 0; n < 2; ++n) _Pragma("unroll") for (int k = 0; k < 2; ++k) dst[n][k] = *(const PG8_LAS bf16x8*)(lds + PG8_SB(b, h) + boff + n * 2048 + k * 1024); } } while (0)
#define PG8_MMA(ai, bj, At, Bt) do { __builtin_amdgcn_s_setprio(1); \
        if constexpr (FP8) { _Pragma("unroll") for (int m = 0; m < 4; ++m) _Pragma("unroll") for (int n = 0; n < 2; ++n) \
            asm volatile("v_mfma_f32_16x16x128_f8f6f4 %0, %1, %2, %0" : "+v"(acc[ai][bj][m][n]) : "v"(Bt##8[n]), "v"(At##8[m])); } \
        else { _Pragma("unroll") for (int m = 0; m < 4; ++m) _Pragma("unroll") for (int n = 0; n < 2; ++n) _Pragma("unroll") for (int k = 0; k < 2; ++k) \
            acc[ai][bj][m][n] = __builtin_amdgcn_mfma_f32_16x16x32_bf16(Bt[n][k], At[m][k], acc[ai][bj][m][n], 0, 0, 0); } \
        __builtin_amdgcn_s_setprio(0); } while (0)
#define PG8_WAIT_V(n) asm volatile("s_waitcnt vmcnt(" #n ")" ::: "memory")
#define PG8_WAIT_L(n) asm volatile("s_waitcnt lgkmcnt(" #n ")" ::: "memory")
#define PG8_BAR __builtin_amdgcn_s_barrier()
#define PG8_SCHED __builtin_amdgcn_sched_barrier(0)
    Unit cur, nxt; int ui = 0;
    if (!S.next(0, cur)) return;
    f32x4 acc[2][2][4][2];
#pragma unroll
    for (int a = 0; a < 2; ++a)
#pragma unroll
        for (int b = 0; b < 2; ++b)
#pragma unroll
            for (int m = 0; m < 4; ++m)
#pragma unroll
                for (int n = 0; n < 2; ++n) acc[a][b][m][n] = (f32x4){0.f, 0.f, 0.f, 0.f};
    bf16x8 At[4][2], B0[2][2], B1[2][2]; i32x8 At8[4], B08[2], B18[2];
    const char* cA = (const char*)g.A + (size_t)cur.pm * tstep + (size_t)cur.k0 * kstep; const char* cB = (const char*)g.Bt + (size_t)cur.pn * tstep + (size_t)cur.k0 * kstep;
    S.a_ready(cur);
    if constexpr (SP2) {
        PG8_STAGE(PG8_SB(0, 0), cB, voffB); PG8_STAGE(PG8_SB(0, 1), cB + hstep, voffB); PG8_STAGE(PG8_SA(0, 0), cA, voffA); PG8_STAGE(PG8_SA(0, 1), cA + hstep, voffA);
        if (wr == 1) PG8_BAR;
        PG8_WAIT_V(2); PG8_BAR;
        PG8_STAGE(PG8_SB(1, 0), cB + kstep, voffB); PG8_STAGE(PG8_SA(1, 0), cA + kstep, voffA); PG8_STAGE(PG8_SB(1, 1), cB + hstep + kstep, voffB);
        PG8_WAIT_V(6); PG8_BAR;
    } else {
        PG8_STAGE(PG8_SB(0, 0), cB, voffB); PG8_STAGE(PG8_SA(0, 0), cA, voffA); PG8_STAGE(PG8_SB(0, 1), cB + hstep, voffB); PG8_STAGE(PG8_SA(0, 1), cA + hstep, voffA);
        if (wr == 1) PG8_BAR;
        PG8_WAIT_V(4); PG8_BAR;
        PG8_STAGE(PG8_SB(1, 0), cB + kstep, voffB); PG8_STAGE(PG8_SA(1, 0), cA + kstep, voffA); PG8_STAGE(PG8_SB(1, 1), cB + hstep + kstep, voffB);
        PG8_WAIT_V(6); PG8_BAR;
    }
    for (;;) {
        const bool has_next = S.next(ui + 1, nxt);
        const char* nA = has_next ? (const char*)g.A + (size_t)nxt.pm * tstep + (size_t)nxt.k0 * kstep : cA; const char* nB = has_next ? (const char*)g.Bt + (size_t)nxt.pn * tstep + (size_t)nxt.k0 * kstep : cB;
        const int nt = cur.nt;
#ifndef KREP
#define KREP 1
#endif
        for (int tt_ = 0; tt_ < nt * KREP; tt_ += 2) {
            const int t = (KREP > 1 && tt_ >= nt) ? tt_ - nt : tt_;
            if (KREP > 1 && tt_ == nt) {
#pragma unroll
                for (int a = 0; a < 2; ++a)
#pragma unroll
                    for (int b2_ = 0; b2_ < 2; ++b2_)
#pragma unroll
                        for (int m = 0; m < 4; ++m)
#pragma unroll
                            for (int n = 0; n < 2; ++n) acc[a][b2_][m][n] = (f32x4){0.f, 0.f, 0.f, 0.f}; }
            const bool last = (tt_ == nt * KREP - 2);
            const char* a1 = cA + (size_t)(t + 1) * kstep;
            const int t2 = (KREP > 1 && t + 2 >= nt) ? t + 2 - nt : t + 2;
            const char* a2 = last ? nA : cA + (size_t)t2 * kstep; const char* b2 = last ? nB : cB + (size_t)t2 * kstep;
            const char* a3 = a2 + kstep; const char* b3 = b2 + kstep;
            if (last && has_next) S.a_ready(nxt);
            if constexpr (SP2) {
            PG8_LDB(B0, 0, 0); PG8_LDB(B1, 0, 1); PG8_SCHED; PG8_LDA(At, 0, 0); PG8_STAGE(PG8_SA(1, 1), a1 + hstep, voffA);
            PG8_WAIT_V(8); PG8_WAIT_L(0); PG8_BAR; PG8_MMA(0, 0, At, B0); PG8_MMA(0, 1, At, B1); PG8_BAR; PG8_SCHED;
            PG8_LDA(At, 0, 1); PG8_STAGE(PG8_SB(0, 0), b2, voffB); PG8_STAGE(PG8_SB(0, 1), b2 + hstep, voffB); PG8_STAGE(PG8_SA(0, 0), a2, voffA);
            PG8_WAIT_V(8); PG8_WAIT_L(0); PG8_BAR; PG8_MMA(1, 0, At, B0); PG8_MMA(1, 1, At, B1); PG8_BAR; PG8_SCHED;
            PG8_LDB(B0, 1, 0); PG8_LDB(B1, 1, 1); PG8_SCHED; PG8_LDA(At, 1, 0); PG8_STAGE(PG8_SA(0, 1), a2 + hstep, voffA);
            PG8_WAIT_V(8); PG8_WAIT_L(0); PG8_BAR; PG8_MMA(0, 0, At, B0); PG8_MMA(0, 1, At, B1); PG8_BAR; PG8_SCHED;
            PG8_LDA(At, 1, 1); PG8_STAGE(PG8_SB(1, 0), b3, voffB); PG8_STAGE(PG8_SB(1, 1), b3 + hstep, voffB); PG8_STAGE(PG8_SA(1, 0), a3, voffA);
            PG8_WAIT_V(8); PG8_WAIT_L(0); PG8_BAR; PG8_MMA(1, 0, At, B0); PG8_MMA(1, 1, At, B1); PG8_BAR; PG8_SCHED;
            } else {
            PG8_LDB(B0, 0, 0); PG8_SCHED; PG8_LDA(At, 0, 0); PG8_STAGE(PG8_SA(1, 1), a1 + hstep, voffA);
            PG8_WAIT_L(8); PG8_BAR; PG8_WAIT_L(0); PG8_MMA(0, 0, At, B0); PG8_BAR; PG8_SCHED;
            PG8_LDB(B1, 0, 1); PG8_STAGE(PG8_SB(0, 0), b2, voffB);
            PG8_BAR; PG8_WAIT_L(0); PG8_MMA(0, 1, At, B1); PG8_BAR;
            PG8_LDA(At, 0, 1); PG8_STAGE(PG8_SA(0, 0), a2, voffA);
            PG8_BAR; PG8_WAIT_L(0); PG8_MMA(1, 0, At, B0); PG8_BAR; PG8_SCHED;
            PG8_STAGE(PG8_SB(0, 1), b2 + hstep, voffB);
            PG8_WAIT_V(6); PG8_BAR; PG8_MMA(1, 1, At, B1); PG8_BAR;
            PG8_LDB(B0, 1, 0); PG8_SCHED; PG8_LDA(At, 1, 0); PG8_STAGE(PG8_SA(0, 1), a2 + hstep, voffA);
            PG8_WAIT_L(8); PG8_BAR; PG8_WAIT_L(0); PG8_MMA(0, 0, At, B0); PG8_BAR; PG8_SCHED;
            PG8_LDB(B1, 1, 1); PG8_STAGE(PG8_SB(1, 0), b3, voffB);
            PG8_BAR; PG8_WAIT_L(0); PG8_MMA(0, 1, At, B1); PG8_BAR;
            PG8_LDA(At, 1, 1); PG8_STAGE(PG8_SA(1, 0), a3, voffA);
            PG8_BAR; PG8_WAIT_L(0); PG8_MMA(1, 0, At, B0); PG8_BAR; PG8_SCHED;
            PG8_STAGE(PG8_SB(1, 1), b3 + hstep, voffB);
            PG8_WAIT_V(6); PG8_BAR; PG8_MMA(1, 1, At, B1); PG8_BAR;
            }
        }
        if constexpr (FP8) asm volatile("s_nop 15\n\ts_nop 7" ::: "memory");
        if constexpr (ALIGN_EPI) { if (wr == 0) PG8_BAR; }
        if constexpr (!Epi::AFTER_DRAIN) { E(acc, cur, wr, wc, fr, fq); S.done(cur); }
        if (!has_next) break;
#pragma unroll
        for (int a = 0; a < 2; ++a)
#pragma unroll
            for (int b = 0; b < 2; ++b)
#pragma unroll
                for (int m = 0; m < 4; ++m)
#pragma unroll
                    for (int n = 0; n < 2; ++n) acc[a][b][m][n] = (f32x4){0.f, 0.f, 0.f, 0.f};
        cur = nxt; cA = nA; cB = nB; ++ui;
        if constexpr (ALIGN_EPI) { if (wr == 1) PG8_BAR; }
    }
    PG8_WAIT_V(0);
    if constexpr (!ALIGN_EPI) { if (wr == 0) PG8_BAR; }
    PG8_BAR;
    if constexpr (Epi::AFTER_DRAIN) { E.fused(acc, cur, wr, wc, fr, fq, lds, wid, lane); S.done(cur); }
#undef PG8_SA
#undef PG8_SB
#undef PG8_STAGE
#undef PG8_LDA
#undef PG8_LDB
#undef PG8_MMA
#undef PG8_WAIT_V
#undef PG8_WAIT_L
#undef PG8_BAR
#undef PG8_SCHED
}
}
#ifndef WGM_G2
#define WGM_G2 6
#endif
#ifndef WGM_G4
#define WGM_G4 6
#endif
#ifndef F8_ALL
#define F8_ALL 1
#endif
#ifndef F8_LAST
#define F8_LAST 1
#endif
constexpr float WD8_SCALE = 128.f;
#ifndef REP_P0
#define REP_P0 1
#endif
#ifndef REP_G1
#define REP_G1 1
#endif
#ifndef REP_MIX
#define REP_MIX 1
#endif
#ifndef REP_G2
#define REP_G2 1
#endif
#ifndef REP_G3
#define REP_G3 1
#endif
#ifndef REP_G4
#define REP_G4 1
#endif
#ifndef REP_FIN
#define REP_FIN 1
#endif
#ifndef REP_SYNC
#define REP_SYNC 1
#endif
using pg8::bf16_t; using pg8::bf16x8; using pg8::f32x4; using pg8::u32x4; using pg8::u32x2; using pg8::unpack8; using pg8::unpack4; using pg8::pack8; using pg8::cvt_pk_bf16; using pg8::load8f;
#define LAS __attribute__((address_space(3)))
constexpr int NWAVES = 8, NTHR = 512;
constexpr int D = 1024, DIN = 2048, DFF = 2816, NGU = 2 * DFF, DEPTH = 2;
constexpr int TP = 8 * 8192, TS = 32 * 64, T = TP + TS;
constexpr int LDS_BYTES = 155648, PST_OFF = 131072, MISC_OFF = LDS_BYTES - 64;
constexpr size_t al256(size_t x) { return (x + 255) & ~(size_t)255; }
constexpr size_t SZ_WIN = (size_t)DIN * D * 2, SZ_WOUT = (size_t)D * D * 2, SZ_WGU = (size_t)NGU * D * 2, SZ_WD = (size_t)D * DFF * 2, SZ_WSB = 8 * 128 * 128 * 2, SZ_WPT = 4 * 64 * 64 * 2;
constexpr size_t WS_WIN = 0, WS_WOUT = WS_WIN + DEPTH * SZ_WIN, WS_WGU = WS_WOUT + DEPTH * SZ_WOUT, WS_WD = WS_WGU + DEPTH * SZ_WGU, WS_WSB = WS_WD + DEPTH * SZ_WD, WS_WPT = WS_WSB + DEPTH * SZ_WSB;
constexpr size_t WS_C1IN = WS_WPT + DEPTH * SZ_WPT, WS_C2IN = WS_C1IN + DEPTH * DIN * 4, WS_C1GU = WS_C2IN + DEPTH * DIN * 4, WS_C2GU = WS_C1GU + DEPTH * NGU * 4;
constexpr size_t WS_BAR = al256(WS_C2GU + DEPTH * NGU * 4), BAR_BYTES = 16384;
constexpr size_t WS_ST1P = WS_BAR + BAR_BYTES, WS_ST2P = WS_ST1P + (size_t)T * 32, WS_ST1 = WS_ST2P + (size_t)T * 32, WS_ST2 = WS_ST1 + (size_t)T * 8;
constexpr size_t SZ_ACT = (size_t)T * D * 2;
constexpr size_t WS_XB = al256(WS_ST2 + (size_t)T * 8), WS_P1 = WS_XB + SZ_ACT, WS_P2 = WS_P1 + SZ_ACT, WS_PROJ = WS_P2 + SZ_ACT, WS_CAT = WS_PROJ + 2 * SZ_ACT, WS_HID = WS_PROJ, WS_PART = WS_CAT + SZ_ACT, WS_END = WS_PART + (size_t)pg8::NSPLIT * TS * D * 4;
static_assert((size_t)T * DFF * 2 <= 3 * SZ_ACT, "hid overlays proj|cat");
constexpr size_t O_YP = 0, O_YS = (size_t)TP * D, O_POOLP = (size_t)T * D, O_POOLS = O_POOLP + (size_t)DEPTH * 8 * 15 * 256, O_CONVP = O_POOLS + (size_t)DEPTH * 32 * 15 * 256,
                 O_CONVS = O_CONVP + (size_t)DEPTH * 8 * 2 * 256, O_V = O_CONVS + (size_t)DEPTH * 32 * 2 * 256, O_END = O_V + (size_t)DEPTH * 32 * 64 * 512;

struct Params { const float* in[20]; float* out; unsigned char* ws; };

__device__ __forceinline__ float wave_sum(float v) {
#pragma unroll
    for (int o = 1; o < 64; o <<= 1) v += __shfl_xor(v, o);
    return v;
}
__device__ __forceinline__ float bf2f(bf16_t h) { return __uint_as_float(((unsigned)h) << 16); }
#define LDS_WAIT() asm volatile("s_waitcnt lgkmcnt(0)" ::: "memory")

#define XB_TMO      128
#define XB_XCNT(j)  (256  + 64 * (j))
#define XB_XSUB(j)  (1280 + 64 * (j))
#define XB_XGEN(j)  (2304 + 64 * (j))
#define XB_TOP      3328
#define XB_TOPGEN   3392
#define XCD_BAR_WORDS 3456
#define XB_SPIN_CAP (1u << 18)

__device__ __forceinline__ unsigned xb_ld(unsigned* p)              { return __hip_atomic_load(p, __ATOMIC_RELAXED, __HIP_MEMORY_SCOPE_AGENT); }
__device__ __forceinline__ unsigned xb_add(unsigned* p, unsigned v) { return __hip_atomic_fetch_add(p, v, __ATOMIC_RELAXED, __HIP_MEMORY_SCOPE_AGENT); }
__device__ __forceinline__ unsigned xb_xcc_id() { return (unsigned)__builtin_amdgcn_s_getreg((3 << 11) | 20) & 0xFu; }
#define XB_SPIN(cond, bar) do { unsigned _sp = 0; while (cond) { __builtin_amdgcn_s_sleep(1); \
    if ((++_sp & 255u) == 0u) { if (xb_ld(&(bar)[XB_TMO])) break; if (_sp > XB_SPIN_CAP) { atomicAdd(&(bar)[XB_TMO], 1u); break; } } } } while (0)

struct XcdBarrier {
    unsigned* bar; unsigned x;
    volatile LAS unsigned* st;
};

__device__ __forceinline__ XcdBarrier xcd_barrier_post(unsigned* bar, volatile LAS unsigned* st) {
    XcdBarrier b; b.bar = bar; b.x = xb_xcc_id(); b.st = st;
    if (threadIdx.x == 0) (void)xb_add(&bar[XB_XCNT(b.x)], 1u);
    return b;
}
__device__ __forceinline__ void xcd_barrier_complete(unsigned* bar, unsigned x, unsigned& nloc, unsigned& nx) {
    const unsigned G = gridDim.x * gridDim.y * gridDim.z;
    unsigned sum, cnt, mine, sp = 0u;
    for (;;) {
        sum = 0u; cnt = 0u; mine = 0u;
#pragma unroll
        for (unsigned j = 0; j < 16; ++j) { const unsigned c = xb_ld(&bar[XB_XCNT(j)]); sum += c; cnt += (c > 0u) ? 1u : 0u; mine = (j == x) ? c : mine; }
        if (sum == G) break;
        __builtin_amdgcn_s_sleep(1);
        if ((++sp & 255u) == 0u) { if (xb_ld(&bar[XB_TMO])) break; if (sp > XB_SPIN_CAP) { atomicAdd(&bar[XB_TMO], 1u); break; } }
    }
    nloc = mine > 0u ? mine : 1u; nx = cnt > 0u ? cnt : 1u;
}

__device__ __forceinline__ void xcd_barrier(const XcdBarrier& b) {
    asm volatile("s_waitcnt vmcnt(0)" ::: "memory");
    __syncthreads();
    if (threadIdx.x == 0) {
        unsigned* bar = b.bar;
        __builtin_amdgcn_s_waitcnt(0);
        unsigned nloc = b.st[0], nx = b.st[1];
        if (nloc == 0u) { xcd_barrier_complete(bar, b.x, nloc, nx); b.st[0] = nloc; b.st[1] = nx; }
        const unsigned old = xb_add(&bar[XB_XSUB(b.x)], 1u);
        const unsigned gen = old / nloc;
        if (old + 1u == (gen + 1u) * nloc) {
            __builtin_amdgcn_fence(__ATOMIC_RELEASE, "agent");
            asm volatile("s_waitcnt vmcnt(0)" ::: "memory");
            const unsigned og = xb_add(&bar[XB_TOP], 1u);
            const unsigned tg = og / nx;
            if (og + 1u == (tg + 1u) * nx) xb_add(&bar[XB_TOPGEN], 1u);
            else XB_SPIN(xb_ld(&bar[XB_TOPGEN]) == tg, bar);
            __builtin_amdgcn_fence(__ATOMIC_ACQUIRE, "agent");
            xb_add(&bar[XB_XGEN(b.x)], 1u);
            asm volatile("s_waitcnt vmcnt(0)" ::: "memory");
        } else {
            XB_SPIN(xb_ld(&bar[XB_XGEN(b.x)]) == gen, bar);
            __builtin_amdgcn_fence(__ATOMIC_ACQUIRE, "agent");
            asm volatile("s_waitcnt vmcnt(0)" ::: "memory");
        }
    }
    __syncthreads();
}

__device__ __forceinline__ void p0_tile(const float* W, int srcN, int K, int k0, int n0, bf16_t* WT, int dstrow0, const float* g, const float* bvec, LAS float* scr, int lane, float (&s1)[4], float (&s2)[4], float f8scale = 0.f) {
#pragma unroll 8
    for (int i = 0; i < 32; ++i) { const int kk = 2 * i + (lane >> 5); scr[kk * 33 + (lane & 31)] = W[(size_t)(k0 + kk) * srcN + n0 + (lane & 31)]; }
    LDS_WAIT(); asm volatile("" ::: "memory");
    const int c = lane & 7;
    float gv[8], bv[8];
    if (g) { load8f(g + k0 + 8 * c, gv); load8f(bvec + k0 + 8 * c, bv); }
    else {
#pragma unroll
        for (int q = 0; q < 8; ++q) { gv[q] = 1.f; bv[q] = 0.f; } }
#pragma unroll
    for (int j = 0; j < 4; ++j) { const int n = (lane >> 3) + 8 * j; const LAS float* s = scr + (8 * c) * 33 + n;
        float v[8]; float t2 = 0.f;
#pragma unroll
        for (int q = 0; q < 8; ++q) { const float w = s[q * 33]; v[q] = w * gv[q]; t2 += w * bv[q]; }
        const u32x4 o = pack8(v);
        float r[8]; unpack8(o, r);
        s1[j] += ((r[0] + r[1]) + (r[2] + r[3])) + ((r[4] + r[5]) + (r[6] + r[7])); s2[j] += t2;
        if (f8scale != 0.f) { int w0 = 0, w1 = 0;
            w0 = __builtin_amdgcn_cvt_pk_fp8_f32(v[0] * f8scale, v[1] * f8scale, w0, false); w0 = __builtin_amdgcn_cvt_pk_fp8_f32(v[2] * f8scale, v[3] * f8scale, w0, true);
            w1 = __builtin_amdgcn_cvt_pk_fp8_f32(v[4] * f8scale, v[5] * f8scale, w1, false); w1 = __builtin_amdgcn_cvt_pk_fp8_f32(v[6] * f8scale, v[7] * f8scale, w1, true);
            u32x2 w; w.x = (unsigned)w0; w.y = (unsigned)w1; *(u32x2*)((unsigned char*)WT + (size_t)(dstrow0 + n) * K + k0 + 8 * c) = w; }
        else *(u32x4*)(WT + (size_t)(dstrow0 + n) * K + k0 + 8 * c) = o; }
    LDS_WAIT(); asm volatile("" ::: "memory");
}
__device__ __forceinline__ void p0_phase(const Params& p, LAS unsigned char* lds, int wave, int lane) {
    LAS float* scr = (LAS float*)(lds + wave * 16384);
    const int gw = blockIdx.x * NWAVES + wave, NGW = gridDim.x * NWAVES;
    unsigned char* ws = p.ws;
    constexpr int IA_IN = DIN / 32, IA_GU = NGU / 32, IA_L = IA_IN + IA_GU, IA = DEPTH * IA_L;
    LAS float* red = (LAS float*)(lds + PST_OFF);
    for (int it = blockIdx.x; it < IA; it += gridDim.x) {
        const int l = it / IA_L; int r = it % IA_L;
        const float* W; int srcN, n0, dstrow0; bf16_t* WT; const float* g; const float* bv; float* c1; float* c2;
        if (r < IA_IN) { W = p.in[6] + (size_t)l * D * DIN; srcN = DIN; n0 = 32 * r; dstrow0 = 32 * r; WT = (bf16_t*)(ws + WS_WIN + l * SZ_WIN);
            g = l ? p.in[15] : nullptr; bv = l ? p.in[16] : nullptr;
            c1 = (float*)(ws + WS_C1IN) + l * DIN; c2 = (float*)(ws + WS_C2IN) + l * DIN; }
        else { r -= IA_IN; dstrow0 = 32 * r; const int pn = dstrow0 >> 8, jj = dstrow0 & 255; W = (jj < 128 ? p.in[17] : p.in[18]) + (size_t)l * D * DFF; srcN = DFF; n0 = pn * 128 + (jj & 127);
            WT = (bf16_t*)(ws + WS_WGU + l * SZ_WGU); g = p.in[4] + l * D; bv = p.in[5] + l * D; c1 = (float*)(ws + WS_C1GU) + l * NGU; c2 = (float*)(ws + WS_C2GU) + l * NGU; }
        float s1[4] = {0.f, 0.f, 0.f, 0.f}, s2[4] = {0.f, 0.f, 0.f, 0.f};
        for (int kb = 2 * wave; kb < 2 * wave + 2; ++kb) p0_tile(W, srcN, D, 64 * kb, n0, WT, dstrow0, g, bv, scr, lane, s1, s2);
#pragma unroll
        for (int j = 0; j < 4; ++j) { float a = s1[j], b = s2[j]; a += __shfl_xor(a, 1); a += __shfl_xor(a, 2); a += __shfl_xor(a, 4); b += __shfl_xor(b, 1); b += __shfl_xor(b, 2); b += __shfl_xor(b, 4);
            if ((lane & 7) == 0) { const int n = (lane >> 3) + 8 * j; red[(wave * 32 + n) * 2] = a; red[(wave * 32 + n) * 2 + 1] = b; } }
        __syncthreads();
        if (wave == 0 && lane < 32) { float a = 0.f, b = 0.f;
#pragma unroll
            for (int w8 = 0; w8 < 8; ++w8) { a += red[(w8 * 32 + lane) * 2]; b += red[(w8 * 32 + lane) * 2 + 1]; }
            c1[dstrow0 + lane] = a; c2[dstrow0 + lane] = b; }
        __syncthreads();
    }
    constexpr int IB_O = (D / 64) * (D / 32), IB_D = (DFF / 64) * (D / 32), IB_L = IB_O + IB_D, IB = DEPTH * IB_L;
    for (int it = gw; it < IB; it += NGW) {
        const int l = it / IB_L; int r = it % IB_L; float d1[4] = {0.f, 0.f, 0.f, 0.f}, d2[4] = {0.f, 0.f, 0.f, 0.f};
        if (r < IB_O) { const int kb = r / (D / 32), nb = r % (D / 32); p0_tile(p.in[14] + (size_t)l * D * D, D, D, 64 * kb, 32 * nb, (bf16_t*)(ws + WS_WOUT + l * SZ_WOUT), 32 * nb, nullptr, nullptr, scr, lane, d1, d2); }
        else { r -= IB_O; const int kb = r / (D / 32), nb = r % (D / 32); p0_tile(p.in[19] + (size_t)l * DFF * D, D, DFF, 64 * kb, 32 * nb, (bf16_t*)(ws + WS_WD + l * SZ_WD), 32 * nb, nullptr, nullptr, scr, lane, d1, d2, (F8_LAST && (F8_ALL || l == DEPTH - 1)) ? WD8_SCALE : 0.f); }
    }
    const int gt = blockIdx.x * NTHR + wave * 64 + lane, GT = gridDim.x * NTHR;
    { bf16_t* wsb = (bf16_t*)(ws + WS_WSB); const float* src = p.in[9];
      for (int i = gt; i < DEPTH * 8 * 128 * 128 / 2; i += GT) { const int e = 2 * i, jj = e & 127, ii = (e >> 7) & 127; const bool keep = (jj >> 6) <= (ii >> 6);
          const float a = keep ? src[e] : 0.f, b = keep ? src[e + 1] : 0.f; ((unsigned*)wsb)[i] = cvt_pk_bf16(a, b); }
      bf16_t* wpt = (bf16_t*)(ws + WS_WPT); const float* wp = p.in[11];
      for (int i = gt; i < DEPTH * 4 * 64 * 64; i += GT) { const int c = i & 63, e = (i >> 6) & 63, lg = i >> 12; wpt[i] = (bf16_t)(cvt_pk_bf16(wp[((size_t)lg * 64 + c) * 64 + e], 0.f) & 0xffffu); } }
    { bf16_t* xb = (bf16_t*)(ws + WS_XB); constexpr int NCH = T * D / 8, PCH = TP * D / 8;
#pragma unroll 4
      for (int i = gt; i < NCH; i += GT) { const float* s = (i < PCH) ? p.in[0] + (size_t)i * 8 : p.in[1] + (size_t)(i - PCH) * 8; float f[8]; load8f(s, f); *(u32x4*)(xb + (size_t)i * 8) = pack8(f); } }
}

struct MixArgs {
    const bf16_t* proj; bf16_t* cat; const float* vg; const float* vb; const bf16_t* wsb; const float* bsp; const bf16_t* wpt; const float* pscale; const float* convw;
    const float* st_pool; const float* st_conv; float* o_pool_p; float* o_pool_s; float* o_conv_p; float* o_conv_s; float* o_v;
};
constexpr int VT_S = 136, XS = 264, VSTAT_OFF = 8 * 64 * VT_S * 2;
static_assert(VSTAT_OFF + 8192 <= MISC_OFF && 79 * XS * 2 <= 41984 && 41984 + 66 * 264 * 4 <= MISC_OFF, "MIX LDS map");
__device__ __forceinline__ void mix_chunk_unit(LAS unsigned char* lds, const MixArgs& A, int u, int tid_in, int wid_in, int lane_in) {
    int tid = tid_in; asm volatile("" : "+v"(tid)); const int lane = tid & 63, wid = __builtin_amdgcn_readfirstlane(tid >> 6); (void)wid_in; (void)lane_in;
    const int fr = lane & 15, fq = lane >> 4;
    const int r0 = u * 128; const bool prompt = u < 512;
    const bf16_t* proj = A.proj;
    typedef float f32x2v __attribute__((ext_vector_type(2)));
    LAS f32x2v* part = (LAS f32x2v*)(lds + VSTAT_OFF);
    const int h = wid; LAS bf16_t* vt = (LAS bf16_t*)lds + h * 64 * VT_S;
    const int j0 = 2 * lane;
    u32x4 ra[8], rb[8];
    {
      LAS unsigned char* stg = (LAS unsigned char*)vt;
      u32x4 t[16];
      const unsigned goff = ((unsigned)(r0 + (lane >> 3)) * DIN + 512u + (unsigned)(h * 64 + (lane & 7) * 8)) * 2u;
#pragma unroll
      for (int k = 0; k < 16; ++k) t[k] = *(const u32x4*)((const char*)proj + (size_t)(goff + (unsigned)(8 * k * DIN) * 2u));
#pragma unroll
      for (int k = 0; k < 16; ++k) { const int r = (lane >> 3) + 8 * k; *(LAS u32x4*)(stg + r * 128 + (((lane & 7) ^ ((r >> 1) & 7)) * 16)) = t[k]; }
      LDS_WAIT(); asm volatile("" ::: "memory");
#pragma unroll
      for (int dc = 0; dc < 8; ++dc) { ra[dc] = *(const LAS u32x4*)(stg + (2 * lane) * 128 + ((dc ^ (lane & 7)) * 16)); rb[dc] = *(const LAS u32x4*)(stg + (2 * lane + 1) * 128 + ((dc ^ (lane & 7)) * 16)); }
      LDS_WAIT(); asm volatile("" ::: "memory");
    }
    { float s0 = 0.f, q0 = 0.f, s1 = 0.f, q1 = 0.f;
#pragma unroll
      for (int dc = 0; dc < 8; ++dc) { float a[8], b[8]; unpack8(ra[dc], a); unpack8(rb[dc], b);
#pragma unroll
          for (int q = 0; q < 8; ++q) { s0 += a[q]; q0 += a[q] * a[q]; s1 += b[q]; q1 += b[q] * b[q]; } }
      part[h * 128 + j0] = (f32x2v){s0, q0}; part[h * 128 + j0 + 1] = (f32x2v){s1, q1}; }
    __syncthreads();
    float mu0, rs0, mu1, rs1;
    { float s0 = 0.f, q0 = 0.f, s1 = 0.f, q1 = 0.f;
#pragma unroll
      for (int hh = 0; hh < 8; ++hh) { const f32x2v a = part[hh * 128 + j0], b = part[hh * 128 + j0 + 1]; s0 += a[0]; q0 += a[1]; s1 += b[0]; q1 += b[1]; }
      mu0 = s0 * (1.f / 512.f); rs0 = rsqrtf(fmaxf(q0 * (1.f / 512.f) - mu0 * mu0, 0.f) + pg8::LN_EPS);
      mu1 = s1 * (1.f / 512.f); rs1 = rsqrtf(fmaxf(q1 * (1.f / 512.f) - mu1 * mu1, 0.f) + pg8::LN_EPS); }
#pragma unroll
    for (int dc = 0; dc < 8; ++dc) { float a[8], b[8], gv[8], bv[8]; unpack8(ra[dc], a); unpack8(rb[dc], b);
        load8f(A.vg + h * 64 + dc * 8, gv); load8f(A.vb + h * 64 + dc * 8, bv);
#pragma unroll
        for (int q = 0; q < 8; ++q) { a[q] = (a[q] - mu0) * rs0 * gv[q] + bv[q]; b[q] = (b[q] - mu1) * rs1 * gv[q] + bv[q]; }
        if (!prompt) { float* o = A.o_v + (size_t)(r0 - TP + j0) * 512 + h * 64 + dc * 8;
            *(f32x4*)o = (f32x4){a[0], a[1], a[2], a[3]}; *(f32x4*)(o + 4) = (f32x4){a[4], a[5], a[6], a[7]}; *(f32x4*)(o + 512) = (f32x4){b[0], b[1], b[2], b[3]}; *(f32x4*)(o + 516) = (f32x4){b[4], b[5], b[6], b[7]}; }
#pragma unroll
        for (int q = 0; q < 8; ++q) *(LAS unsigned*)(vt + (dc * 8 + q) * VT_S + j0) = cvt_pk_bf16(a[q], b[q]); }
    LDS_WAIT(); asm volatile("" ::: "memory");
#pragma unroll 1
    for (int ob = 0; ob < 2; ++ob) {
        const int wsr0 = prompt ? ob * 64 : 0, vr0 = prompt ? 0 : ob * 64, nk = (prompt && ob) ? 4 : 2;
        u32x2 uw[4][4];
#pragma unroll
        for (int it = 0; it < 4; ++it)
#pragma unroll
            for (int dt = 0; dt < 4; ++dt) uw[it][dt] = *(const u32x2*)(proj + ((size_t)r0 + ob * 64 + it * 16 + fr) * DIN + h * 64 + dt * 16 + fq * 4);
#pragma unroll
        for (int it = 0; it < 4; ++it) {
            const int wrow = wsr0 + it * 16 + fr; const size_t row = (size_t)r0 + ob * 64 + it * 16 + fr;
            const float bs = A.bsp[h * 128 + wrow];
            bf16x8 wf[4];
#pragma unroll
            for (int ks = 0; ks < 4; ++ks) if (ks < nk) wf[ks] = *(const bf16x8*)(A.wsb + ((size_t)h * 128 + wrow) * 128 + ks * 32 + fq * 8);
            f32x4 acc[4];
#pragma unroll
            for (int b = 0; b < 4; ++b) acc[b] = (f32x4){0.f, 0.f, 0.f, 0.f};
#pragma unroll
            for (int ks = 0; ks < 4; ++ks) if (ks < nk) { bf16x8 vf[4];
#pragma unroll
                for (int dt = 0; dt < 4; ++dt) vf[dt] = *(const LAS bf16x8*)(vt + (dt * 16 + fr) * VT_S + vr0 + ks * 32 + fq * 8);
#pragma unroll
                for (int dt = 0; dt < 4; ++dt) acc[dt] = __builtin_amdgcn_mfma_f32_16x16x32_bf16(vf[dt], wf[ks], acc[dt], 0, 0, 0); }
#pragma unroll
            for (int dt = 0; dt < 4; ++dt) { const int d = h * 64 + dt * 16 + fq * 4; float uu[4]; unpack4(uw[it][dt], uu);
                u32x2 o; o.x = cvt_pk_bf16(uu[0] * (acc[dt][0] + bs), uu[1] * (acc[dt][1] + bs)); o.y = cvt_pk_bf16(uu[2] * (acc[dt][2] + bs), uu[3] * (acc[dt][3] + bs));
                *(u32x2*)(A.cat + row * D + d) = o; }
        }
    }
    __syncthreads();
}
__device__ __forceinline__ void mix_pool_conv_block(LAS unsigned char* lds, const MixArgs& A, int blk, int tid_in, int wid_in, int lane_in) {
    int tid = tid_in; asm volatile("" : "+v"(tid)); const int lane = tid & 63, wid = __builtin_amdgcn_readfirstlane(tid >> 6); (void)wid_in; (void)lane_in;
    const int fr = lane & 15, fq = lane >> 4;
    const int r0 = blk * 64; const bool prompt = blk < 1024; const int bi = blk & 127, sb = blk - 1024;
    const int t0 = prompt ? bi * 64 : 0;
    const bf16_t* proj = A.proj;
    LAS bf16_t* xt = (LAS bf16_t*)lds;
    const int g = wid >> 1, half = wid & 1, w = 2 << g;
    bf16x8 wf[2][4];
#pragma unroll
    for (int ks = 0; ks < 2; ++ks)
#pragma unroll
        for (int et = 0; et < 4; ++et) wf[ks][et] = *(const bf16x8*)(A.wpt + ((size_t)g * 64 + et * 16 + fr) * 64 + ks * 32 + fq * 8);
    u32x4 tw[5];
#pragma unroll
    for (int i = 0; i < 5; ++i) { const int idx = tid + i * NTHR, tr = idx >> 5, cc = idx & 31; u32x4 wv = (u32x4){0u, 0u, 0u, 0u};
        if (idx < 79 * 32) {
            if (tr >= 15 || (prompt && bi != 0)) wv = *(const u32x4*)(proj + (size_t)(r0 - 15 + tr) * DIN + 1024 + cc * 8);
            else if (!prompt) { float f[8]; load8f(A.st_pool + ((size_t)sb * 15 + tr) * 256 + cc * 8, f); wv = pack8(f); } }
        tw[i] = wv; }
    const int cj = tid >> 5, cc8 = (tid & 31) * 8;
    constexpr int ZS = 264, ZT_OFF = 41984;
    LAS float* zt = (LAS float*)(lds + ZT_OFF);
    u32x4 cgb[4], cgc[4], chh[4];
#pragma unroll
    for (int it = 0; it < 4; ++it) { const bf16_t* pr = proj + ((size_t)r0 + cj + 16 * it) * DIN; cgb[it] = *(const u32x4*)(pr + 1280 + cc8); cgc[it] = *(const u32x4*)(pr + 1536 + cc8); chh[it] = *(const u32x4*)(pr + 1792 + cc8); }
    float zh[8];
#pragma unroll
    for (int q = 0; q < 8; ++q) zh[q] = 0.f;
    if (tid < 64) {
        if (prompt && bi != 0) { float a[8], b[8]; unpack8(*(const u32x4*)(proj + ((size_t)r0 - 2 + cj) * DIN + 1536 + cc8), a); unpack8(*(const u32x4*)(proj + ((size_t)r0 - 2 + cj) * DIN + 1792 + cc8), b);
#pragma unroll
            for (int q = 0; q < 8; ++q) zh[q] = a[q] * b[q]; }
        else if (!prompt) load8f(A.st_conv + ((size_t)sb * 2 + cj) * 256 + cc8, zh);
    }
    float z0[4][8];
#pragma unroll
    for (int it = 0; it < 4; ++it) { float gc[8], hh[8]; unpack8(cgc[it], gc); unpack8(chh[it], hh);
#pragma unroll
        for (int q = 0; q < 8; ++q) z0[it][q] = gc[q] * hh[q];
        LAS float* d = zt + (2 + cj + 16 * it) * ZS + cc8; *(LAS f32x4*)d = (f32x4){z0[it][0], z0[it][1], z0[it][2], z0[it][3]}; *(LAS f32x4*)(d + 4) = (f32x4){z0[it][4], z0[it][5], z0[it][6], z0[it][7]}; }
    if (tid < 64) { LAS float* d = zt + cj * ZS + cc8; *(LAS f32x4*)d = (f32x4){zh[0], zh[1], zh[2], zh[3]}; *(LAS f32x4*)(d + 4) = (f32x4){zh[4], zh[5], zh[6], zh[7]}; }
#pragma unroll
    for (int i = 0; i < 5; ++i) { const int idx = tid + i * NTHR, tr = idx >> 5, cc = idx & 31; if (idx < 79 * 32) *(LAS u32x4*)(xt + tr * XS + cc * 8) = tw[i]; }
    __syncthreads();
    { float w0[8], w1[8], w2[8]; load8f(A.convw + cc8, w0); load8f(A.convw + 256 + cc8, w1); load8f(A.convw + 512 + cc8, w2);
#pragma unroll
      for (int it = 0; it < 4; ++it) { const int j = cj + 16 * it, t = t0 + j; const size_t row = (size_t)r0 + j;
          const LAS float* p1 = zt + (1 + j) * ZS + cc8; const LAS float* p2 = zt + j * ZS + cc8;
          const f32x4 a1 = *(const LAS f32x4*)p1, b1 = *(const LAS f32x4*)(p1 + 4), a2 = *(const LAS f32x4*)p2, b2 = *(const LAS f32x4*)(p2 + 4);
          const float z1[8] = {a1[0], a1[1], a1[2], a1[3], b1[0], b1[1], b1[2], b1[3]}, z2[8] = {a2[0], a2[1], a2[2], a2[3], b2[0], b2[1], b2[2], b2[3]};
          float gb[8], o[8]; unpack8(cgb[it], gb);
#pragma unroll
          for (int q = 0; q < 8; ++q) o[q] = gb[q] * (w0[q] * z2[q] + w1[q] * z1[q] + w2[q] * z0[it][q]);
          *(u32x4*)(A.cat + row * D + 768 + cc8) = pack8(o);
          const int tl = prompt ? 8190 : 62;
          if (t >= tl) { float* o2 = (prompt ? A.o_conv_p + ((size_t)(blk >> 7) * 2 + (t - tl)) * 256 : A.o_conv_s + ((size_t)sb * 2 + (t - tl)) * 256) + cc8;
              *(f32x4*)o2 = (f32x4){z0[it][0], z0[it][1], z0[it][2], z0[it][3]}; *(f32x4*)(o2 + 4) = (f32x4){z0[it][4], z0[it][5], z0[it][6], z0[it][7]}; } } }
#pragma unroll 1
    for (int tt = 0; tt < 2; ++tt) {
        f32x4 acc[4];
#pragma unroll
        for (int b = 0; b < 4; ++b) acc[b] = (f32x4){0.f, 0.f, 0.f, 0.f};
        const int j = half * 32 + tt * 16 + fr, ti = 15 + j;
        const int pos = t0 + j; const float cnt = prompt ? (float)min(pos + 1, w) : (float)w; const float inv = 1.f / cnt;
#pragma unroll
        for (int ks = 0; ks < 2; ++ks) { const int c = g * 64 + ks * 32 + fq * 8;
            float sum[8] = {0.f, 0.f, 0.f, 0.f, 0.f, 0.f, 0.f, 0.f}, x0[8];
#pragma unroll 2
            for (int k = 0; k < w; ++k) { float x[8]; unpack8(*(const LAS u32x4*)(xt + (ti - k) * XS + c), x);
#pragma unroll
                for (int q = 0; q < 8; ++q) sum[q] += x[q]; }
            unpack8(*(const LAS u32x4*)(xt + ti * XS + c), x0);
            float df[8];
#pragma unroll
            for (int q = 0; q < 8; ++q) df[q] = sum[q] * inv - x0[q];
            const u32x4 dw = pack8(df); bf16x8 dfr; __builtin_memcpy(&dfr, &dw, 16);
#pragma unroll
            for (int et = 0; et < 4; ++et) acc[et] = __builtin_amdgcn_mfma_f32_16x16x32_bf16(wf[ks][et], dfr, acc[et], 0, 0, 0); }
        const size_t row = (size_t)r0 + j;
#pragma unroll
        for (int et = 0; et < 4; ++et) { const int e = g * 64 + et * 16 + fq * 4; const f32x4 sc = *(const f32x4*)(A.pscale + e);
            u32x2 o; o.x = cvt_pk_bf16(acc[et][0] * sc[0], acc[et][1] * sc[1]); o.y = cvt_pk_bf16(acc[et][2] * sc[2], acc[et][3] * sc[3]);
            *(u32x2*)(A.cat + row * D + 512 + e) = o; } }
    if (!prompt || bi == 127) { float* dst = prompt ? A.o_pool_p + (size_t)(blk >> 7) * 15 * 256 : A.o_pool_s + (size_t)sb * 15 * 256;
        for (int idx = tid; idx < 15 * 256; idx += NTHR) { const int i = idx >> 8, c = idx & 255; dst[i * 256 + c] = bf2f(xt[(15 + 49 + i) * XS + c]); } }
    __syncthreads();
}
__device__ __forceinline__ void mix_phase(LAS unsigned char* lds, const MixArgs& A, int tid, int wid, int lane) {
    const int c = blockIdx.x, G = gridDim.x;
    constexpr int NA = T / 128, NB = T / 64;
    const int nA = (NA + G - 1) / G, nB = (NB + G - 1) / G;
#pragma unroll 1
    for (int i = 0; i < nA + nB; ++i) {
        int type = -1, idx = 0;
        if (G == 256) {
            if (i < 2) { type = 0; idx = c + 256 * i; }
            else if (c < 16) { if (i == 2) { type = 0; idx = 512 + c; } else if (i < 5) { type = 1; idx = 2 * c + (i - 3); } }
            else { const int j = c - 16; if (i < 6) { type = 1; idx = 32 + j + 240 * (i - 2); } else if (i == 6 && j < 64) { type = 1; idx = 992 + j; } }
        } else {
            if (i < nA) { idx = c + G * i; type = idx < NA ? 0 : -1; } else { idx = c + G * (i - nA); type = idx < NB ? 1 : -1; }
        }
        type = __builtin_amdgcn_readfirstlane(type); idx = __builtin_amdgcn_readfirstlane(idx);
#ifndef REP_MIXA
#define REP_MIXA 1
#endif
#ifndef REP_MIXB
#define REP_MIXB 1
#endif
        if (type == 0) { for (int r = 0; r < REP_MIXA; ++r) mix_chunk_unit(lds, A, idx, tid, wid, lane); }
        else if (type == 1) { for (int r = 0; r < REP_MIXB; ++r) mix_pool_conv_block(lds, A, idx, tid, wid, lane); }
    }
}

__device__ __forceinline__ void finalize_stats(const float* part, float* fin, int nrows) {
    typedef float f32x2v __attribute__((ext_vector_type(2)));
    for (int row = blockIdx.x * NTHR + threadIdx.x; row < nrows; row += gridDim.x * NTHR) {
        const f32x4 a = *(const f32x4*)(part + (size_t)row * 8), b = *(const f32x4*)(part + (size_t)row * 8 + 4);
        const float S = (a[0] + a[2]) + (b[0] + b[2]), Q = (a[1] + a[3]) + (b[1] + b[3]);
        const float mu = S * (1.f / 1024.f), var = fmaxf(Q * (1.f / 1024.f) - mu * mu, 0.f);
        *(f32x2v*)(fin + (size_t)row * 2) = (f32x2v){mu, rsqrtf(var + pg8::LN_EPS)};
    }
}
__device__ __forceinline__ bool split_on(int G) { return pg8::split_ok(T, TP, D, G); }
__device__ __forceinline__ void finalize_sample(const float* part, const bf16_t* R, const float* stats_in, const float* g, const float* b, bf16_t* O, float* fin) {
    typedef float f32x2v __attribute__((ext_vector_type(2)));
    int tid_ = threadIdx.x; asm volatile("" : "+v"(tid_)); const int lane = tid_ & 63, wave = __builtin_amdgcn_readfirstlane(tid_ >> 6);
    for (int lr = blockIdx.x * NWAVES + wave; lr < TS; lr += gridDim.x * NWAVES) {
        const size_t row = (size_t)TP + lr; float mu = 0.f, rs = 1.f; if (stats_in) pg8::row_stats(stats_in, (int)row, mu, rs);
        float v[2][8], s = 0.f, q = 0.f;
#pragma unroll
        for (int hh = 0; hh < 2; ++hh) { const int c = hh * 512 + lane * 8; float r[8], gg[8], bb[8]; unpack8(*(const u32x4*)(R + row * D + c), r);
            if (stats_in) { load8f(g + c, gg); load8f(b + c, bb); }
#pragma unroll
            for (int k = 0; k < 8; ++k) v[hh][k] = pg8::ALPHA * (stats_in ? (r[k] - mu) * rs * gg[k] + bb[k] : r[k]);
#pragma unroll
            for (int sp = 0; sp < pg8::NSPLIT; ++sp) { float p8[8]; load8f(part + ((size_t)sp * TS + lr) * D + c, p8);
#pragma unroll
                for (int k = 0; k < 8; ++k) v[hh][k] += p8[k]; }
#pragma unroll
            for (int k = 0; k < 8; ++k) { s += v[hh][k]; q += v[hh][k] * v[hh][k]; }
            *(u32x4*)(O + row * D + c) = pack8(v[hh]); }
        s = wave_sum(s); q = wave_sum(q);
        const float m2 = s * (1.f / 1024.f), var = fmaxf(q * (1.f / 1024.f) - m2 * m2, 0.f);
        if (lane == 0) *(f32x2v*)(fin + row * 2) = (f32x2v){m2, rsqrtf(var + pg8::LN_EPS)};
    }
}
typedef const __attribute__((address_space(4))) Params* ParamsPtr;
#define GETP() ParamsPtr pp; { auto kp_ = __builtin_amdgcn_kernarg_segment_ptr(); asm volatile("" : "+s"(kp_)); pp = (ParamsPtr)kp_; } unsigned char* ws = pp->ws; int l = lc; asm volatile("" : "+s"(l));
__global__ void __launch_bounds__(NTHR, 2) fwd_megakernel(Params p_unused) {
    extern __shared__ __attribute__((aligned(16))) unsigned char lds_raw[];
    LAS unsigned char* lds = (LAS unsigned char*)lds_raw;
    cg::grid_group grid = cg::this_grid();
    const int tid = threadIdx.x;
    if (gridDim.x == 0x7fffffffu) grid.sync();
    volatile LAS unsigned* MISC = (volatile LAS unsigned*)(lds + MISC_OFF);
    if (tid < 16) MISC[tid] = 0u;
    __syncthreads();
    { auto kp0 = __builtin_amdgcn_kernarg_segment_ptr(); (void)xcd_barrier_post((unsigned*)(((ParamsPtr)kp0)->ws + WS_BAR), MISC); }
#define GRIDBAR() do { auto kpb_ = __builtin_amdgcn_kernarg_segment_ptr(); asm volatile("" : "+s"(kpb_)); XcdBarrier xb_; xb_.bar = (unsigned*)(((ParamsPtr)kpb_)->ws + WS_BAR); xb_.x = xb_xcc_id(); \
        xb_.st = (volatile LAS unsigned*)((LAS unsigned char*)lds_raw + MISC_OFF); xcd_barrier(xb_); } while (0)
#ifndef NO_P0
    for (int rep = 0; rep < REP_P0; ++rep) { const int lc = 0; GETP(); (void)l; (void)ws; Params p; for (int i = 0; i < 20; ++i) p.in[i] = pp->in[i]; p.out = pp->out; p.ws = pp->ws;
      int tid0 = threadIdx.x; asm volatile("" : "+v"(tid0)); p0_phase(p, lds, __builtin_amdgcn_readfirstlane(tid0 >> 6), tid0 & 63); }
#endif
    GRIDBAR();

    for (int lc = 0; lc < DEPTH; ++lc) {
#ifndef NO_G1
        for (int rep = 0; rep < REP_G1; ++rep) { GETP(); const int G = gridDim.x;
          pg8::Gemm g{(const bf16_t*)(ws + (l ? WS_P2 : WS_XB)), (const bf16_t*)(ws + WS_WIN + l * SZ_WIN), T, DIN, D}; pg8::StaticOrder S; S.init(T, DIN, D, G, (int)blockIdx.x);
          pg8::EpiProj E{(bf16_t*)(ws + WS_PROJ), DIN, l ? (const float*)(ws + WS_ST2) : nullptr, (const float*)(ws + WS_C1IN) + l * DIN, (const float*)(ws + WS_C2IN) + l * DIN};
          pg8::gemm_phase<pg8::EpiProj, pg8::StaticOrder, true, true>(lds, g, S, E); }
#endif
        GRIDBAR();
#ifndef NO_MIX
        for (int rep = 0; rep < REP_MIX; ++rep) { GETP(); const int G = gridDim.x; float* out = pp->out;
          MixArgs A; A.proj = (const bf16_t*)(ws + WS_PROJ); A.cat = (bf16_t*)(ws + WS_CAT); A.vg = pp->in[7] + l * 512; A.vb = pp->in[8] + l * 512; A.wsb = (const bf16_t*)(ws + WS_WSB + l * SZ_WSB); A.bsp = pp->in[10] + l * 8 * 128;
          A.wpt = (const bf16_t*)(ws + WS_WPT + l * SZ_WPT); A.pscale = pp->in[12] + l * 256; A.convw = pp->in[13] + l * 3 * 256; A.st_pool = pp->in[2] + (size_t)l * 32 * 15 * 256; A.st_conv = pp->in[3] + (size_t)l * 32 * 2 * 256;
          A.o_pool_p = out + O_POOLP + (size_t)l * 8 * 15 * 256; A.o_pool_s = out + O_POOLS + (size_t)l * 32 * 15 * 256; A.o_conv_p = out + O_CONVP + (size_t)l * 8 * 2 * 256; A.o_conv_s = out + O_CONVS + (size_t)l * 32 * 2 * 256;
          A.o_v = out + O_V + (size_t)l * 32 * 64 * 512;
          int tid2 = threadIdx.x; asm volatile("" : "+v"(tid2)); const int lane2 = tid2 & 63, wid2 = __builtin_amdgcn_readfirstlane(tid2 >> 6);
          (void)G; mix_phase(lds, A, tid2, wid2, lane2); }
#endif
        GRIDBAR();
#ifndef NO_G2
        for (int rep = 0; rep < REP_G2; ++rep) { GETP(); const int G = gridDim.x;
          pg8::Gemm g{(const bf16_t*)(ws + WS_CAT), (const bf16_t*)(ws + WS_WOUT + l * SZ_WOUT), T, D, D}; const bool sp = split_on(G); pg8::StaticOrder S; S.init(sp ? TP : T, D, D, G, (int)blockIdx.x, WGM_G2);
          pg8::EpiRes<4> E{(bf16_t*)(ws + WS_P1), (const bf16_t*)(ws + (l ? WS_P2 : WS_XB)), l ? (const float*)(ws + WS_ST2) : nullptr, pp->in[15] + (l - 1) * D, pp->in[16] + (l - 1) * D, (float*)(ws + WS_ST1P), (LAS float*)(lds + PST_OFF), 1.f};
          pg8::gemm_phase<pg8::EpiRes<4>, pg8::StaticOrder, true, true>(lds, g, S, E);
          if (sp) { pg8::TailSplitOrder S2; S2.init(TP, D, D, (int)blockIdx.x); pg8::EpiPart E2{(float*)(ws + WS_PART), TP, TS, 1.f}; pg8::gemm_phase<pg8::EpiPart, pg8::TailSplitOrder, true, true>(lds, g, S2, E2); } }
#endif
        GRIDBAR();
        { GETP(); const bool sp = split_on((int)gridDim.x); finalize_stats((const float*)(ws + WS_ST1P), (float*)(ws + WS_ST1), sp ? TP : T);
          if (sp) finalize_sample((const float*)(ws + WS_PART), (const bf16_t*)(ws + (l ? WS_P2 : WS_XB)), l ? (const float*)(ws + WS_ST2) : nullptr, pp->in[15] + (l - 1) * D, pp->in[16] + (l - 1) * D, (bf16_t*)(ws + WS_P1), (float*)(ws + WS_ST1)); }
        GRIDBAR();
#ifndef NO_G3
        for (int rep = 0; rep < REP_G3; ++rep) { GETP(); const int G = gridDim.x;
          pg8::Gemm g{(const bf16_t*)(ws + WS_P1), (const bf16_t*)(ws + WS_WGU + l * SZ_WGU), T, NGU, D}; pg8::StaticOrder S; S.init(T, NGU, D, G, (int)blockIdx.x);
          if (F8_LAST && (F8_ALL || l == DEPTH - 1)) { pg8::EpiSwiGLU<true> E{(bf16_t*)(ws + WS_HID), DFF, (const float*)(ws + WS_ST1), (const float*)(ws + WS_C1GU) + l * NGU, (const float*)(ws + WS_C2GU) + l * NGU};
              pg8::gemm_phase<pg8::EpiSwiGLU<true>, pg8::StaticOrder, true, true>(lds, g, S, E); }
          else { pg8::EpiSwiGLU<false> E{(bf16_t*)(ws + WS_HID), DFF, (const float*)(ws + WS_ST1), (const float*)(ws + WS_C1GU) + l * NGU, (const float*)(ws + WS_C2GU) + l * NGU};
              pg8::gemm_phase<pg8::EpiSwiGLU<false>, pg8::StaticOrder, true, true>(lds, g, S, E); } }
#endif
        GRIDBAR();
#ifndef NO_G4
        for (int rep = 0; rep < REP_G4; ++rep) { GETP(); const int G = gridDim.x;
          const bool sp = split_on(G);
          if (F8_LAST && l == DEPTH - 1) {
              pg8::Gemm g{(const bf16_t*)(ws + WS_HID), (const bf16_t*)(ws + WS_WD + l * SZ_WD), T, D, DFF / 2}; pg8::StaticOrder S; S.init(T, D, DFF / 2, G, (int)blockIdx.x, WGM_G4);
              pg8::EpiRaw E{(bf16_t*)(ws + WS_P2), D, 1.f / WD8_SCALE};
              pg8::gemm_phase<pg8::EpiRaw, pg8::StaticOrder, true, true, true>(lds, g, S, E);
          } else if (F8_LAST && F8_ALL) {
              pg8::Gemm g{(const bf16_t*)(ws + WS_HID), (const bf16_t*)(ws + WS_WD + l * SZ_WD), T, D, DFF / 2}; pg8::StaticOrder S; S.init(sp ? TP : T, D, DFF / 2, G, (int)blockIdx.x, WGM_G4);
              pg8::EpiRes<4> E{(bf16_t*)(ws + WS_P2), (const bf16_t*)(ws + WS_P1), (const float*)(ws + WS_ST1), pp->in[4] + l * D, pp->in[5] + l * D, (float*)(ws + WS_ST2P), (LAS float*)(lds + PST_OFF), 1.f / WD8_SCALE};
              pg8::gemm_phase<pg8::EpiRes<4>, pg8::StaticOrder, true, true, true>(lds, g, S, E);
              if (sp) { pg8::TailSplitOrder S2; S2.init(TP, D, DFF / 2, (int)blockIdx.x); pg8::EpiPart E2{(float*)(ws + WS_PART), TP, TS, 1.f / WD8_SCALE}; pg8::gemm_phase<pg8::EpiPart, pg8::TailSplitOrder, true, true, true>(lds, g, S2, E2); }
          } else {
              pg8::Gemm g{(const bf16_t*)(ws + WS_HID), (const bf16_t*)(ws + WS_WD + l * SZ_WD), T, D, DFF}; pg8::StaticOrder S; S.init(sp ? TP : T, D, DFF, G, (int)blockIdx.x, WGM_G4);
              pg8::EpiRes<4> E{(bf16_t*)(ws + WS_P2), (const bf16_t*)(ws + WS_P1), (const float*)(ws + WS_ST1), pp->in[4] + l * D, pp->in[5] + l * D, (float*)(ws + WS_ST2P), (LAS float*)(lds + PST_OFF), 1.f};
              pg8::gemm_phase<pg8::EpiRes<4>, pg8::StaticOrder, true, true>(lds, g, S, E);
              if (sp) { pg8::TailSplitOrder S2; S2.init(TP, D, DFF, (int)blockIdx.x); pg8::EpiPart E2{(float*)(ws + WS_PART), TP, TS, 1.f}; pg8::gemm_phase<pg8::EpiPart, pg8::TailSplitOrder, true, true>(lds, g, S2, E2); } } }
#endif
        GRIDBAR();
        if (!(F8_LAST && lc == DEPTH - 1)) {
        { GETP(); const bool sp = split_on((int)gridDim.x); finalize_stats((const float*)(ws + WS_ST2P), (float*)(ws + WS_ST2), sp ? TP : T);
          if (sp) finalize_sample((const float*)(ws + WS_PART), (const bf16_t*)(ws + WS_P1), (const float*)(ws + WS_ST1), pp->in[4] + l * D, pp->in[5] + l * D, (bf16_t*)(ws + WS_P2), (float*)(ws + WS_ST2)); }
        GRIDBAR();
        }
        for (int rep = 1; rep < REP_SYNC; ++rep) GRIDBAR();
    }
    for (int rep = 0; rep < REP_FIN; ++rep) { const int lc = DEPTH - 1; GETP(); const int G = gridDim.x; float* out = pp->out;
      const float* gF = pp->in[15] + l * D; const float* bF = pp->in[16] + l * D; const bf16_t* P2 = (const bf16_t*)(ws + WS_P2); const float* ST2 = (const float*)(ws + WS_ST2);
      int tidf = threadIdx.x; asm volatile("" : "+v"(tidf)); const int lane = tidf & 63, wid = __builtin_amdgcn_readfirstlane(tidf >> 6);
      const int gw = blockIdx.x * NWAVES + wid, NGW = G * NWAVES;
      float gv[2][8], bv[2][8]; load8f(gF + lane * 8, gv[0]); load8f(gF + 512 + lane * 8, gv[1]); load8f(bF + lane * 8, bv[0]); load8f(bF + 512 + lane * 8, bv[1]);
#if F8_LAST
      const float* gM = pp->in[4] + l * D; const float* bM = pp->in[5] + l * D; const bf16_t* P1 = (const bf16_t*)(ws + WS_P1); const float* ST1 = (const float*)(ws + WS_ST1);
      float g1[2][8], b1[2][8]; load8f(gM + lane * 8, g1[0]); load8f(gM + 512 + lane * 8, g1[1]); load8f(bM + lane * 8, b1[0]); load8f(bM + 512 + lane * 8, b1[1]);
#pragma unroll 2
      for (int row = gw; row < T; row += NGW) { float mu1, rs1; pg8::row_stats(ST1, row, mu1, rs1);
          float v[2][8], s = 0.f, q2 = 0.f;
#pragma unroll
          for (int hh = 0; hh < 2; ++hh) { float p[8], f[8]; unpack8(*(const u32x4*)(P1 + (size_t)row * D + hh * 512 + lane * 8), p); unpack8(*(const u32x4*)(P2 + (size_t)row * D + hh * 512 + lane * 8), f);
#pragma unroll
              for (int q = 0; q < 8; ++q) { const float x = pg8::ALPHA * ((p[q] - mu1) * rs1 * g1[hh][q] + b1[hh][q]) + f[q]; v[hh][q] = x; s += x; q2 += x * x; } }
          s = wave_sum(s); q2 = wave_sum(q2);
          const float mu = s * (1.f / 1024.f), rs = rsqrtf(fmaxf(q2 * (1.f / 1024.f) - mu * mu, 0.f) + pg8::LN_EPS);
#pragma unroll
          for (int hh = 0; hh < 2; ++hh) { float* o = out + (size_t)row * D + hh * 512 + lane * 8; float f[8];
#pragma unroll
              for (int q = 0; q < 8; ++q) f[q] = (v[hh][q] - mu) * rs * gv[hh][q] + bv[hh][q];
              *(f32x4*)o = (f32x4){f[0], f[1], f[2], f[3]}; *(f32x4*)(o + 4) = (f32x4){f[4], f[5], f[6], f[7]}; } }
      (void)ST2;
#else
#pragma unroll 2
      for (int row = gw; row < T; row += NGW) { float mu, rs; pg8::row_stats(ST2, row, mu, rs);
#pragma unroll
          for (int hh = 0; hh < 2; ++hh) { float f[8]; unpack8(*(const u32x4*)(P2 + (size_t)row * D + hh * 512 + lane * 8), f); float* o = out + (size_t)row * D + hh * 512 + lane * 8;
#pragma unroll
              for (int q = 0; q < 8; ++q) f[q] = (f[q] - mu) * rs * gv[hh][q] + bv[hh][q];
              *(f32x4*)o = (f32x4){f[0], f[1], f[2], f[3]}; *(f32x4*)(o + 4) = (f32x4){f[4], f[5], f[6], f[7]}; } }
#endif
    }
}

extern "C" void kernel_launch(void* const* d_in, const int* in_sizes, int n_in, void* d_out, int out_size, void* d_ws, size_t ws_size, hipStream_t stream) {
    static int grid = 0;
    if (grid == 0) {
        if (n_in != 20 || (size_t)out_size != O_END || ws_size < WS_END) { fprintf(stderr, "kernel_launch: unexpected sizes n_in %d out %d (want %zu) ws %zu (want %zu)\n", n_in, out_size, (size_t)O_END, ws_size, (size_t)WS_END); grid = -1; return; }
        int dev = 0, cus = 0, per_cu = 0;
        if (hipGetDevice(&dev) != hipSuccess || hipDeviceGetAttribute(&cus, hipDeviceAttributeMultiprocessorCount, dev) != hipSuccess) { grid = -1; return; }
        if (hipFuncSetAttribute((const void*)fwd_megakernel, hipFuncAttributeMaxDynamicSharedMemorySize, LDS_BYTES) != hipSuccess) { fprintf(stderr, "kernel_launch: hipFuncSetAttribute failed\n"); grid = -1; return; }
        if (hipOccupancyMaxActiveBlocksPerMultiprocessor(&per_cu, (const void*)fwd_megakernel, NTHR, LDS_BYTES) != hipSuccess || per_cu < 1) { fprintf(stderr, "kernel_launch: occupancy query reports %d\n", per_cu); (void)hipGetLastError(); per_cu = 1; }
        grid = cus;
    }
    if (grid < 0) return;
    if (hipMemsetAsync((char*)d_ws + WS_BAR, 0, BAR_BYTES, stream) != hipSuccess) { fprintf(stderr, "kernel_launch: memset of the barrier words failed\n"); return; }
    Params p{};
    for (int i = 0; i < 20; ++i) p.in[i] = (const float*)d_in[i];
    p.out = (float*)d_out; p.ws = (unsigned char*)d_ws;
    void* args[] = {&p};
    const hipError_t e = hipLaunchCooperativeKernel((const void*)fwd_megakernel, dim3(grid), dim3(NTHR), args, LDS_BYTES, stream);
    if (e != hipSuccess) fprintf(stderr, "kernel_launch: cooperative launch failed: %s (grid %d)\n", hipGetErrorString(e), grid);
}
```

```cpp
#include <hip/hip_runtime.h>
#include <hip/hip_cooperative_groups.h>
#include <cstdio>
#include <cstdint>
namespace cg = cooperative_groups;
#define WGM_G2 8
#define WGM_G4 8
namespace pg8 {
#define PG8_LAS __attribute__((address_space(3)))
typedef unsigned short bf16_t;
typedef short bf16x8 __attribute__((ext_vector_type(8)));
typedef float f32x4 __attribute__((ext_vector_type(4)));
typedef unsigned u32x4 __attribute__((ext_vector_type(4)));
typedef int i32x4 __attribute__((ext_vector_type(4)));
typedef int i32x8 __attribute__((ext_vector_type(8)));
constexpr int BM = 256, BK = 64, HALF = 128, HTB = HALF * BK * 2  , STAGE_BYTES = 8 * HTB, NXCD = 8, WGM = 6;

__host__ __device__ __forceinline__ int lds_byte(int r, int c) { const int st = (r >> 4) * 2 + (c >> 5), rr = r & 15, cc = c & 31, ob = rr * 64 + cc * 2; return st * 1024 + (ob ^ (((ob >> 9) & 1) << 5)); }
__host__ __device__ __forceinline__ void stage_rc(int b, int& R, int& C) { const int st = b / 1024, sb = b % 1024, swz = sb ^ (((sb >> 9) & 1) << 5); R = (st >> 1) * 16 + swz / 64; C = (st & 1) * 32 + (swz % 64) / 2; }
__host__ __device__ __forceinline__ int perm32(int rho) { const int n = rho >> 4, i = rho & 15; return 8 * (i >> 2) + 4 * n + (i & 3); }

struct Unit { int pm, pn, k0, nt, split; };
struct Gemm { const bf16_t* A; const bf16_t* Bt; int M, N, K; };

struct StaticOrder {
    int nM, nN, nwg, G, c, ntf, wgm;
    __host__ __device__ void init(int M, int N, int K, int G_, int c_, int wgm_ = WGM) { nM = M / BM; nN = N / BM; nwg = nM * nN; G = G_; c = c_; ntf = K / BK; wgm = wgm_; }
    __host__ __device__ bool next(int i, Unit& u) const {
        const long L = (long)i * G + c; if (L >= nwg) return false;
        int wgid = (int)L; { const int q = nwg / NXCD, r = nwg % NXCD, xcd = wgid % NXCD, off = wgid / NXCD; wgid = (xcd < r ? xcd * (q + 1) : r * (q + 1) + (xcd - r) * q) + off; }
        const int nig = wgm * nN, gid = wgid / nig, fm = gid * wgm, gsz = (nM - fm) < wgm ? (nM - fm) : wgm;
        u.pm = fm + ((wgid % nig) % gsz); u.pn = (wgid % nig) / gsz; u.k0 = 0; u.nt = ntf; u.split = -1; return true;
    }
    __device__ __forceinline__ void a_ready(const Unit&) const {}
    __device__ __forceinline__ void done(const Unit&) const {}
};
constexpr int NSPLIT = 4;
__host__ __device__ __forceinline__ bool split_ok(int Mfull, int Mprompt, int N, int G) { const int nN = N / BM; return (G >= 8 * nN * NSPLIT) && ((Mprompt / BM * nN) % G == 0) && ((Mfull - Mprompt) / BM == 8); }
struct TailSplitOrder {
    int pm0, nN, c, q, rem;
    __host__ __device__ void init(int Mprompt, int N, int K, int c_) { nN = N / BM; pm0 = Mprompt / BM; c = c_; const int ntf = K / BK; q = (ntf / NSPLIT) & ~1; rem = ntf - q * NSPLIT; }
    __host__ __device__ bool next(int i, Unit& u) const {
        if (i > 0 || c >= 8 * nN * NSPLIT) return false;
        const int tu = c % (8 * nN), s = c / (8 * nN), first_big = NSPLIT - rem / 2;
        u.pm = pm0 + tu / nN; u.pn = tu % nN; u.k0 = s * q + (s > first_big ? 2 * (s - first_big) : 0); u.nt = q + (s >= first_big ? 2 : 0); u.split = s; return true;
    }
    __device__ __forceinline__ void a_ready(const Unit&) const {}
    __device__ __forceinline__ void done(const Unit&) const {}
};
__device__ __forceinline__ unsigned cvt_pk_bf16(float lo, float hi) { unsigned r; asm volatile("v_cvt_pk_bf16_f32 %0, %1, %2" : "=v"(r) : "v"(lo), "v"(hi)); return r; }
constexpr float LN_EPS = 1e-5f;
constexpr float ALPHA = 1.41421356237309515f;
typedef unsigned u32x2 __attribute__((ext_vector_type(2)));
__device__ __forceinline__ void unpack8(const u32x4 w, float (&f)[8]) {
    f[0] = __uint_as_float(w.x << 16); f[1] = __uint_as_float(w.x & 0xffff0000u); f[2] = __uint_as_float(w.y << 16); f[3] = __uint_as_float(w.y & 0xffff0000u);
    f[4] = __uint_as_float(w.z << 16); f[5] = __uint_as_float(w.z & 0xffff0000u); f[6] = __uint_as_float(w.w << 16); f[7] = __uint_as_float(w.w & 0xffff0000u);
}
__device__ __forceinline__ void unpack4(const u32x2 w, float (&f)[4]) {
    f[0] = __uint_as_float(w.x << 16); f[1] = __uint_as_float(w.x & 0xffff0000u); f[2] = __uint_as_float(w.y << 16); f[3] = __uint_as_float(w.y & 0xffff0000u);
}
__device__ __forceinline__ u32x4 pack8(const float (&f)[8]) { u32x4 w; w.x = cvt_pk_bf16(f[0], f[1]); w.y = cvt_pk_bf16(f[2], f[3]); w.z = cvt_pk_bf16(f[4], f[5]); w.w = cvt_pk_bf16(f[6], f[7]); return w; }
__device__ __forceinline__ void row_stats(const float* st, int row, float& mu, float& rstd) {
    typedef float f32x2v __attribute__((ext_vector_type(2)));
    const f32x2v a = *(const f32x2v*)(st + (size_t)row * 2); mu = a[0]; rstd = a[1];
}
__device__ __forceinline__ void load8f(const float* p, float (&f)[8]) { const f32x4 a = *(const f32x4*)p, b = *(const f32x4*)(p + 4); f[0] = a[0]; f[1] = a[1]; f[2] = a[2]; f[3] = a[3]; f[4] = b[0]; f[5] = b[1]; f[6] = b[2]; f[7] = b[3]; }

struct EpiProj {
    static constexpr bool PERM = true, AFTER_DRAIN = false;
    bf16_t* O; int ldo; const float* stats; const float* c1; const float* c2;
    __device__ __forceinline__ void operator()(f32x4 (&acc)[2][2][4][2], const Unit& u, int wr, int wc, int fr, int fq) const {
        const int row0 = u.pm * BM + wr * 64 + fr, col0 = u.pn * BM + wc * 32 + 8 * fq;
        const bool ln = stats != nullptr;
        float rs8[8], nm8[8];
#pragma unroll
        for (int i = 0; i < 8; ++i) { float mu = 0.f; rs8[i] = 1.f; if (ln) row_stats(stats, row0 + (i >> 2) * HALF + (i & 3) * 16, mu, rs8[i]); nm8[i] = -rs8[i] * mu; }
#pragma unroll
        for (int bj = 0; bj < 2; ++bj) {
            float k1[8], k2[8];
            if (ln) { load8f(c1 + col0 + bj * HALF, k1); load8f(c2 + col0 + bj * HALF, k2); }
            else {
#pragma unroll
                for (int q = 0; q < 8; ++q) { k1[q] = 0.f; k2[q] = 0.f; } }
#pragma unroll
            for (int ai = 0; ai < 2; ++ai)
#pragma unroll
                for (int m = 0; m < 4; ++m) {
                    const float rs = rs8[ai * 4 + m], nm = nm8[ai * 4 + m];
#pragma unroll
                    for (int q = 0; q < 4; ++q) { acc[ai][bj][m][0][q] = rs * acc[ai][bj][m][0][q] + (nm * k1[q] + k2[q]); acc[ai][bj][m][1][q] = rs * acc[ai][bj][m][1][q] + (nm * k1[4 + q] + k2[4 + q]); }
                }
        }
        asm volatile("" ::: "memory");
#pragma unroll
        for (int ai = 0; ai < 2; ++ai)
#pragma unroll
            for (int m = 0; m < 4; ++m) {
                const int row = row0 + ai * HALF + m * 16;
#pragma unroll
                for (int bj = 0; bj < 2; ++bj) { u32x4 w; w.x = cvt_pk_bf16(acc[ai][bj][m][0][0], acc[ai][bj][m][0][1]); w.y = cvt_pk_bf16(acc[ai][bj][m][0][2], acc[ai][bj][m][0][3]);
                    w.z = cvt_pk_bf16(acc[ai][bj][m][1][0], acc[ai][bj][m][1][1]); w.w = cvt_pk_bf16(acc[ai][bj][m][1][2], acc[ai][bj][m][1][3]);
                    *(u32x4*)(O + (size_t)row * ldo + col0 + bj * HALF) = w; }
            }
    }
};
template <bool F8OUT> struct EpiSwiGLU {
    static constexpr bool PERM = true, AFTER_DRAIN = false;
    bf16_t* O; int ldo; const float* stats; const float* c1; const float* c2;
    __device__ __forceinline__ void operator()(f32x4 (&acc)[2][2][4][2], const Unit& u, int wr, int wc, int fr, int fq) const {
        const int row0 = u.pm * BM + wr * 64 + fr, cidx = u.pn * BM + wc * 32 + 8 * fq, ocol = u.pn * HALF + wc * 32 + 8 * fq;
        float rs8[8], nm8[8];
#pragma unroll
        for (int i = 0; i < 8; ++i) { float mu; row_stats(stats, row0 + (i >> 2) * HALF + (i & 3) * 16, mu, rs8[i]); nm8[i] = -rs8[i] * mu; }
        float k1g[8], k2g[8], k1u[8], k2u[8];
        load8f(c1 + cidx, k1g); load8f(c2 + cidx, k2g); load8f(c1 + cidx + HALF, k1u); load8f(c2 + cidx + HALF, k2u);
#pragma unroll
        for (int ai = 0; ai < 2; ++ai)
#pragma unroll
            for (int m = 0; m < 4; ++m) {
                const int row = row0 + ai * HALF + m * 16;
                const float rs = rs8[ai * 4 + m], nm = nm8[ai * 4 + m];
                float o[8];
#pragma unroll
                for (int q = 0; q < 8; ++q) {
                    const float ga = (q < 4) ? acc[ai][0][m][0][q & 3] : acc[ai][0][m][1][q & 3], ua = (q < 4) ? acc[ai][1][m][0][q & 3] : acc[ai][1][m][1][q & 3];
                    const float g = rs * ga + (nm * k1g[q] + k2g[q]), up = rs * ua + (nm * k1u[q] + k2u[q]);
                    o[q] = g * __builtin_amdgcn_rcpf(1.f + __expf(-g)) * up;
                }
                if constexpr (F8OUT) { int w0 = 0, w1 = 0; w0 = __builtin_amdgcn_cvt_pk_fp8_f32(o[0], o[1], w0, false); w0 = __builtin_amdgcn_cvt_pk_fp8_f32(o[2], o[3], w0, true);
                    w1 = __builtin_amdgcn_cvt_pk_fp8_f32(o[4], o[5], w1, false); w1 = __builtin_amdgcn_cvt_pk_fp8_f32(o[6], o[7], w1, true);
                    u32x2 w; w.x = (unsigned)w0; w.y = (unsigned)w1; *(u32x2*)((unsigned char*)O + (size_t)row * ldo + ocol) = w; }
                else *(u32x4*)(O + (size_t)row * ldo + ocol) = pack8(o);
            }
    }
};
template <int RB> struct EpiRes {
    static constexpr bool PERM = true, AFTER_DRAIN = false;
    bf16_t* O; const bf16_t* R; const float* stats_in; const float* g; const float* b; float* stats_out; PG8_LAS float* pst; float accscale;
    __device__ __forceinline__ void operator()(f32x4 (&acc)[2][2][4][2], const Unit& u, int wr, int wc, int fr, int fq) const {
        const int row0 = u.pm * BM + wr * 64 + fr, col0 = u.pn * BM + wc * 32 + 8 * fq;
        const bool ln = stats_in != nullptr;
#pragma unroll
        for (int bj = 0; bj < 2; ++bj) {
            float gg[8], bb[8];
            if (ln) { load8f(g + col0 + bj * HALF, gg); load8f(b + col0 + bj * HALF, bb); }
            else {
#pragma unroll
                for (int q = 0; q < 8; ++q) { gg[q] = 1.f; bb[q] = 0.f; } }
#pragma unroll
            for (int ai = 0; ai < 2; ++ai)
#pragma unroll
            for (int mh = 0; mh < 4; mh += RB) {
                u32x4 rw[RB];
                asm volatile("" ::: "memory");
#pragma unroll
                for (int mm = 0; mm < RB; ++mm) rw[mm] = *(const u32x4*)((const char*)R + (size_t)(((unsigned)(row0 + ai * HALF + (mh + mm) * 16) * 1024u + (unsigned)(col0 + bj * HALF)) * 2u));
                float mu4[RB], rs4[RB];
#pragma unroll
                for (int mm = 0; mm < RB; ++mm) { mu4[mm] = 0.f; rs4[mm] = 1.f; if (ln) row_stats(stats_in, row0 + ai * HALF + (mh + mm) * 16, mu4[mm], rs4[mm]); }
#pragma unroll
                for (int mm = 0; mm < RB; ++mm) { const int m = mh + mm;
                    const float mu = mu4[mm], rs = rs4[mm];
                    float r[8]; unpack8(rw[mm], r);
#pragma unroll
                    for (int n = 0; n < 2; ++n)
#pragma unroll
                        for (int q4 = 0; q4 < 4; ++q4) { const int q = n * 4 + q4;
                            const float xr = (r[q] - mu) * rs * gg[q] + bb[q];
                            const float a = ALPHA * xr + accscale * acc[ai][bj][m][n][q4];
                            acc[ai][bj][m][n][q4] = a; }
                }
                if constexpr (RB == 4) asm volatile("" : "+v"(acc[ai][bj][0][0]), "+v"(acc[ai][bj][0][1]), "+v"(acc[ai][bj][1][0]), "+v"(acc[ai][bj][1][1]), "+v"(acc[ai][bj][2][0]), "+v"(acc[ai][bj][2][1]), "+v"(acc[ai][bj][3][0]), "+v"(acc[ai][bj][3][1]) :: "memory");
                else asm volatile("" : "+v"(acc[ai][bj][mh][0]), "+v"(acc[ai][bj][mh][1]), "+v"(acc[ai][bj][mh + 1][0]), "+v"(acc[ai][bj][mh + 1][1]) :: "memory");
            }
        }
        asm volatile("" ::: "memory");
#pragma unroll
        for (int ai = 0; ai < 2; ++ai)
#pragma unroll
            for (int m = 0; m < 4; ++m) {
                const int row = row0 + ai * HALF + m * 16;
                float s = 0.f, q2 = 0.f;
#pragma unroll
                for (int bj = 0; bj < 2; ++bj) {
#pragma unroll
                    for (int n = 0; n < 2; ++n)
#pragma unroll
                        for (int q4 = 0; q4 < 4; ++q4) { const float a = acc[ai][bj][m][n][q4]; s += a; q2 += a * a; }
                    u32x4 w; w.x = cvt_pk_bf16(acc[ai][bj][m][0][0], acc[ai][bj][m][0][1]); w.y = cvt_pk_bf16(acc[ai][bj][m][0][2], acc[ai][bj][m][0][3]);
                    w.z = cvt_pk_bf16(acc[ai][bj][m][1][0], acc[ai][bj][m][1][1]); w.w = cvt_pk_bf16(acc[ai][bj][m][1][2], acc[ai][bj][m][1][3]);
                    *(u32x4*)((char*)O + (size_t)(((unsigned)row * 1024u + (unsigned)(col0 + bj * HALF)) * 2u)) = w; }
                s += __shfl_xor(s, 16); s += __shfl_xor(s, 32); q2 += __shfl_xor(q2, 16); q2 += __shfl_xor(q2, 32);
                if (fq == 0) { PG8_LAS float* p = pst + ((ai * HALF + wr * 64 + m * 16 + fr) * 4 + wc) * 2; p[0] = s; p[1] = q2; }
            }
        asm volatile("s_waitcnt lgkmcnt(0)" ::: "memory"); __builtin_amdgcn_s_barrier(); asm volatile("" ::: "memory");
        if (threadIdx.x < 256) {
            const int row = threadIdx.x; const PG8_LAS f32x4* p = (const PG8_LAS f32x4*)(pst + row * 8);
            const f32x4 a = p[0], c = p[1];
            typedef float f32x2v __attribute__((ext_vector_type(2)));
            *(f32x2v*)(stats_out + ((size_t)(u.pm * BM + row) * 4 + u.pn) * 2) = (f32x2v){(a[0] + a[2]) + (c[0] + c[2]), (a[1] + a[3]) + (c[1] + c[3])};
        }
    }
};

struct EpiPart {
    static constexpr bool PERM = true, AFTER_DRAIN = false;
    float* part; int part_row0, part_rows; float accscale;
    __device__ __forceinline__ void operator()(f32x4 (&acc)[2][2][4][2], const Unit& u, int wr, int wc, int fr, int fq) const {
        const int row0 = u.pm * BM + wr * 64 + fr, col0 = u.pn * BM + wc * 32 + 8 * fq;
        const unsigned pb = (((unsigned)u.split * (unsigned)part_rows + (unsigned)(row0 - part_row0)) * 1024u + (unsigned)col0) * 4u;
#pragma unroll
        for (int ai = 0; ai < 2; ++ai)
#pragma unroll
            for (int m = 0; m < 4; ++m)
#pragma unroll
                for (int bj = 0; bj < 2; ++bj) { float* p = (float*)((char*)part + (size_t)(pb + (unsigned)((ai * HALF + m * 16) * 1024 + bj * HALF) * 4u)); *(f32x4*)p = acc[ai][bj][m][0] * accscale; *(f32x4*)(p + 4) = acc[ai][bj][m][1] * accscale; }
    }
};

struct EpiRaw {
    static constexpr bool PERM = true, AFTER_DRAIN = false;
    __device__ __forceinline__ void prefetch(const Unit&, PG8_LAS unsigned char*, int) const {}
    bf16_t* O; int ldo; float scale;
    __device__ __forceinline__ void operator()(f32x4 (&acc)[2][2][4][2], const Unit& u, int wr, int wc, int fr, int fq) const {
        const int row0 = u.pm * BM + wr * 64 + fr, col0 = u.pn * BM + wc * 32 + 8 * fq;
#pragma unroll
        for (int ai = 0; ai < 2; ++ai)
#pragma unroll
            for (int m = 0; m < 4; ++m)
#pragma unroll
                for (int bj = 0; bj < 2; ++bj) { u32x4 w; const f32x4 a = acc[ai][bj][m][0] * scale, b = acc[ai][bj][m][1] * scale;
                    w.x = cvt_pk_bf16(a[0], a[1]); w.y = cvt_pk_bf16(a[2], a[3]); w.z = cvt_pk_bf16(b[0], b[1]); w.w = cvt_pk_bf16(b[2], b[3]);
                    *(u32x4*)((char*)O + (size_t)(((unsigned)(row0 + ai * HALF + m * 16) * (unsigned)ldo + (unsigned)(col0 + bj * HALF)) * 2u)) = w; }
    }
};
template <class Epi, class Sched, bool ALIGN_EPI = false, bool SP2 = false, bool FP8 = false>
__device__ __forceinline__ void gemm_phase(PG8_LAS unsigned char* lds, const Gemm g, const Sched& S, const Epi& E) {
    int tid_ = threadIdx.x; asm volatile("" : "+v"(tid_));
    const int tid = tid_, wid = __builtin_amdgcn_readfirstlane(tid >> 6), lane = tid & 63, wr = wid >> 2, wc = wid & 3, fr = lane & 15, fq = lane >> 4;
    const int K = g.K;
    unsigned voffA[2], voffB[2];
#pragma unroll
    for (int i = 0; i < 2; ++i) { int R, C; stage_rc(tid * 16 + i * 8192, R, C); const int Rb = Epi::PERM ? ((R & ~31) + perm32(R & 31)) : R;
        voffA[i] = (unsigned)(R * K + C) * 2u; voffB[i] = (unsigned)(Rb * K + C) * 2u; }
    const size_t kstep = (size_t)(BK * 2);
    const size_t hstep = (size_t)HALF * K * 2;
    const size_t tstep = 2 * hstep;
    const unsigned ldsw = (unsigned)wid * 1024u;
    const int aoff = lds_byte(wr * 64 + fr, fq * 8), boff = lds_byte(wc * 32 + fr, fq * 8);
#define PG8_SA(b, h) (((b) * 2 + (h)) * HTB)
#define PG8_SB(b, h) ((4 + (b) * 2 + (h)) * HTB)
#define PG8_STAGE(bufoff, gbase, voff) do { _Pragma("unroll") for (int _i = 0; _i < 2; ++_i) \
        __builtin_amdgcn_global_load_lds((const unsigned*)((const char*)(gbase) + (voff)[_i]), (PG8_LAS unsigned*)(lds + (bufoff) + ldsw + _i * 8192), 16, 0, 0); } while (0)
#define PG8_LDA(dst, b, h) do { if constexpr (FP8) { _Pragma("unroll") for (int m = 0; m < 4; ++m) { const i32x4 lo_ = *(const PG8_LAS i32x4*)(lds + PG8_SA(b, h) + aoff + m * 2048), hi_ = *(const PG8_LAS i32x4*)(lds + PG8_SA(b, h) + aoff + m * 2048 + 1024); \
            dst##8[m] = __builtin_shufflevector(lo_, hi_, 0, 1, 2, 3, 4, 5, 6, 7); } } \
        else { _Pragma("unroll") for (int m = 0; m < 4; ++m) _Pragma("unroll") for (int k = 0; k < 2; ++k) dst[m][k] = *(const PG8_LAS bf16x8*)(lds + PG8_SA(b, h) + aoff + m * 2048 + k * 1024); } } while (0)
#define PG8_LDB(dst, b, h) do { if constexpr (FP8) { _Pragma("unroll") for (int n = 0; n < 2; ++n) { const i32x4 lo_ = *(const PG8_LAS i32x4*)(lds + PG8_SB(b, h) + boff + n * 2048), hi_ = *(const PG8_LAS i32x4*)(lds + PG8_SB(b, h) + boff + n * 2048 + 1024); \
            dst##8[n] = __builtin_shufflevector(lo_, hi_, 0, 1, 2, 3, 4, 5, 6, 7); } } \
        else { _Pragma("unroll") for (int n = 0; n < 2; ++n) _Pragma("unroll") for (int k = 0; k < 2; ++k) dst[n][k] = *(const PG8_LAS bf16x8*)(lds + PG8_SB(b, h) + boff + n * 2048 + k * 1024); } } while (0)
#define PG8_MMA(ai, bj, At, Bt) do { __builtin_amdgcn_s_setprio(1); \
        if constexpr (FP8) { _Pragma("unroll") for (int m = 0; m < 4; ++m) _Pragma("unroll") for (int n = 0; n < 2; ++n) \
            asm volatile("v_mfma_f32_16x16x128_f8f6f4 %0, %1, %2, %0" : "+v"(acc[ai][bj][m][n]) : "v"(Bt##8[n]), "v"(At##8[m])); } \
        else { _Pragma("unroll") for (int m = 0; m < 4; ++m) _Pragma("unroll") for (int n = 0; n < 2; ++n) _Pragma("unroll") for (int k = 0; k < 2; ++k) \
            acc[ai][bj][m][n] = __builtin_amdgcn_mfma_f32_16x16x32_bf16(Bt[n][k], At[m][k], acc[ai][bj][m][n], 0, 0, 0); } \
        __builtin_amdgcn_s_setprio(0); } while (0)
#define PG8_WAIT_V(n) asm volatile("s_waitcnt vmcnt(" #n ")" ::: "memory")
#define PG8_WAIT_L(n) asm volatile("s_waitcnt lgkmcnt(" #n ")" ::: "memory")
#define PG8_BAR __builtin_amdgcn_s_barrier()
#define PG8_SCHED __builtin_amdgcn_sched_barrier(0)
    Unit cur, nxt; int ui = 0;
    if (!S.next(0, cur)) return;
    f32x4 acc[2][2][4][2];
#pragma unroll
    for (int a = 0; a < 2; ++a)
#pragma unroll
        for (int b = 0; b < 2; ++b)
#pragma unroll
            for (int m = 0; m < 4; ++m)
#pragma unroll
                for (int n = 0; n < 2; ++n) acc[a][b][m][n] = (f32x4){0.f, 0.f, 0.f, 0.f};
    bf16x8 At[4][2], B0[2][2], B1[2][2]; i32x8 At8[4], B08[2], B18[2];
    const char* cA = (const char*)g.A + (size_t)cur.pm * tstep + (size_t)cur.k0 * kstep; const char* cB = (const char*)g.Bt + (size_t)cur.pn * tstep + (size_t)cur.k0 * kstep;
    S.a_ready(cur);
    if constexpr (SP2) {
        PG8_STAGE(PG8_SB(0, 0), cB, voffB); PG8_STAGE(PG8_SB(0, 1), cB + hstep, voffB); PG8_STAGE(PG8_SA(0, 0), cA, voffA); PG8_STAGE(PG8_SA(0, 1), cA + hstep, voffA);
        if (wr == 1) PG8_BAR;
        PG8_WAIT_V(2); PG8_BAR;
        PG8_STAGE(PG8_SB(1, 0), cB + kstep, voffB); PG8_STAGE(PG8_SA(1, 0), cA + kstep, voffA); PG8_STAGE(PG8_SB(1, 1), cB + hstep + kstep, voffB);
        PG8_WAIT_V(6); PG8_BAR;
    } else {
        PG8_STAGE(PG8_SB(0, 0), cB, voffB); PG8_STAGE(PG8_SA(0, 0), cA, voffA); PG8_STAGE(PG8_SB(0, 1), cB + hstep, voffB); PG8_STAGE(PG8_SA(0, 1), cA + hstep, voffA);
        if (wr == 1) PG8_BAR;
        PG8_WAIT_V(4); PG8_BAR;
        PG8_STAGE(PG8_SB(1, 0), cB + kstep, voffB); PG8_STAGE(PG8_SA(1, 0), cA + kstep, voffA); PG8_STAGE(PG8_SB(1, 1), cB + hstep + kstep, voffB);
        PG8_WAIT_V(6); PG8_BAR;
    }
    for (;;) {
        const bool has_next = S.next(ui + 1, nxt);
        const char* nA = has_next ? (const char*)g.A + (size_t)nxt.pm * tstep + (size_t)nxt.k0 * kstep : cA; const char* nB = has_next ? (const char*)g.Bt + (size_t)nxt.pn * tstep + (size_t)nxt.k0 * kstep : cB;
        const int nt = cur.nt;
#ifndef KREP
#define KREP 1
#endif
        for (int tt_ = 0; tt_ < nt * KREP; tt_ += 2) {
            const int t = (KREP > 1 && tt_ >= nt) ? tt_ - nt : tt_;
            if (KREP > 1 && tt_ == nt) {
#pragma unroll
                for (int a = 0; a < 2; ++a)
#pragma unroll
                    for (int b2_ = 0; b2_ < 2; ++b2_)
#pragma unroll
                        for (int m = 0; m < 4; ++m)
#pragma unroll
                            for (int n = 0; n < 2; ++n) acc[a][b2_][m][n] = (f32x4){0.f, 0.f, 0.f, 0.f}; }
            const bool last = (tt_ == nt * KREP - 2);
            const char* a1 = cA + (size_t)(t + 1) * kstep;
            const int t2 = (KREP > 1 && t + 2 >= nt) ? t + 2 - nt : t + 2;
            const char* a2 = last ? nA : cA + (size_t)t2 * kstep; const char* b2 = last ? nB : cB + (size_t)t2 * kstep;
            const char* a3 = a2 + kstep; const char* b3 = b2 + kstep;
            if (last && has_next) S.a_ready(nxt);
            if constexpr (SP2) {
            PG8_LDB(B0, 0, 0); PG8_LDB(B1, 0, 1); PG8_SCHED; PG8_LDA(At, 0, 0); PG8_STAGE(PG8_SA(1, 1), a1 + hstep, voffA);
            PG8_WAIT_V(8); PG8_WAIT_L(0); PG8_BAR; PG8_MMA(0, 0, At, B0); PG8_MMA(0, 1, At, B1); PG8_BAR; PG8_SCHED;
            PG8_LDA(At, 0, 1); PG8_STAGE(PG8_SB(0, 0), b2, voffB); PG8_STAGE(PG8_SB(0, 1), b2 + hstep, voffB); PG8_STAGE(PG8_SA(0, 0), a2, voffA);
            PG8_WAIT_V(8); PG8_WAIT_L(0); PG8_BAR; PG8_MMA(1, 0, At, B0); PG8_MMA(1, 1, At, B1); PG8_BAR; PG8_SCHED;
            PG8_LDB(B0, 1, 0); PG8_LDB(B1, 1, 1); PG8_SCHED; PG8_LDA(At, 1, 0); PG8_STAGE(PG8_SA(0, 1), a2 + hstep, voffA);
            PG8_WAIT_V(8); PG8_WAIT_L(0); PG8_BAR; PG8_MMA(0, 0, At, B0); PG8_MMA(0, 1, At, B1); PG8_BAR; PG8_SCHED;
            PG8_LDA(At, 1, 1); PG8_STAGE(PG8_SB(1, 0), b3, voffB); PG8_STAGE(PG8_SB(1, 1), b3 + hstep, voffB); PG8_STAGE(PG8_SA(1, 0), a3, voffA);
            PG8_WAIT_V(8); PG8_WAIT_L(0); PG8_BAR; PG8_MMA(1, 0, At, B0); PG8_MMA(1, 1, At, B1); PG8_BAR; PG8_SCHED;
            } else {
            PG8_LDB(B0, 0, 0); PG8_SCHED; PG8_LDA(At, 0, 0); PG8_STAGE(PG8_SA(1, 1), a1 + hstep, voffA);
            PG8_WAIT_L(8); PG8_BAR; PG8_WAIT_L(0); PG8_MMA(0, 0, At, B0); PG8_BAR; PG8_SCHED;
            PG8_LDB(B1, 0, 1); PG8_STAGE(PG8_SB(0, 0), b2, voffB);
            PG8_BAR; PG8_WAIT_L(0); PG8_MMA(0, 1, At, B1); PG8_BAR;
            PG8_LDA(At, 0, 1); PG8_STAGE(PG8_SA(0, 0), a2, voffA);
            PG8_BAR; PG8_WAIT_L(0); PG8_MMA(1, 0, At, B0); PG8_BAR; PG8_SCHED;
            PG8_STAGE(PG8_SB(0, 1), b2 + hstep, voffB);
            PG8_WAIT_V(6); PG8_BAR; PG8_MMA(1, 1, At, B1); PG8_BAR;
            PG8_LDB(B0, 1, 0); PG8_SCHED; PG8_LDA(At, 1, 0); PG8_STAGE(PG8_SA(0, 1), a2 + hstep, voffA);
            PG8_WAIT_L(8); PG8_BAR; PG8_WAIT_L(0); PG8_MMA(0, 0, At, B0); PG8_BAR; PG8_SCHED;
            PG8_LDB(B1, 1, 1); PG8_STAGE(PG8_SB(1, 0), b3, voffB);
            PG8_BAR; PG8_WAIT_L(0); PG8_MMA(0, 1, At, B1); PG8_BAR;
            PG8_LDA(At, 1, 1); PG8_STAGE(PG8_SA(1, 0), a3, voffA);
            PG8_BAR; PG8_WAIT_L(0); PG8_MMA(1, 0, At, B0); PG8_BAR; PG8_SCHED;
            PG8_STAGE(PG8_SB(1, 1), b3 + hstep, voffB);
            PG8_WAIT_V(6); PG8_BAR; PG8_MMA(1, 1, At, B1); PG8_BAR;
            }
        }
        if constexpr (FP8) asm volatile("s_nop 15\n\ts_nop 7" ::: "memory");
        if constexpr (ALIGN_EPI) { if (wr == 0) PG8_BAR; }
        if constexpr (!Epi::AFTER_DRAIN) { E(acc, cur, wr, wc, fr, fq); S.done(cur); }
        if (!has_next) break;
#pragma unroll
        for (int a = 0; a < 2; ++a)
#pragma unroll
            for (int b = 0; b < 2; ++b)
#pragma unroll
                for (int m = 0; m < 4; ++m)
#pragma unroll
                    for (int n = 0; n < 2; ++n) acc[a][b][m][n] = (f32x4){0.f, 0.f, 0.f, 0.f};
        cur = nxt; cA = nA; cB = nB; ++ui;
        if constexpr (ALIGN_EPI) { if (wr == 1) PG8_BAR; }
    }
    PG8_WAIT_V(0);
    if constexpr (!ALIGN_EPI) { if (wr == 0) PG8_BAR; }
    PG8_BAR;
    if constexpr (Epi::AFTER_DRAIN) { E.fused(acc, cur, wr, wc, fr, fq, lds, wid, lane); S.done(cur); }
#undef PG8_SA
#undef PG8_SB
#undef PG8_STAGE
#undef PG8_LDA
#undef PG8_LDB
#undef PG8_MMA
#undef PG8_WAIT_V
#undef PG8_WAIT_L
#undef PG8_BAR
#undef PG8_SCHED
}
}
#ifndef WGM_G2
#define WGM_G2 6
#endif
#ifndef WGM_G4
#define WGM_G4 6
#endif
#ifndef F8_ALL
#define F8_ALL 1
#endif
#ifndef F8_LAST
#define F8_LAST 1
#endif
constexpr float WD8_SCALE = 128.f;
#ifndef REP_P0
#define REP_P0 1
#endif
#ifndef REP_G1
#define REP_G1 1
#endif
#ifndef REP_MIX
#define REP_MIX 1
#endif
#ifndef REP_G2
#define REP_G2 1
#endif
#ifndef REP_G3
#define REP_G3 1
#endif
#ifndef REP_G4
#define REP_G4 1
#endif
#ifndef REP_FIN
#define REP_FIN 1
#endif
#ifndef REP_SYNC
#define REP_SYNC 1
#endif
using pg8::bf16_t; using pg8::bf16x8; using pg8::f32x4; using pg8::u32x4; using pg8::u32x2; using pg8::unpack8; using pg8::unpack4; using pg8::pack8; using pg8::cvt_pk_bf16; using pg8::load8f;
#define LAS __attribute__((address_space(3)))
constexpr int NWAVES = 8, NTHR = 512;
constexpr int D = 1024, DIN = 2048, DFF = 2816, NGU = 2 * DFF, DEPTH = 2;
constexpr int TP = 8 * 8192, TS = 32 * 64, T = TP + TS;
constexpr int LDS_BYTES = 155648, PST_OFF = 131072, MISC_OFF = LDS_BYTES - 64;
constexpr size_t al256(size_t x) { return (x + 255) & ~(size_t)255; }
constexpr size_t SZ_WIN = (size_t)DIN * D * 2, SZ_WOUT = (size_t)D * D * 2, SZ_WGU = (size_t)NGU * D * 2, SZ_WD = (size_t)D * DFF * 2, SZ_WSB = 8 * 128 * 128 * 2, SZ_WPT = 4 * 64 * 64 * 2;
constexpr size_t WS_WIN = 0, WS_WOUT = WS_WIN + DEPTH * SZ_WIN, WS_WGU = WS_WOUT + DEPTH * SZ_WOUT, WS_WD = WS_WGU + DEPTH * SZ_WGU, WS_WSB = WS_WD + DEPTH * SZ_WD, WS_WPT = WS_WSB + DEPTH * SZ_WSB;
constexpr size_t WS_C1IN = WS_WPT + DEPTH * SZ_WPT, WS_C2IN = WS_C1IN + DEPTH * DIN * 4, WS_C1GU = WS_C2IN + DEPTH * DIN * 4, WS_C2GU = WS_C1GU + DEPTH * NGU * 4;
constexpr size_t WS_BAR = al256(WS_C2GU + DEPTH * NGU * 4), BAR_BYTES = 16384;
constexpr size_t WS_ST1P = WS_BAR + BAR_BYTES, WS_ST2P = WS_ST1P + (size_t)T * 32, WS_ST1 = WS_ST2P + (size_t)T * 32, WS_ST2 = WS_ST1 + (size_t)T * 8;
constexpr size_t SZ_ACT = (size_t)T * D * 2;
constexpr size_t WS_XB = al256(WS_ST2 + (size_t)T * 8), WS_P1 = WS_XB + SZ_ACT, WS_P2 = WS_P1 + SZ_ACT, WS_PROJ = WS_P2 + SZ_ACT, WS_CAT = WS_PROJ + 2 * SZ_ACT, WS_HID = WS_PROJ, WS_PART = WS_CAT + SZ_ACT, WS_END = WS_PART + (size_t)pg8::NSPLIT * TS * D * 4;
static_assert((size_t)T * DFF * 2 <= 3 * SZ_ACT, "hid overlays proj|cat");
constexpr size_t O_YP = 0, O_YS = (size_t)TP * D, O_POOLP = (size_t)T * D, O_POOLS = O_POOLP + (size_t)DEPTH * 8 * 15 * 256, O_CONVP = O_POOLS + (size_t)DEPTH * 32 * 15 * 256,
                 O_CONVS = O_CONVP + (size_t)DEPTH * 8 * 2 * 256, O_V = O_CONVS + (size_t)DEPTH * 32 * 2 * 256, O_END = O_V + (size_t)DEPTH * 32 * 64 * 512;

struct Params { const float* in[20]; float* out; unsigned char* ws; };

__device__ __forceinline__ float wave_sum(float v) {
#pragma unroll
    for (int o = 1; o < 64; o <<= 1) v += __shfl_xor(v, o);
    return v;
}
__device__ __forceinline__ float bf2f(bf16_t h) { return __uint_as_float(((unsigned)h) << 16); }
#define LDS_WAIT() asm volatile("s_waitcnt lgkmcnt(0)" ::: "memory")

#define XB_TMO      128
#define XB_XCNT(j)  (256  + 64 * (j))
#define XB_XSUB(j)  (1280 + 64 * (j))
#define XB_XGEN(j)  (2304 + 64 * (j))
#define XB_TOP      3328
#define XB_TOPGEN   3392
#define XCD_BAR_WORDS 3456
#define XB_SPIN_CAP (1u << 18)

__device__ __forceinline__ unsigned xb_ld(unsigned* p)              { return __hip_atomic_load(p, __ATOMIC_RELAXED, __HIP_MEMORY_SCOPE_AGENT); }
__device__ __forceinline__ unsigned xb_add(unsigned* p, unsigned v) { return __hip_atomic_fetch_add(p, v, __ATOMIC_RELAXED, __HIP_MEMORY_SCOPE_AGENT); }
__device__ __forceinline__ unsigned xb_xcc_id() { return (unsigned)__builtin_amdgcn_s_getreg((3 << 11) | 20) & 0xFu; }
#define XB_SPIN(cond, bar) do { unsigned _sp = 0; while (cond) { __builtin_amdgcn_s_sleep(1); \
    if ((++_sp & 255u) == 0u) { if (xb_ld(&(bar)[XB_TMO])) break; if (_sp > XB_SPIN_CAP) { atomicAdd(&(bar)[XB_TMO], 1u); break; } } } } while (0)

struct XcdBarrier {
    unsigned* bar; unsigned x;
    volatile LAS unsigned* st;
};

__device__ __forceinline__ XcdBarrier xcd_barrier_post(unsigned* bar, volatile LAS unsigned* st) {
    XcdBarrier b; b.bar = bar; b.x = xb_xcc_id(); b.st = st;
    if (threadIdx.x == 0) (void)xb_add(&bar[XB_XCNT(b.x)], 1u);
    return b;
}
__device__ __forceinline__ void xcd_barrier_complete(unsigned* bar, unsigned x, unsigned& nloc, unsigned& nx) {
    const unsigned G = gridDim.x * gridDim.y * gridDim.z;
    unsigned sum, cnt, mine, sp = 0u;
    for (;;) {
        sum = 0u; cnt = 0u; mine = 0u;
#pragma unroll
        for (unsigned j = 0; j < 16; ++j) { const unsigned c = xb_ld(&bar[XB_XCNT(j)]); sum += c; cnt += (c > 0u) ? 1u : 0u; mine = (j == x) ? c : mine; }
        if (sum == G) break;
        __builtin_amdgcn_s_sleep(1);
        if ((++sp & 255u) == 0u) { if (xb_ld(&bar[XB_TMO])) break; if (sp > XB_SPIN_CAP) { atomicAdd(&bar[XB_TMO], 1u); break; } }
    }
    nloc = mine > 0u ? mine : 1u; nx = cnt > 0u ? cnt : 1u;
}

__device__ __forceinline__ void xcd_barrier(const XcdBarrier& b) {
    asm volatile("s_waitcnt vmcnt(0)" ::: "memory");
    __syncthreads();
    if (threadIdx.x == 0) {
        unsigned* bar = b.bar;
        __builtin_amdgcn_s_waitcnt(0);
        unsigned nloc = b.st[0], nx = b.st[1];
        if (nloc == 0u) { xcd_barrier_complete(bar, b.x, nloc, nx); b.st[0] = nloc; b.st[1] = nx; }
        const unsigned old = xb_add(&bar[XB_XSUB(b.x)], 1u);
        const unsigned gen = old / nloc;
        if (old + 1u == (gen + 1u) * nloc) {
            __builtin_amdgcn_fence(__ATOMIC_RELEASE, "agent");
            asm volatile("s_waitcnt vmcnt(0)" ::: "memory");
            const unsigned og = xb_add(&bar[XB_TOP], 1u);
            const unsigned tg = og / nx;
            if (og + 1u == (tg + 1u) * nx) xb_add(&bar[XB_TOPGEN], 1u);
            else XB_SPIN(xb_ld(&bar[XB_TOPGEN]) == tg, bar);
            __builtin_amdgcn_fence(__ATOMIC_ACQUIRE, "agent");
            xb_add(&bar[XB_XGEN(b.x)], 1u);
            asm volatile("s_waitcnt vmcnt(0)" ::: "memory");
        } else {
            XB_SPIN(xb_ld(&bar[XB_XGEN(b.x)]) == gen, bar);
            __builtin_amdgcn_fence(__ATOMIC_ACQUIRE, "agent");
            asm volatile("s_waitcnt vmcnt(0)" ::: "memory");
        }
    }
    __syncthreads();
}

__device__ __forceinline__ void p0_tile(const float* W, int srcN, int K, int k0, int n0, bf16_t* WT, int dstrow0, const float* g, const float* bvec, LAS float* scr, int lane, float (&s1)[4], float (&s2)[4], float f8scale = 0.f) {
#pragma unroll 8
    for (int i = 0; i < 32; ++i) { const int kk = 2 * i + (lane >> 5); scr[kk * 33 + (lane & 31)] = W[(size_t)(k0 + kk) * srcN + n0 + (lane & 31)]; }
    LDS_WAIT(); asm volatile("" ::: "memory");
    const int c = lane & 7;
    float gv[8], bv[8];
    if (g) { load8f(g + k0 + 8 * c, gv); load8f(bvec + k0 + 8 * c, bv); }
    else {
#pragma unroll
        for (int q = 0; q < 8; ++q) { gv[q] = 1.f; bv[q] = 0.f; } }
#pragma unroll
    for (int j = 0; j < 4; ++j) { const int n = (lane >> 3) + 8 * j; const LAS float* s = scr + (8 * c) * 33 + n;
        float v[8]; float t2 = 0.f;
#pragma unroll
        for (int q = 0; q < 8; ++q) { const float w = s[q * 33]; v[q] = w * gv[q]; t2 += w * bv[q]; }
        const u32x4 o = pack8(v);
        float r[8]; unpack8(o, r);
        s1[j] += ((r[0] + r[1]) + (r[2] + r[3])) + ((r[4] + r[5]) + (r[6] + r[7])); s2[j] += t2;
        if (f8scale != 0.f) { int w0 = 0, w1 = 0;
            w0 = __builtin_amdgcn_cvt_pk_fp8_f32(v[0] * f8scale, v[1] * f8scale, w0, false); w0 = __builtin_amdgcn_cvt_pk_fp8_f32(v[2] * f8scale, v[3] * f8scale, w0, true);
            w1 = __builtin_amdgcn_cvt_pk_fp8_f32(v[4] * f8scale, v[5] * f8scale, w1, false); w1 = __builtin_amdgcn_cvt_pk_fp8_f32(v[6] * f8scale, v[7] * f8scale, w1, true);
            u32x2 w; w.x = (unsigned)w0; w.y = (unsigned)w1; *(u32x2*)((unsigned char*)WT + (size_t)(dstrow0 + n) * K + k0 + 8 * c) = w; }
        else *(u32x4*)(WT + (size_t)(dstrow0 + n) * K + k0 + 8 * c) = o; }
    LDS_WAIT(); asm volatile("" ::: "memory");
}
__device__ __forceinline__ void p0_phase(const Params& p, LAS unsigned char* lds, int wave, int lane) {
    LAS float* scr = (LAS float*)(lds + wave * 16384);
    const int gw = blockIdx.x * NWAVES + wave, NGW = gridDim.x * NWAVES;
    unsigned char* ws = p.ws;
    constexpr int IA_IN = DIN / 32, IA_GU = NGU / 32, IA_L = IA_IN + IA_GU, IA = DEPTH * IA_L;
    LAS float* red = (LAS float*)(lds + PST_OFF);
    for (int it = blockIdx.x; it < IA; it += gridDim.x) {
        const int l = it / IA_L; int r = it % IA_L;
        const float* W; int srcN, n0, dstrow0; bf16_t* WT; const float* g; const float* bv; float* c1; float* c2;
        if (r < IA_IN) { W = p.in[6] + (size_t)l * D * DIN; srcN = DIN; n0 = 32 * r; dstrow0 = 32 * r; WT = (bf16_t*)(ws + WS_WIN + l * SZ_WIN);
            g = l ? p.in[15] : nullptr; bv = l ? p.in[16] : nullptr;
            c1 = (float*)(ws + WS_C1IN) + l * DIN; c2 = (float*)(ws + WS_C2IN) + l * DIN; }
        else { r -= IA_IN; dstrow0 = 32 * r; const int pn = dstrow0 >> 8, jj = dstrow0 & 255; W = (jj < 128 ? p.in[17] : p.in[18]) + (size_t)l * D * DFF; srcN = DFF; n0 = pn * 128 + (jj & 127);
            WT = (bf16_t*)(ws + WS_WGU + l * SZ_WGU); g = p.in[4] + l * D; bv = p.in[5] + l * D; c1 = (float*)(ws + WS_C1GU) + l * NGU; c2 = (float*)(ws + WS_C2GU) + l * NGU; }
        float s1[4] = {0.f, 0.f, 0.f, 0.f}, s2[4] = {0.f, 0.f, 0.f, 0.f};
        for (int kb = 2 * wave; kb < 2 * wave + 2; ++kb) p0_tile(W, srcN, D, 64 * kb, n0, WT, dstrow0, g, bv, scr, lane, s1, s2);
#pragma unroll
        for (int j = 0; j < 4; ++j) { float a = s1[j], b = s2[j]; a += __shfl_xor(a, 1); a += __shfl_xor(a, 2); a += __shfl_xor(a, 4); b += __shfl_xor(b, 1); b += __shfl_xor(b, 2); b += __shfl_xor(b, 4);
            if ((lane & 7) == 0) { const int n = (lane >> 3) + 8 * j; red[(wave * 32 + n) * 2] = a; red[(wave * 32 + n) * 2 + 1] = b; } }
        __syncthreads();
        if (wave == 0 && lane < 32) { float a = 0.f, b = 0.f;
#pragma unroll
            for (int w8 = 0; w8 < 8; ++w8) { a += red[(w8 * 32 + lane) * 2]; b += red[(w8 * 32 + lane) * 2 + 1]; }
            c1[dstrow0 + lane] = a; c2[dstrow0 + lane] = b; }
        __syncthreads();
    }
    constexpr int IB_O = (D / 64) * (D / 32), IB_D = (DFF / 64) * (D / 32), IB_L = IB_O + IB_D, IB = DEPTH * IB_L;
    for (int it = gw; it < IB; it += NGW) {
        const int l = it / IB_L; int r = it % IB_L; float d1[4] = {0.f, 0.f, 0.f, 0.f}, d2[4] = {0.f, 0.f, 0.f, 0.f};
        if (r < IB_O) { const int kb = r / (D / 32), nb = r % (D / 32); p0_tile(p.in[14] + (size_t)l * D * D, D, D, 64 * kb, 32 * nb, (bf16_t*)(ws + WS_WOUT + l * SZ_WOUT), 32 * nb, nullptr, nullptr, scr, lane, d1, d2); }
        else { r -= IB_O; const int kb = r / (D / 32), nb = r % (D / 32); p0_tile(p.in[19] + (size_t)l * DFF * D, D, DFF, 64 * kb, 32 * nb, (bf16_t*)(ws + WS_WD + l * SZ_WD), 32 * nb, nullptr, nullptr, scr, lane, d1, d2, (F8_LAST && (F8_ALL || l == DEPTH - 1)) ? WD8_SCALE : 0.f); }
    }
    const int gt = blockIdx.x * NTHR + wave * 64 + lane, GT = gridDim.x * NTHR;
    { bf16_t* wsb = (bf16_t*)(ws + WS_WSB); const float* src = p.in[9];
      for (int i = gt; i < DEPTH * 8 * 128 * 128 / 2; i += GT) { const int e = 2 * i, jj = e & 127, ii = (e >> 7) & 127; const bool keep = (jj >> 6) <= (ii >> 6);
          const float a = keep ? src[e] : 0.f, b = keep ? src[e + 1] : 0.f; ((unsigned*)wsb)[i] = cvt_pk_bf16(a, b); }
      bf16_t* wpt = (bf16_t*)(ws + WS_WPT); const float* wp = p.in[11];
      for (int i = gt; i < DEPTH * 4 * 64 * 64; i += GT) { const int c = i & 63, e = (i >> 6) & 63, lg = i >> 12; wpt[i] = (bf16_t)(cvt_pk_bf16(wp[((size_t)lg * 64 + c) * 64 + e], 0.f) & 0xffffu); } }
    { bf16_t* xb = (bf16_t*)(ws + WS_XB); constexpr int NCH = T * D / 8, PCH = TP * D / 8;
#pragma unroll 4
      for (int i = gt; i < NCH; i += GT) { const float* s = (i < PCH) ? p.in[0] + (size_t)i * 8 : p.in[1] + (size_t)(i - PCH) * 8; float f[8]; load8f(s, f); *(u32x4*)(xb + (size_t)i * 8) = pack8(f); } }
}

struct MixArgs {
    const bf16_t* proj; bf16_t* cat; const float* vg; const float* vb; const bf16_t* wsb; const float* bsp; const bf16_t* wpt; const float* pscale; const float* convw;
    const float* st_pool; const float* st_conv; float* o_pool_p; float* o_pool_s; float* o_conv_p; float* o_conv_s; float* o_v;
};
constexpr int VT_S = 136, XS = 264, VSTAT_OFF = 8 * 64 * VT_S * 2;
static_assert(VSTAT_OFF + 8192 <= MISC_OFF && 79 * XS * 2 <= 41984 && 41984 + 66 * 264 * 4 <= MISC_OFF, "MIX LDS map");
__device__ __forceinline__ void mix_chunk_unit(LAS unsigned char* lds, const MixArgs& A, int u, int tid_in, int wid_in, int lane_in) {
    int tid = tid_in; asm volatile("" : "+v"(tid)); const int lane = tid & 63, wid = __builtin_amdgcn_readfirstlane(tid >> 6); (void)wid_in; (void)lane_in;
    const int fr = lane & 15, fq = lane >> 4;
    const int r0 = u * 128; const bool prompt = u < 512;
    const bf16_t* proj = A.proj;
    typedef float f32x2v __attribute__((ext_vector_type(2)));
    LAS f32x2v* part = (LAS f32x2v*)(lds + VSTAT_OFF);
    const int h = wid; LAS bf16_t* vt = (LAS bf16_t*)lds + h * 64 * VT_S;
    const int j0 = 2 * lane;
    u32x2 uw[4][4];
    const unsigned uoff = ((unsigned)(r0 + fr) * DIN + (unsigned)(h * 64 + fq * 4)) * 2u;
#pragma unroll
    for (int it = 0; it < 4; ++it)
#pragma unroll
        for (int dt = 0; dt < 4; ++dt) uw[it][dt] = *(const u32x2*)((const char*)proj + (size_t)(uoff + (unsigned)((it * 16) * DIN + dt * 16) * 2u));
    u32x4 ra[8], rb[8];
    {
      LAS unsigned char* stg = (LAS unsigned char*)vt;
      u32x4 t[16];
      const unsigned goff = ((unsigned)(r0 + (lane >> 3)) * DIN + 512u + (unsigned)(h * 64 + (lane & 7) * 8)) * 2u;
#pragma unroll
      for (int k = 0; k < 16; ++k) t[k] = *(const u32x4*)((const char*)proj + (size_t)(goff + (unsigned)(8 * k * DIN) * 2u));
#pragma unroll
      for (int k = 0; k < 16; ++k) { const int r = (lane >> 3) + 8 * k; *(LAS u32x4*)(stg + r * 128 + (((lane & 7) ^ ((r >> 1) & 7)) * 16)) = t[k]; }
      LDS_WAIT(); asm volatile("" ::: "memory");
#pragma unroll
      for (int dc = 0; dc < 8; ++dc) { ra[dc] = *(const LAS u32x4*)(stg + (2 * lane) * 128 + ((dc ^ (lane & 7)) * 16)); rb[dc] = *(const LAS u32x4*)(stg + (2 * lane + 1) * 128 + ((dc ^ (lane & 7)) * 16)); }
      LDS_WAIT(); asm volatile("" ::: "memory");
    }
    { float s0 = 0.f, q0 = 0.f, s1 = 0.f, q1 = 0.f;
#pragma unroll
      for (int dc = 0; dc < 8; ++dc) { float a[8], b[8]; unpack8(ra[dc], a); unpack8(rb[dc], b);
#pragma unroll
          for (int q = 0; q < 8; ++q) { s0 += a[q]; q0 += a[q] * a[q]; s1 += b[q]; q1 += b[q] * b[q]; } }
      part[h * 128 + j0] = (f32x2v){s0, q0}; part[h * 128 + j0 + 1] = (f32x2v){s1, q1}; }
    __syncthreads();
    float mu0, rs0, mu1, rs1;
    { float s0 = 0.f, q0 = 0.f, s1 = 0.f, q1 = 0.f;
#pragma unroll
      for (int hh = 0; hh < 8; ++hh) { const f32x2v a = part[hh * 128 + j0], b = part[hh * 128 + j0 + 1]; s0 += a[0]; q0 += a[1]; s1 += b[0]; q1 += b[1]; }
      mu0 = s0 * (1.f / 512.f); rs0 = rsqrtf(fmaxf(q0 * (1.f / 512.f) - mu0 * mu0, 0.f) + pg8::LN_EPS);
      mu1 = s1 * (1.f / 512.f); rs1 = rsqrtf(fmaxf(q1 * (1.f / 512.f) - mu1 * mu1, 0.f) + pg8::LN_EPS); }
#pragma unroll
    for (int dc = 0; dc < 8; ++dc) { float a[8], b[8], gv[8], bv[8]; unpack8(ra[dc], a); unpack8(rb[dc], b);
        load8f(A.vg + h * 64 + dc * 8, gv); load8f(A.vb + h * 64 + dc * 8, bv);
#pragma unroll
        for (int q = 0; q < 8; ++q) { a[q] = (a[q] - mu0) * rs0 * gv[q] + bv[q]; b[q] = (b[q] - mu1) * rs1 * gv[q] + bv[q]; }
        if (!prompt) { float* o = A.o_v + (size_t)(r0 - TP + j0) * 512 + h * 64 + dc * 8;
            *(f32x4*)o = (f32x4){a[0], a[1], a[2], a[3]}; *(f32x4*)(o + 4) = (f32x4){a[4], a[5], a[6], a[7]}; *(f32x4*)(o + 512) = (f32x4){b[0], b[1], b[2], b[3]}; *(f32x4*)(o + 516) = (f32x4){b[4], b[5], b[6], b[7]}; }
#pragma unroll
        for (int q = 0; q < 8; ++q) *(LAS unsigned*)(vt + (dc * 8 + q) * VT_S + j0) = cvt_pk_bf16(a[q], b[q]); }
    LDS_WAIT(); asm volatile("" ::: "memory");
#pragma unroll 1
    for (int ob = 0; ob < 2; ++ob) {
        const int wsr0 = prompt ? ob * 64 : 0, vr0 = prompt ? 0 : ob * 64, nk = (prompt && ob) ? 4 : 2;
        if (ob == 1) {
#pragma unroll
            for (int it = 0; it < 4; ++it)
#pragma unroll
                for (int dt = 0; dt < 4; ++dt) uw[it][dt] = *(const u32x2*)((const char*)proj + (size_t)(uoff + (unsigned)((64 + it * 16) * DIN + dt * 16) * 2u));
        }
#pragma unroll
        for (int it = 0; it < 4; ++it) {
            const int wrow = wsr0 + it * 16 + fr; const size_t row = (size_t)r0 + ob * 64 + it * 16 + fr;
            const float bs = A.bsp[h * 128 + wrow];
            bf16x8 wf[4];
#pragma unroll
            for (int ks = 0; ks < 4; ++ks) if (ks < nk) wf[ks] = *(const bf16x8*)(A.wsb + ((size_t)h * 128 + wrow) * 128 + ks * 32 + fq * 8);
            f32x4 acc[4];
#pragma unroll
            for (int b = 0; b < 4; ++b) acc[b] = (f32x4){0.f, 0.f, 0.f, 0.f};
#pragma unroll
            for (int ks = 0; ks < 4; ++ks) if (ks < nk) { bf16x8 vf[4];
#pragma unroll
                for (int dt = 0; dt < 4; ++dt) vf[dt] = *(const LAS bf16x8*)(vt + (dt * 16 + fr) * VT_S + vr0 + ks * 32 + fq * 8);
#pragma unroll
                for (int dt = 0; dt < 4; ++dt) acc[dt] = __builtin_amdgcn_mfma_f32_16x16x32_bf16(vf[dt], wf[ks], acc[dt], 0, 0, 0); }
#pragma unroll
            for (int dt = 0; dt < 4; ++dt) { const int d = h * 64 + dt * 16 + fq * 4; float uu[4]; unpack4(uw[it][dt], uu);
                u32x2 o; o.x = cvt_pk_bf16(uu[0] * (acc[dt][0] + bs), uu[1] * (acc[dt][1] + bs)); o.y = cvt_pk_bf16(uu[2] * (acc[dt][2] + bs), uu[3] * (acc[dt][3] + bs));
                *(u32x2*)(A.cat + row * D + d) = o; }
        }
    }
    __syncthreads();
}
__device__ __forceinline__ void mix_pool_conv_block(LAS unsigned char* lds, const MixArgs& A, int blk, int tid_in, int wid_in, int lane_in) {
    int tid = tid_in; asm volatile("" : "+v"(tid)); const int lane = tid & 63, wid = __builtin_amdgcn_readfirstlane(tid >> 6); (void)wid_in; (void)lane_in;
    const int fr = lane & 15, fq = lane >> 4;
    const int r0 = blk * 64; const bool prompt = blk < 1024; const int bi = blk & 127, sb = blk - 1024;
    const int t0 = prompt ? bi * 64 : 0;
    const bf16_t* proj = A.proj;
    LAS bf16_t* xt = (LAS bf16_t*)lds;
    const int g = wid >> 1, half = wid & 1, w = 2 << g;
    bf16x8 wf[2][4];
#pragma unroll
    for (int ks = 0; ks < 2; ++ks)
#pragma unroll
        for (int et = 0; et < 4; ++et) wf[ks][et] = *(const bf16x8*)(A.wpt + ((size_t)g * 64 + et * 16 + fr) * 64 + ks * 32 + fq * 8);
    u32x4 tw[5];
#pragma unroll
    for (int i = 0; i < 5; ++i) { const int idx = tid + i * NTHR, tr = idx >> 5, cc = idx & 31; u32x4 wv = (u32x4){0u, 0u, 0u, 0u};
        if (idx < 79 * 32) {
            if (tr >= 15 || (prompt && bi != 0)) wv = *(const u32x4*)(proj + (size_t)(r0 - 15 + tr) * DIN + 1024 + cc * 8);
            else if (!prompt) { float f[8]; load8f(A.st_pool + ((size_t)sb * 15 + tr) * 256 + cc * 8, f); wv = pack8(f); } }
        tw[i] = wv; }
    const int cj = tid >> 5, cc8 = (tid & 31) * 8;
    constexpr int ZS = 264, ZT_OFF = 41984;
    LAS float* zt = (LAS float*)(lds + ZT_OFF);
    u32x4 cgb[4], cgc[4], chh[4];
#pragma unroll
    for (int it = 0; it < 4; ++it) { const bf16_t* pr = proj + ((size_t)r0 + cj + 16 * it) * DIN; cgb[it] = *(const u32x4*)(pr + 1280 + cc8); cgc[it] = *(const u32x4*)(pr + 1536 + cc8); chh[it] = *(const u32x4*)(pr + 1792 + cc8); }
    float zh[8];
#pragma unroll
    for (int q = 0; q < 8; ++q) zh[q] = 0.f;
    if (tid < 64) {
        if (prompt && bi != 0) { float a[8], b[8]; unpack8(*(const u32x4*)(proj + ((size_t)r0 - 2 + cj) * DIN + 1536 + cc8), a); unpack8(*(const u32x4*)(proj + ((size_t)r0 - 2 + cj) * DIN + 1792 + cc8), b);
#pragma unroll
            for (int q = 0; q < 8; ++q) zh[q] = a[q] * b[q]; }
        else if (!prompt) load8f(A.st_conv + ((size_t)sb * 2 + cj) * 256 + cc8, zh);
    }
    float z0[4][8];
#pragma unroll
    for (int it = 0; it < 4; ++it) { float gc[8], hh[8]; unpack8(cgc[it], gc); unpack8(chh[it], hh);
#pragma unroll
        for (int q = 0; q < 8; ++q) z0[it][q] = gc[q] * hh[q];
        LAS float* d = zt + (2 + cj + 16 * it) * ZS + cc8; *(LAS f32x4*)d = (f32x4){z0[it][0], z0[it][1], z0[it][2], z0[it][3]}; *(LAS f32x4*)(d + 4) = (f32x4){z0[it][4], z0[it][5], z0[it][6], z0[it][7]}; }
    if (tid < 64) { LAS float* d = zt + cj * ZS + cc8; *(LAS f32x4*)d = (f32x4){zh[0], zh[1], zh[2], zh[3]}; *(LAS f32x4*)(d + 4) = (f32x4){zh[4], zh[5], zh[6], zh[7]}; }
#pragma unroll
    for (int i = 0; i < 5; ++i) { const int idx = tid + i * NTHR, tr = idx >> 5, cc = idx & 31; if (idx < 79 * 32) *(LAS u32x4*)(xt + tr * XS + cc * 8) = tw[i]; }
    __syncthreads();
    { float w0[8], w1[8], w2[8]; load8f(A.convw + cc8, w0); load8f(A.convw + 256 + cc8, w1); load8f(A.convw + 512 + cc8, w2);
#pragma unroll
      for (int it = 0; it < 4; ++it) { const int j = cj + 16 * it, t = t0 + j; const size_t row = (size_t)r0 + j;
          const LAS float* p1 = zt + (1 + j) * ZS + cc8; const LAS float* p2 = zt + j * ZS + cc8;
          const f32x4 a1 = *(const LAS f32x4*)p1, b1 = *(const LAS f32x4*)(p1 + 4), a2 = *(const LAS f32x4*)p2, b2 = *(const LAS f32x4*)(p2 + 4);
          const float z1[8] = {a1[0], a1[1], a1[2], a1[3], b1[0], b1[1], b1[2], b1[3]}, z2[8] = {a2[0], a2[1], a2[2], a2[3], b2[0], b2[1], b2[2], b2[3]};
          float gb[8], o[8]; unpack8(cgb[it], gb);
#pragma unroll
          for (int q = 0; q < 8; ++q) o[q] = gb[q] * (w0[q] * z2[q] + w1[q] * z1[q] + w2[q] * z0[it][q]);
          *(u32x4*)(A.cat + row * D + 768 + cc8) = pack8(o);
          const int tl = prompt ? 8190 : 62;
          if (t >= tl) { float* o2 = (prompt ? A.o_conv_p + ((size_t)(blk >> 7) * 2 + (t - tl)) * 256 : A.o_conv_s + ((size_t)sb * 2 + (t - tl)) * 256) + cc8;
              *(f32x4*)o2 = (f32x4){z0[it][0], z0[it][1], z0[it][2], z0[it][3]}; *(f32x4*)(o2 + 4) = (f32x4){z0[it][4], z0[it][5], z0[it][6], z0[it][7]}; } } }
#pragma unroll 1
    for (int tt = 0; tt < 2; ++tt) {
        f32x4 acc[4];
#pragma unroll
        for (int b = 0; b < 4; ++b) acc[b] = (f32x4){0.f, 0.f, 0.f, 0.f};
        const int j = half * 32 + tt * 16 + fr, ti = 15 + j;
        const int pos = t0 + j; const float cnt = prompt ? (float)min(pos + 1, w) : (float)w; const float inv = 1.f / cnt;
#pragma unroll
        for (int ks = 0; ks < 2; ++ks) { const int c = g * 64 + ks * 32 + fq * 8;
            float sum[8] = {0.f, 0.f, 0.f, 0.f, 0.f, 0.f, 0.f, 0.f}, x0[8];
#pragma unroll 2
            for (int k = 0; k < w; ++k) { float x[8]; unpack8(*(const LAS u32x4*)(xt + (ti - k) * XS + c), x);
#pragma unroll
                for (int q = 0; q < 8; ++q) sum[q] += x[q]; }
            unpack8(*(const LAS u32x4*)(xt + ti * XS + c), x0);
            float df[8];
#pragma unroll
            for (int q = 0; q < 8; ++q) df[q] = sum[q] * inv - x0[q];
            const u32x4 dw = pack8(df); bf16x8 dfr; __builtin_memcpy(&dfr, &dw, 16);
#pragma unroll
            for (int et = 0; et < 4; ++et) acc[et] = __builtin_amdgcn_mfma_f32_16x16x32_bf16(wf[ks][et], dfr, acc[et], 0, 0, 0); }
        const size_t row = (size_t)r0 + j;
#pragma unroll
        for (int et = 0; et < 4; ++et) { const int e = g * 64 + et * 16 + fq * 4; const f32x4 sc = *(const f32x4*)(A.pscale + e);
            u32x2 o; o.x = cvt_pk_bf16(acc[et][0] * sc[0], acc[et][1] * sc[1]); o.y = cvt_pk_bf16(acc[et][2] * sc[2], acc[et][3] * sc[3]);
            *(u32x2*)(A.cat + row * D + 512 + e) = o; } }
    if (!prompt || bi == 127) { float* dst = prompt ? A.o_pool_p + (size_t)(blk >> 7) * 15 * 256 : A.o_pool_s + (size_t)sb * 15 * 256;
        for (int idx = tid; idx < 15 * 256; idx += NTHR) { const int i = idx >> 8, c = idx & 255; dst[i * 256 + c] = bf2f(xt[(15 + 49 + i) * XS + c]); } }
    __syncthreads();
}
__device__ __forceinline__ void mix_phase(LAS unsigned char* lds, const MixArgs& A, int tid, int wid, int lane) {
    const int c = blockIdx.x, G = gridDim.x;
    constexpr int NA = T / 128, NB = T / 64;
    const int nA = (NA + G - 1) / G, nB = (NB + G - 1) / G;
#pragma unroll 1
    for (int i = 0; i < nA + nB; ++i) {
        int type = -1, idx = 0;
        if (G == 256) {
            if (i < 2) { type = 0; idx = c + 256 * i; }
            else if (c < 16) { if (i == 2) { type = 0; idx = 512 + c; } else if (i < 5) { type = 1; idx = 2 * c + (i - 3); } }
            else { const int j = c - 16; if (i < 6) { type = 1; idx = 32 + j + 240 * (i - 2); } else if (i == 6 && j < 64) { type = 1; idx = 992 + j; } }
        } else {
            if (i < nA) { idx = c + G * i; type = idx < NA ? 0 : -1; } else { idx = c + G * (i - nA); type = idx < NB ? 1 : -1; }
        }
        type = __builtin_amdgcn_readfirstlane(type); idx = __builtin_amdgcn_readfirstlane(idx);
#ifndef REP_MIXA
#define REP_MIXA 1
#endif
#ifndef REP_MIXB
#define REP_MIXB 1
#endif
        if (type == 0) { for (int r = 0; r < REP_MIXA; ++r) mix_chunk_unit(lds, A, idx, tid, wid, lane); }
        else if (type == 1) { for (int r = 0; r < REP_MIXB; ++r) mix_pool_conv_block(lds, A, idx, tid, wid, lane); }
    }
}

__device__ __forceinline__ void finalize_stats(const float* part, float* fin, int nrows) {
    typedef float f32x2v __attribute__((ext_vector_type(2)));
    for (int row = blockIdx.x * NTHR + threadIdx.x; row < nrows; row += gridDim.x * NTHR) {
        const f32x4 a = *(const f32x4*)(part + (size_t)row * 8), b = *(const f32x4*)(part + (size_t)row * 8 + 4);
        const float S = (a[0] + a[2]) + (b[0] + b[2]), Q = (a[1] + a[3]) + (b[1] + b[3]);
        const float mu = S * (1.f / 1024.f), var = fmaxf(Q * (1.f / 1024.f) - mu * mu, 0.f);
        *(f32x2v*)(fin + (size_t)row * 2) = (f32x2v){mu, rsqrtf(var + pg8::LN_EPS)};
    }
}
__device__ __forceinline__ bool split_on(int G) { return pg8::split_ok(T, TP, D, G); }
__device__ __forceinline__ void finalize_sample(const float* part, const bf16_t* R, const float* stats_in, const float* g, const float* b, bf16_t* O, float* fin) {
    typedef float f32x2v __attribute__((ext_vector_type(2)));
    int tid_ = threadIdx.x; asm volatile("" : "+v"(tid_)); const int lane = tid_ & 63, wave = __builtin_amdgcn_readfirstlane(tid_ >> 6);
    for (int lr = blockIdx.x * NWAVES + wave; lr < TS; lr += gridDim.x * NWAVES) {
        const size_t row = (size_t)TP + lr; float mu = 0.f, rs = 1.f; if (stats_in) pg8::row_stats(stats_in, (int)row, mu, rs);
        float v[2][8], s = 0.f, q = 0.f;
#pragma unroll
        for (int hh = 0; hh < 2; ++hh) { const int c = hh * 512 + lane * 8; float r[8], gg[8], bb[8]; unpack8(*(const u32x4*)(R + row * D + c), r);
            if (stats_in) { load8f(g + c, gg); load8f(b + c, bb); }
#pragma unroll
            for (int k = 0; k < 8; ++k) v[hh][k] = pg8::ALPHA * (stats_in ? (r[k] - mu) * rs * gg[k] + bb[k] : r[k]);
#pragma unroll
            for (int sp = 0; sp < pg8::NSPLIT; ++sp) { float p8[8]; load8f(part + ((size_t)sp * TS + lr) * D + c, p8);
#pragma unroll
                for (int k = 0; k < 8; ++k) v[hh][k] += p8[k]; }
#pragma unroll
            for (int k = 0; k < 8; ++k) { s += v[hh][k]; q += v[hh][k] * v[hh][k]; }
            *(u32x4*)(O + row * D + c) = pack8(v[hh]); }
        s = wave_sum(s); q = wave_sum(q);
        const float m2 = s * (1.f / 1024.f), var = fmaxf(q * (1.f / 1024.f) - m2 * m2, 0.f);
        if (lane == 0) *(f32x2v*)(fin + row * 2) = (f32x2v){m2, rsqrtf(var + pg8::LN_EPS)};
    }
}
typedef const __attribute__((address_space(4))) Params* ParamsPtr;
#define GETP() ParamsPtr pp; { auto kp_ = __builtin_amdgcn_kernarg_segment_ptr(); asm volatile("" : "+s"(kp_)); pp = (ParamsPtr)kp_; } unsigned char* ws = pp->ws; int l = lc; asm volatile("" : "+s"(l));
__global__ void __launch_bounds__(NTHR, 2) fwd_megakernel(Params p_unused) {
    extern __shared__ __attribute__((aligned(16))) unsigned char lds_raw[];
    LAS unsigned char* lds = (LAS unsigned char*)lds_raw;
    cg::grid_group grid = cg::this_grid();
    const int tid = threadIdx.x;
    if (gridDim.x == 0x7fffffffu) grid.sync();
    volatile LAS unsigned* MISC = (volatile LAS unsigned*)(lds + MISC_OFF);
    if (tid < 16) MISC[tid] = 0u;
    __syncthreads();
    { auto kp0 = __builtin_amdgcn_kernarg_segment_ptr(); (void)xcd_barrier_post((unsigned*)(((ParamsPtr)kp0)->ws + WS_BAR), MISC); }
#define GRIDBAR() do { auto kpb_ = __builtin_amdgcn_kernarg_segment_ptr(); asm volatile("" : "+s"(kpb_)); XcdBarrier xb_; xb_.bar = (unsigned*)(((ParamsPtr)kpb_)->ws + WS_BAR); xb_.x = xb_xcc_id(); \
        xb_.st = (volatile LAS unsigned*)((LAS unsigned char*)lds_raw + MISC_OFF); xcd_barrier(xb_); } while (0)
#ifndef NO_P0
    for (int rep = 0; rep < REP_P0; ++rep) { const int lc = 0; GETP(); (void)l; (void)ws; Params p; for (int i = 0; i < 20; ++i) p.in[i] = pp->in[i]; p.out = pp->out; p.ws = pp->ws;
      int tid0 = threadIdx.x; asm volatile("" : "+v"(tid0)); p0_phase(p, lds, __builtin_amdgcn_readfirstlane(tid0 >> 6), tid0 & 63); }
#endif
    GRIDBAR();

    for (int lc = 0; lc < DEPTH; ++lc) {
#ifndef NO_G1
        for (int rep = 0; rep < REP_G1; ++rep) { GETP(); const int G = gridDim.x;
          pg8::Gemm g{(const bf16_t*)(ws + (l ? WS_P2 : WS_XB)), (const bf16_t*)(ws + WS_WIN + l * SZ_WIN), T, DIN, D}; pg8::StaticOrder S; S.init(T, DIN, D, G, (int)blockIdx.x);
          pg8::EpiProj E{(bf16_t*)(ws + WS_PROJ), DIN, l ? (const float*)(ws + WS_ST2) : nullptr, (const float*)(ws + WS_C1IN) + l * DIN, (const float*)(ws + WS_C2IN) + l * DIN};
          pg8::gemm_phase<pg8::EpiProj, pg8::StaticOrder, true, true>(lds, g, S, E); }
#endif
        GRIDBAR();
#ifndef NO_MIX
        for (int rep = 0; rep < REP_MIX; ++rep) { GETP(); const int G = gridDim.x; float* out = pp->out;
          MixArgs A; A.proj = (const bf16_t*)(ws + WS_PROJ); A.cat = (bf16_t*)(ws + WS_CAT); A.vg = pp->in[7] + l * 512; A.vb = pp->in[8] + l * 512; A.wsb = (const bf16_t*)(ws + WS_WSB + l * SZ_WSB); A.bsp = pp->in[10] + l * 8 * 128;
          A.wpt = (const bf16_t*)(ws + WS_WPT + l * SZ_WPT); A.pscale = pp->in[12] + l * 256; A.convw = pp->in[13] + l * 3 * 256; A.st_pool = pp->in[2] + (size_t)l * 32 * 15 * 256; A.st_conv = pp->in[3] + (size_t)l * 32 * 2 * 256;
          A.o_pool_p = out + O_POOLP + (size_t)l * 8 * 15 * 256; A.o_pool_s = out + O_POOLS + (size_t)l * 32 * 15 * 256; A.o_conv_p = out + O_CONVP + (size_t)l * 8 * 2 * 256; A.o_conv_s = out + O_CONVS + (size_t)l * 32 * 2 * 256;
          A.o_v = out + O_V + (size_t)l * 32 * 64 * 512;
          int tid2 = threadIdx.x; asm volatile("" : "+v"(tid2)); const int lane2 = tid2 & 63, wid2 = __builtin_amdgcn_readfirstlane(tid2 >> 6);
          (void)G; mix_phase(lds, A, tid2, wid2, lane2); }
#endif
        GRIDBAR();
#ifndef NO_G2
        for (int rep = 0; rep < REP_G2; ++rep) { GETP(); const int G = gridDim.x;
          pg8::Gemm g{(const bf16_t*)(ws + WS_CAT), (const bf16_t*)(ws + WS_WOUT + l * SZ_WOUT), T, D, D}; const bool sp = split_on(G); pg8::StaticOrder S; S.init(sp ? TP : T, D, D, G, (int)blockIdx.x, WGM_G2);
          pg8::EpiRes<4> E{(bf16_t*)(ws + WS_P1), (const bf16_t*)(ws + (l ? WS_P2 : WS_XB)), l ? (const float*)(ws + WS_ST2) : nullptr, pp->in[15] + (l - 1) * D, pp->in[16] + (l - 1) * D, (float*)(ws + WS_ST1P), (LAS float*)(lds + PST_OFF), 1.f};
          pg8::gemm_phase<pg8::EpiRes<4>, pg8::StaticOrder, true, true>(lds, g, S, E);
          if (sp) { pg8::TailSplitOrder S2; S2.init(TP, D, D, (int)blockIdx.x); pg8::EpiPart E2{(float*)(ws + WS_PART), TP, TS, 1.f}; pg8::gemm_phase<pg8::EpiPart, pg8::TailSplitOrder, true, true>(lds, g, S2, E2); } }
#endif
        GRIDBAR();
        { GETP(); const bool sp = split_on((int)gridDim.x); finalize_stats((const float*)(ws + WS_ST1P), (float*)(ws + WS_ST1), sp ? TP : T);
          if (sp) finalize_sample((const float*)(ws + WS_PART), (const bf16_t*)(ws + (l ? WS_P2 : WS_XB)), l ? (const float*)(ws + WS_ST2) : nullptr, pp->in[15] + (l - 1) * D, pp->in[16] + (l - 1) * D, (bf16_t*)(ws + WS_P1), (float*)(ws + WS_ST1)); }
        GRIDBAR();
#ifndef NO_G3
        for (int rep = 0; rep < REP_G3; ++rep) { GETP(); const int G = gridDim.x;
          pg8::Gemm g{(const bf16_t*)(ws + WS_P1), (const bf16_t*)(ws + WS_WGU + l * SZ_WGU), T, NGU, D}; pg8::StaticOrder S; S.init(T, NGU, D, G, (int)blockIdx.x);
          if (F8_LAST && (F8_ALL || l == DEPTH - 1)) { pg8::EpiSwiGLU<true> E{(bf16_t*)(ws + WS_HID), DFF, (const float*)(ws + WS_ST1), (const float*)(ws + WS_C1GU) + l * NGU, (const float*)(ws + WS_C2GU) + l * NGU};
              pg8::gemm_phase<pg8::EpiSwiGLU<true>, pg8::StaticOrder, true, true>(lds, g, S, E); }
          else { pg8::EpiSwiGLU<false> E{(bf16_t*)(ws + WS_HID), DFF, (const float*)(ws + WS_ST1), (const float*)(ws + WS_C1GU) + l * NGU, (const float*)(ws + WS_C2GU) + l * NGU};
              pg8::gemm_phase<pg8::EpiSwiGLU<false>, pg8::StaticOrder, true, true>(lds, g, S, E); } }
#endif
        GRIDBAR();
#ifndef NO_G4
        for (int rep = 0; rep < REP_G4; ++rep) { GETP(); const int G = gridDim.x;
          const bool sp = split_on(G);
          if (F8_LAST && l == DEPTH - 1) {
              pg8::Gemm g{(const bf16_t*)(ws + WS_HID), (const bf16_t*)(ws + WS_WD + l * SZ_WD), T, D, DFF / 2}; pg8::StaticOrder S; S.init(T, D, DFF / 2, G, (int)blockIdx.x, WGM_G4);
              pg8::EpiRaw E{(bf16_t*)(ws + WS_P2), D, 1.f / WD8_SCALE};
              pg8::gemm_phase<pg8::EpiRaw, pg8::StaticOrder, true, true, true>(lds, g, S, E);
          } else if (F8_LAST && F8_ALL) {
              pg8::Gemm g{(const bf16_t*)(ws + WS_HID), (const bf16_t*)(ws + WS_WD + l * SZ_WD), T, D, DFF / 2}; pg8::StaticOrder S; S.init(sp ? TP : T, D, DFF / 2, G, (int)blockIdx.x, WGM_G4);
              pg8::EpiRes<4> E{(bf16_t*)(ws + WS_P2), (const bf16_t*)(ws + WS_P1), (const float*)(ws + WS_ST1), pp->in[4] + l * D, pp->in[5] + l * D, (float*)(ws + WS_ST2P), (LAS float*)(lds + PST_OFF), 1.f / WD8_SCALE};
              pg8::gemm_phase<pg8::EpiRes<4>, pg8::StaticOrder, true, true, true>(lds, g, S, E);
              if (sp) { pg8::TailSplitOrder S2; S2.init(TP, D, DFF / 2, (int)blockIdx.x); pg8::EpiPart E2{(float*)(ws + WS_PART), TP, TS, 1.f / WD8_SCALE}; pg8::gemm_phase<pg8::EpiPart, pg8::TailSplitOrder, true, true, true>(lds, g, S2, E2); }
          } else {
              pg8::Gemm g{(const bf16_t*)(ws + WS_HID), (const bf16_t*)(ws + WS_WD + l * SZ_WD), T, D, DFF}; pg8::StaticOrder S; S.init(sp ? TP : T, D, DFF, G, (int)blockIdx.x, WGM_G4);
              pg8::EpiRes<4> E{(bf16_t*)(ws + WS_P2), (const bf16_t*)(ws + WS_P1), (const float*)(ws + WS_ST1), pp->in[4] + l * D, pp->in[5] + l * D, (float*)(ws + WS_ST2P), (LAS float*)(lds + PST_OFF), 1.f};
              pg8::gemm_phase<pg8::EpiRes<4>, pg8::StaticOrder, true, true>(lds, g, S, E);
              if (sp) { pg8::TailSplitOrder S2; S2.init(TP, D, DFF, (int)blockIdx.x); pg8::EpiPart E2{(float*)(ws + WS_PART), TP, TS, 1.f}; pg8::gemm_phase<pg8::EpiPart, pg8::TailSplitOrder, true, true>(lds, g, S2, E2); } } }
#endif
        GRIDBAR();
        if (!(F8_LAST && lc == DEPTH - 1)) {
        { GETP(); const bool sp = split_on((int)gridDim.x); finalize_stats((const float*)(ws + WS_ST2P), (float*)(ws + WS_ST2), sp ? TP : T);
          if (sp) finalize_sample((const float*)(ws + WS_PART), (const bf16_t*)(ws + WS_P1), (const float*)(ws + WS_ST1), pp->in[4] + l * D, pp->in[5] + l * D, (bf16_t*)(ws + WS_P2), (float*)(ws + WS_ST2)); }
        GRIDBAR();
        }
        for (int rep = 1; rep < REP_SYNC; ++rep) GRIDBAR();
    }
    for (int rep = 0; rep < REP_FIN; ++rep) { const int lc = DEPTH - 1; GETP(); const int G = gridDim.x; float* out = pp->out;
      const float* gF = pp->in[15] + l * D; const float* bF = pp->in[16] + l * D; const bf16_t* P2 = (const bf16_t*)(ws + WS_P2); const float* ST2 = (const float*)(ws + WS_ST2);
      int tidf = threadIdx.x; asm volatile("" : "+v"(tidf)); const int lane = tidf & 63, wid = __builtin_amdgcn_readfirstlane(tidf >> 6);
      const int gw = blockIdx.x * NWAVES + wid, NGW = G * NWAVES;
      float gv[2][8], bv[2][8]; load8f(gF + lane * 8, gv[0]); load8f(gF + 512 + lane * 8, gv[1]); load8f(bF + lane * 8, bv[0]); load8f(bF + 512 + lane * 8, bv[1]);
#if F8_LAST
      const float* gM = pp->in[4] + l * D; const float* bM = pp->in[5] + l * D; const bf16_t* P1 = (const bf16_t*)(ws + WS_P1); const float* ST1 = (const float*)(ws + WS_ST1);
      float g1[2][8], b1[2][8]; load8f(gM + lane * 8, g1[0]); load8f(gM + 512 + lane * 8, g1[1]); load8f(bM + lane * 8, b1[0]); load8f(bM + 512 + lane * 8, b1[1]);
#pragma unroll 2
      for (int row = gw; row < T; row += NGW) { float mu1, rs1; pg8::row_stats(ST1, row, mu1, rs1);
          float v[2][8], s = 0.f, q2 = 0.f;
#pragma unroll
          for (int hh = 0; hh < 2; ++hh) { float p[8], f[8]; unpack8(*(const u32x4*)(P1 + (size_t)row * D + hh * 512 + lane * 8), p); unpack8(*(const u32x4*)(P2 + (size_t)row * D + hh * 512 + lane * 8), f);
#pragma unroll
              for (int q = 0; q < 8; ++q) { const float x = pg8::ALPHA * ((p[q] - mu1) * rs1 * g1[hh][q] + b1[hh][q]) + f[q]; v[hh][q] = x; s += x; q2 += x * x; } }
          s = wave_sum(s); q2 = wave_sum(q2);
          const float mu = s * (1.f / 1024.f), rs = rsqrtf(fmaxf(q2 * (1.f / 1024.f) - mu * mu, 0.f) + pg8::LN_EPS);
#pragma unroll
          for (int hh = 0; hh < 2; ++hh) { float* o = out + (size_t)row * D + hh * 512 + lane * 8; float f[8];
#pragma unroll
              for (int q = 0; q < 8; ++q) f[q] = (v[hh][q] - mu) * rs * gv[hh][q] + bv[hh][q];
              *(f32x4*)o = (f32x4){f[0], f[1], f[2], f[3]}; *(f32x4*)(o + 4) = (f32x4){f[4], f[5], f[6], f[7]}; } }
      (void)ST2;
#else
#pragma unroll 2
      for (int row = gw; row < T; row += NGW) { float mu, rs; pg8::row_stats(ST2, row, mu, rs);
#pragma unroll
          for (int hh = 0; hh < 2; ++hh) { float f[8]; unpack8(*(const u32x4*)(P2 + (size_t)row * D + hh * 512 + lane * 8), f); float* o = out + (size_t)row * D + hh * 512 + lane * 8;
#pragma unroll
              for (int q = 0; q < 8; ++q) f[q] = (f[q] - mu) * rs * gv[hh][q] + bv[hh][q];
              *(f32x4*)o = (f32x4){f[0], f[1], f[2], f[3]}; *(f32x4*)(o + 4) = (f32x4){f[4], f[5], f[6], f[7]}; } }
#endif
    }
}

extern "C" void kernel_launch(void* const* d_in, const int* in_sizes, int n_in, void* d_out, int out_size, void* d_ws, size_t ws_size, hipStream_t stream) {
    static int grid = 0;
    if (grid == 0) {
        if (n_in != 20 || (size_t)out_size != O_END || ws_size < WS_END) { fprintf(stderr, "kernel_launch: unexpected sizes n_in %d out %d (want %zu) ws %zu (want %zu)\n", n_in, out_size, (size_t)O_END, ws_size, (size_t)WS_END); grid = -1; return; }
        int dev = 0, cus = 0, per_cu = 0;
        if (hipGetDevice(&dev) != hipSuccess || hipDeviceGetAttribute(&cus, hipDeviceAttributeMultiprocessorCount, dev) != hipSuccess) { grid = -1; return; }
        if (hipFuncSetAttribute((const void*)fwd_megakernel, hipFuncAttributeMaxDynamicSharedMemorySize, LDS_BYTES) != hipSuccess) { fprintf(stderr, "kernel_launch: hipFuncSetAttribute failed\n"); grid = -1; return; }
        if (hipOccupancyMaxActiveBlocksPerMultiprocessor(&per_cu, (const void*)fwd_megakernel, NTHR, LDS_BYTES) != hipSuccess || per_cu < 1) { fprintf(stderr, "kernel_launch: occupancy query reports %d\n", per_cu); (void)hipGetLastError(); per_cu = 1; }
        grid = cus;
    }
    if (grid < 0) return;
    if (hipMemsetAsync((char*)d_ws + WS_BAR, 0, BAR_BYTES, stream) != hipSuccess) { fprintf(stderr, "kernel_launch: memset of the barrier words failed\n"); return; }
    Params p{};
    for (int i = 0; i < 20; ++i) p.in[i] = (const float*)d_in[i];
    p.out = (float*)d_out; p.ws = (unsigned char*)d_ws;
    void* args[] = {&p};
    const hipError_t e = hipLaunchCooperativeKernel((const void*)fwd_megakernel, dim3(grid), dim3(NTHR), args, LDS_BYTES, stream);
    if (e != hipSuccess) fprintf(stderr, "kernel_launch: cooperative launch failed: %s (grid %d)\n", hipGetErrorString(e), grid);
}
```
